# Optimizing an MI355X kernel written in HIP

```python
import jax, jax.numpy as jnp
from jax import lax
import numpy as np

D_MODEL = 1024
BATCH = 1
SEQ = 16384
DEPTH = 2

GRID_W = 64
CTX_LEN = 256
CHUNK = 128
Q_BLOCK = 128
EPS = 1e-6
A_GROUPS = 4
A_WIDTH = D_MODEL // 4
B_BLOCKS = 4
B_WIDTH = D_MODEL // 4
CONV_W = 4
LRU_C = 8.0
C_NOPE = 128
C_ROPE = 64
C_V = 128
C_HEADS = (D_MODEL // 2) // C_V
C_WIDTH = C_HEADS * C_V
Q_LORA = 384
KV_LORA = 256
ROPE_BASE = 10000.0
ATTN_SCALE = (C_NOPE + C_ROPE) ** -0.5
MIX_WIDTH = A_WIDTH + B_WIDTH + C_WIDTH
IN_SPLITS = (2 * A_WIDTH, 2 * A_WIDTH + B_WIDTH, 2 * A_WIDTH + 2 * B_WIDTH, 2 * A_WIDTH + 2 * B_WIDTH + Q_LORA, 2 * A_WIDTH + 2 * B_WIDTH + Q_LORA + KV_LORA)
IN_COLS = IN_SPLITS[-1] + C_ROPE
N_EXPERTS = 16
EXPERT_FF = 1024
EC_CAPACITY = 2

kernel_name = 'hybrid_gmlp_rglru_mla_ecmoe_dit'


def rmsnorm(x, g):
    xf = x.astype(jnp.float32)
    y = xf * lax.rsqrt(jnp.mean(xf * xf, axis=-1, keepdims=True) + EPS)
    return (y * g.astype(jnp.float32)).astype(x.dtype)


def modulate(h, shift, scale):
    return h * (1 + scale) + shift


def rope_tables(n):
    rows = n // GRID_W
    r = jnp.repeat(jnp.arange(rows), GRID_W).astype(jnp.float32)
    col = jnp.tile(jnp.arange(GRID_W), rows).astype(jnp.float32)
    nf = C_ROPE // 4
    inv = ROPE_BASE ** (-jnp.arange(nf, dtype=jnp.float32) / nf)
    ang = jnp.concatenate([r[:, None] * inv, col[:, None] * inv], axis=-1)
    return jnp.cos(ang), jnp.sin(ang)


def apply_rope(x, cos, sin):
    shp = x.shape
    nf = C_ROPE // 4
    xf = x.astype(jnp.float32).reshape(*shp[:-1], 2, 2, nf)
    cs = cos.reshape(cos.shape[0], 1, 2, nf)
    sn = sin.reshape(sin.shape[0], 1, 2, nf)
    x1 = xf[..., 0, :]
    x2 = xf[..., 1, :]
    out = jnp.stack([x1 * cs - x2 * sn, x2 * cs + x1 * sn], axis=-2).reshape(shp)
    return out.astype(x.dtype)


def chunk_sgu(z, w_s, b_s):
    u, v = jnp.split(z, 2, axis=-1)
    vf = v.astype(jnp.float32)
    v = (vf * lax.rsqrt(jnp.mean(vf * vf, axis=-1, keepdims=True) + EPS)).astype(z.dtype)
    b, t, _ = v.shape
    vb = v.reshape(b, t // CHUNK, CHUNK, A_GROUPS, A_WIDTH // A_GROUPS)
    mixed = jnp.einsum('gpq,bnqgc->bnpgc', w_s, vb) + b_s.T[:, :, None]
    return u * mixed.reshape(b, t, A_WIDTH)


def dwconv(x, w, b):
    t = x.shape[1]
    left = CONV_W // 2
    xp = jnp.pad(x, ((0, 0), (left, CONV_W - 1 - left), (0, 0)))
    y = b
    for k in range(CONV_W):
        y = y + xp[:, k:k + t] * w[k]
    return y


def blockdiag(x, w, b):
    xb = x.reshape(*x.shape[:-1], B_BLOCKS, B_WIDTH // B_BLOCKS)
    return jnp.einsum('btnc,ncd->btnd', xb, w).reshape(x.shape) + b


def lru_coeffs(xc, wa, ba, wx, bx, lam):
    r = jax.nn.sigmoid(blockdiag(xc, wa, ba)).astype(jnp.float32)
    i = jax.nn.sigmoid(blockdiag(xc, wx, bx)).astype(jnp.float32)
    log_a = -LRU_C * r * jax.nn.softplus(-lam.astype(jnp.float32))
    a = jnp.exp(log_a)
    mult = jnp.sqrt(jnp.maximum(-jnp.expm1(2 * log_a), 0.0))
    return a, mult * (i * xc.astype(jnp.float32))


def linear_scan(a, b, reverse):
    def comb(e1, e2):
        a1, b1 = e1
        a2, b2 = e2
        return a1 * a2, a2 * b1 + b2
    return lax.associative_scan(comb, (a, b), reverse=reverse, axis=1)


def rglru_mixer(xb_l, gb_l, xb_c, gb_c, lp, need_ctx_out):
    cl = dwconv(xb_l, lp['conv_w'], lp['conv_b'])
    cc = dwconv(xb_c, lp['conv_w'], lp['conv_b'])
    hl_dirs = []
    hc_dirs = []
    for d in range(2):
        rev = d == 1
        a_c, b_c = lru_coeffs(cc, lp['lru_wa'][d], lp['lru_ba'][d], lp['lru_wx'][d], lp['lru_bx'][d], lp['lru_lambda'][d])
        _, hc = linear_scan(a_c, b_c, rev)
        h0 = hc[:, 0] if rev else hc[:, -1]
        a_l, b_l = lru_coeffs(cl, lp['lru_wa'][d], lp['lru_ba'][d], lp['lru_wx'][d], lp['lru_bx'][d], lp['lru_lambda'][d])
        acum, bcum = linear_scan(a_l, b_l, rev)
        hl_dirs.append(acum * h0[:, None] + bcum)
        hc_dirs.append(hc)
    yl = (hl_dirs[0] + hl_dirs[1]).astype(xb_l.dtype) * jax.nn.gelu(gb_l)
    yc = (hc_dirs[0] + hc_dirs[1]).astype(xb_c.dtype) * jax.nn.gelu(gb_c) if need_ctx_out else None
    return yl, yc


def mla_q(cq, g, w_uq, rope):
    b, t, _ = cq.shape
    q = (rmsnorm(cq, g) @ w_uq).reshape(b, t, C_HEADS, C_NOPE + C_ROPE)
    if rope is not None:
        q = jnp.concatenate([q[..., :C_NOPE], apply_rope(q[..., C_NOPE:], rope[0], rope[1])], axis=-1)
    return q


def mla_kv(ckv, kr, g, w_ukv, rope):
    b, t, _ = ckv.shape
    kv = (rmsnorm(ckv, g) @ w_ukv).reshape(b, t, C_HEADS, C_NOPE + C_V)
    k_nope, v = kv[..., :C_NOPE], kv[..., C_NOPE:]
    kr = kr[:, :, None, :]
    if rope is not None:
        kr = apply_rope(kr, rope[0], rope[1])
    k = jnp.concatenate([k_nope, jnp.broadcast_to(kr, (b, t, C_HEADS, C_ROPE))], axis=-1)
    return k, v


def attend(q, k, v):
    s = jnp.einsum('bqhd,bkhd->bhqk', q, k, preferred_element_type=jnp.float32) * ATTN_SCALE
    p = jax.nn.softmax(s, axis=-1).astype(v.dtype)
    return jnp.einsum('bhqk,bkhd->bqhd', p, v)


def latent_attention(q, k, v):
    b, t, h, dk = q.shape
    qb = q.reshape(b, t // Q_BLOCK, Q_BLOCK, h, dk).swapaxes(0, 1)
    ob = lax.map(lambda qq: attend(qq, k, v), qb)
    return ob.swapaxes(0, 1).reshape(b, t, h * v.shape[-1])


def ec_moe(h, w_router, w_gate, w_up, w_down):
    b, t, d = h.shape
    cap = EC_CAPACITY * t // N_EXPERTS
    logits = jnp.einsum('btd,de->bte', h, w_router, preferred_element_type=jnp.float32)
    probs = jax.nn.softmax(logits, axis=-1)
    g, idx = lax.top_k(jnp.swapaxes(probs, 1, 2), cap)
    xs = jax.vmap(lambda hb, ib: hb[ib])(h, idx)
    hid = jax.nn.silu(jnp.einsum('becd,edf->becf', xs, w_gate)) * jnp.einsum('becd,edf->becf', xs, w_up)
    ye = jnp.einsum('becf,efd->becd', hid, w_down) * g[..., None].astype(h.dtype)
    return jax.vmap(lambda yb, ib: jnp.zeros((t, d), yb.dtype).at[ib.reshape(-1)].add(yb.reshape(-1, d)))(ye, idx)


def layer(xl, xc, c, c_ctx, lp, rope, last):
    mod_l = (jax.nn.silu(c) @ lp['w_mod'] + lp['b_mod'])[:, None, :]
    mod_c = (jax.nn.silu(c_ctx) @ lp['w_mod'] + lp['b_mod'])[None, None, :]
    sh1_l, sc1_l, g1_l, sh2_l, sc2_l, g2_l = jnp.split(mod_l, 6, axis=-1)
    sh1_c, sc1_c, g1_c, sh2_c, sc2_c, g2_c = jnp.split(mod_c, 6, axis=-1)
    hl = modulate(rmsnorm(xl, lp['norm1_g']), sh1_l, sc1_l)
    hc = modulate(rmsnorm(xc, lp['norm1_g']), sh1_c, sc1_c)
    za_l, xb_l, gb_l, cq_l, ckv_l, kr_l = jnp.split(hl @ lp['w_in'], IN_SPLITS, axis=-1)
    za_c, xb_c, gb_c, cq_c, ckv_c, kr_c = jnp.split(hc @ lp['w_in'], IN_SPLITS, axis=-1)
    kc, vc = mla_kv(ckv_c, kr_c, lp['kv_norm_g'], lp['w_ukv'], None)
    kl, vl = mla_kv(ckv_l, kr_l, lp['kv_norm_g'], lp['w_ukv'], rope)
    ql = mla_q(cq_l, lp['q_norm_g'], lp['w_uq'], rope)
    yc_l = latent_attention(ql, jnp.concatenate([kc, kl], axis=1), jnp.concatenate([vc, vl], axis=1))
    yb_l, yb_c = rglru_mixer(xb_l, gb_l, xb_c, gb_c, lp, not last)
    ya_l = chunk_sgu(jax.nn.gelu(za_l), lp['sgu_w'], lp['sgu_b'])
    xl = xl + g1_l * (jnp.concatenate([ya_l, yb_l, yc_l], axis=-1) @ lp['w_out'])
    h2l = modulate(rmsnorm(xl, lp['norm2_g']), sh2_l, sc2_l)
    xl = xl + g2_l * ec_moe(h2l, lp['w_router'], lp['w_gate'], lp['w_up'], lp['w_down'])
    if not last:
        b = xc.shape[0]
        qc = mla_q(cq_c, lp['q_norm_g'], lp['w_uq'], None)
        yc_c = attend(qc, kc, vc).reshape(b, xc.shape[1], C_WIDTH)
        ya_c = chunk_sgu(jax.nn.gelu(za_c), lp['sgu_w'], lp['sgu_b'])
        xc = xc + g1_c * (jnp.concatenate([ya_c, yb_c, yc_c], axis=-1) @ lp['w_out'])
        h2c = modulate(rmsnorm(xc, lp['norm2_g']), sh2_c, sc2_c)
        xc = xc + g2_c * ec_moe(h2c, lp['w_router'], lp['w_gate'], lp['w_up'], lp['w_down'])
    return xl, xc


def setup_inputs(seed: int = 0) -> dict:
    key = jax.random.key(seed)
    ks = jax.random.split(key, 32)
    L, D = DEPTH, D_MODEL
    f32 = jnp.float32

    def nrm(k, shape, s):
        return jax.random.normal(k, shape, f32) * s

    def gain(k, shape):
        return 1.0 + nrm(k, shape, 0.01)

    u = jax.random.uniform(ks[16], (L, 2, B_WIDTH), f32, minval=0.9, maxval=0.999)
    base = u ** (1.0 / LRU_C)
    lru_lambda = jnp.log(base) - jnp.log1p(-base)
    bw = B_WIDTH // B_BLOCKS
    return {
        'x': nrm(ks[0], (BATCH, SEQ, D), 1.0),
        'c': nrm(ks[1], (BATCH, D), 1.0),
        'ctx': nrm(ks[2], (BATCH, CTX_LEN, D), 1.0),
        'c_ctx': nrm(ks[3], (D,), 1.0),
        'norm1_g': gain(ks[4], (L, D)),
        'w_mod': nrm(ks[5], (L, D, 6 * D), 0.5 * D ** -0.5),
        'b_mod': nrm(ks[6], (L, 6 * D), 0.01),
        'w_in': nrm(ks[7], (L, D, IN_COLS), D ** -0.5),
        'sgu_w': nrm(ks[8], (L, A_GROUPS, CHUNK, CHUNK), 0.5 * CHUNK ** -0.5),
        'sgu_b': 1.0 + nrm(ks[9], (L, A_GROUPS, CHUNK), 0.01),
        'conv_w': nrm(ks[10], (L, CONV_W, B_WIDTH), CONV_W ** -0.5),
        'conv_b': nrm(ks[11], (L, B_WIDTH), 0.01),
        'lru_wa': nrm(ks[12], (L, 2, B_BLOCKS, bw, bw), bw ** -0.5),
        'lru_ba': nrm(ks[13], (L, 2, B_WIDTH), 0.01),
        'lru_wx': nrm(ks[14], (L, 2, B_BLOCKS, bw, bw), bw ** -0.5),
        'lru_bx': nrm(ks[15], (L, 2, B_WIDTH), 0.01),
        'lru_lambda': lru_lambda,
        'q_norm_g': gain(ks[17], (L, Q_LORA)),
        'w_uq': nrm(ks[18], (L, Q_LORA, C_HEADS * (C_NOPE + C_ROPE)), Q_LORA ** -0.5),
        'kv_norm_g': gain(ks[19], (L, KV_LORA)),
        'w_ukv': nrm(ks[20], (L, KV_LORA, C_HEADS * (C_NOPE + C_V)), KV_LORA ** -0.5),
        'w_out': nrm(ks[21], (L, MIX_WIDTH, D), MIX_WIDTH ** -0.5),
        'norm2_g': gain(ks[22], (L, D)),
        'w_router': nrm(ks[23], (L, D, N_EXPERTS), D ** -0.5),
        'w_gate': nrm(ks[24], (L, N_EXPERTS, D, EXPERT_FF), D ** -0.5),
        'w_up': nrm(ks[25], (L, N_EXPERTS, D, EXPERT_FF), D ** -0.5),
        'w_down': nrm(ks[26], (L, N_EXPERTS, EXPERT_FF, D), EXPERT_FF ** -0.5),
        'final_norm_g': gain(ks[27], (D,)),
    }


def reference(x, c, ctx, c_ctx, norm1_g, w_mod, b_mod, w_in, sgu_w, sgu_b, conv_w, conv_b, lru_wa, lru_ba, lru_wx, lru_bx, lru_lambda, q_norm_g, w_uq, kv_norm_g, w_ukv, w_out, norm2_g, w_router, w_gate, w_up, w_down, final_norm_g):
    rope = rope_tables(x.shape[1])
    xl, xc = x, ctx
    for i in range(DEPTH):
        lp = {
            'norm1_g': norm1_g[i], 'w_mod': w_mod[i], 'b_mod': b_mod[i], 'w_in': w_in[i],
            'sgu_w': sgu_w[i], 'sgu_b': sgu_b[i], 'conv_w': conv_w[i], 'conv_b': conv_b[i],
            'lru_wa': lru_wa[i], 'lru_ba': lru_ba[i], 'lru_wx': lru_wx[i], 'lru_bx': lru_bx[i],
            'lru_lambda': lru_lambda[i], 'q_norm_g': q_norm_g[i], 'w_uq': w_uq[i],
            'kv_norm_g': kv_norm_g[i], 'w_ukv': w_ukv[i], 'w_out': w_out[i], 'norm2_g': norm2_g[i],
            'w_router': w_router[i], 'w_gate': w_gate[i], 'w_up': w_up[i], 'w_down': w_down[i],
        }
        xl, xc = layer(xl, xc, c, c_ctx, lp, rope, i == DEPTH - 1)
    return rmsnorm(xl, final_norm_g)
```

```cpp
#include <hip/hip_runtime.h>
#include <hip/hip_cooperative_groups.h>
#include <hip/hip_bf16.h>
#include <cstdio>
#include <cstdint>
namespace cg = cooperative_groups;
__device__ __forceinline__ int otid() { int t = threadIdx.x; asm volatile("" : "+v"(t)); return t; }
namespace pg8 {
#define PG8_LAS __attribute__((address_space(3)))
typedef unsigned short bf16_t;
typedef short bf16x8 __attribute__((ext_vector_type(8)));
typedef float f32x4 __attribute__((ext_vector_type(4)));
typedef unsigned u32x4 __attribute__((ext_vector_type(4)));
constexpr int BM = 256, BK = 64, HALF = 128, HTB = HALF * BK * 2  , STAGE_BYTES = 8 * HTB, NXCD = 8, WGM = 8;

__host__ __device__ __forceinline__ int lds_byte(int r, int c) { const int st = (r >> 4) * 2 + (c >> 5), rr = r & 15, cc = c & 31, ob = rr * 64 + cc * 2; return st * 1024 + (ob ^ (((ob >> 9) & 1) << 5)); }
__host__ __device__ __forceinline__ void stage_rc(int b, int& R, int& C) { const int st = b / 1024, sb = b % 1024, swz = sb ^ (((sb >> 9) & 1) << 5); R = (st >> 1) * 16 + swz / 64; C = (st & 1) * 32 + (swz % 64) / 2; }
__host__ __device__ __forceinline__ int perm32(int rho) { const int n = rho >> 4, i = rho & 15; return 8 * (i >> 2) + 4 * n + (i & 3); }

struct Unit { int pm, pn; };
struct Gemm { const bf16_t* A; const bf16_t* Bt; int M, N, K; const int* ridx; };

struct StaticOrder {
    int nM, nN, nwg, G, c;
    __host__ __device__ void init(int M, int N, int G_, int c_) { nM = M / BM; nN = N / BM; nwg = nM * nN; G = G_; c = c_; }
    __host__ __device__ bool next(int i, Unit& u) const {
        const long L = (long)i * G + c; if (L >= nwg) return false;
        int wgid = (int)L; { const int q = nwg / NXCD, r = nwg % NXCD, xcd = wgid % NXCD, off = wgid / NXCD; wgid = (xcd < r ? xcd * (q + 1) : r * (q + 1) + (xcd - r) * q) + off; }
        const int nig = WGM * nN, gid = wgid / nig, fm = gid * WGM, gsz = (nM - fm) < WGM ? (nM - fm) : WGM;
        u.pm = fm + ((wgid % nig) % gsz); u.pn = (wgid % nig) / gsz; return true;
    }
    __device__ __forceinline__ void a_ready(const Unit&) const {}
    __device__ __forceinline__ void done(const Unit&) const {}
};

__device__ __forceinline__ unsigned cvt_pk_bf16(float lo, float hi) { unsigned r; asm volatile("v_cvt_pk_bf16_f32 %0, %1, %2" : "=v"(r) : "v"(lo), "v"(hi)); return r; }
typedef float f32x2 __attribute__((ext_vector_type(2)));
typedef unsigned u32x2 __attribute__((ext_vector_type(2)));
struct GridOrder {
    int nM, nN, G, c, pm0;
    __device__ __forceinline__ bool next(int i, Unit& u) const {
        const int L = i * G + c; if (L >= nM * nN) return false;
        const int nig = 8 * nN, gid = L / nig, fm = gid * 8, gsz = (nM - fm) < 8 ? (nM - fm) : 8, w = L % nig;
        u.pm = pm0 + fm + (w % gsz); u.pn = w / gsz; return true;
    }
    __device__ __forceinline__ void a_ready(const Unit&) const {}
    __device__ __forceinline__ void done(const Unit&) const {}
};
struct MoeOrder {
    int ncol, G, c, nctx;
    __device__ __forceinline__ bool next(int i, Unit& u) const {
        const int L = i * G + c, per = 8 * ncol, nlat = 16 * per;
        if (L < nlat) { const int e = L / per, w = L % per; u.pm = e * 8 + (w & 7); u.pn = e * ncol + (w >> 3); return true; }
        const int L2 = L - nlat; if (L2 >= nctx * ncol) return false;
        const int e = L2 / ncol; u.pm = 128 + e; u.pn = e * ncol + (L2 % ncol); return true;
    }
    __device__ __forceinline__ void a_ready(const Unit&) const {}
    __device__ __forceinline__ void done(const Unit&) const {}
};
struct EpiPlainBf16 {
    static constexpr bool PERM = true, AFTER_DRAIN = false;
    bf16_t* O; int ldc;
    __device__ __forceinline__ void operator()(const f32x4 (&acc)[2][2][4][2], const Unit& u, int wr, int wc, int fr, int fq) const {
        const int row0 = u.pm * BM + wr * 64 + fr, col0 = u.pn * BM + wc * 32 + 8 * fq;
#pragma unroll
        for (int ai = 0; ai < 2; ++ai)
#pragma unroll
            for (int m = 0; m < 4; ++m) { bf16_t* rowp = O + (size_t)(row0 + ai * HALF + m * 16) * ldc + col0;
#pragma unroll
                for (int bj = 0; bj < 2; ++bj) { const f32x4 v0 = acc[ai][bj][m][0], v1 = acc[ai][bj][m][1];
                    u32x4 w; w.x = cvt_pk_bf16(v0[0], v0[1]); w.y = cvt_pk_bf16(v0[2], v0[3]); w.z = cvt_pk_bf16(v1[0], v1[1]); w.w = cvt_pk_bf16(v1[2], v1[3]);
                    *(u32x4*)(rowp + bj * HALF) = w; } }
    }
};
__device__ __forceinline__ unsigned pk4_fp8(f32x4 v) {
    const float a = __builtin_amdgcn_fmed3f(v[0], -448.f, 448.f), b = __builtin_amdgcn_fmed3f(v[1], -448.f, 448.f), c = __builtin_amdgcn_fmed3f(v[2], -448.f, 448.f), d = __builtin_amdgcn_fmed3f(v[3], -448.f, 448.f);
    int w = __builtin_amdgcn_cvt_pk_fp8_f32(a, b, 0, false); w = __builtin_amdgcn_cvt_pk_fp8_f32(c, d, w, true); return (unsigned)w; }
struct EpiK8 {
    static constexpr bool PERM = false, AFTER_DRAIN = false;
    static constexpr int rows = 16640;
    unsigned char* K8; float ksc;
    __device__ __forceinline__ void operator()(const f32x4 (&acc)[2][2][4][2], const Unit& u, int wr, int wc, int fr, int fq) const {
#pragma unroll
        for (int ai = 0; ai < 2; ++ai)
#pragma unroll
            for (int m = 0; m < 4; ++m) { const int row = u.pm * BM + ai * HALF + wr * 64 + m * 16 + fr;
#pragma unroll
                for (int bj = 0; bj < 2; ++bj) { u32x2 w; w.x = pk4_fp8(acc[ai][bj][m][0] * ksc); w.y = pk4_fp8(acc[ai][bj][m][1] * ksc);
                    *(u32x2*)(K8 + ((size_t)(2 * u.pn + bj) * rows + row) * 128 + wc * 32 + 8 * fq) = w; } }
    }
};
struct EpiVT {
    static constexpr bool PERM = true, AFTER_DRAIN = false;
    static constexpr int rows = 16640;
    unsigned char* VT;
    __device__ __forceinline__ void operator()(const f32x4 (&acc)[2][2][4][2], const Unit& u, int wr, int wc, int fr, int fq) const {
#pragma unroll
        for (int ai = 0; ai < 2; ++ai)
#pragma unroll
            for (int m = 0; m < 4; ++m) { unsigned char* rowp = VT + (size_t)(u.pm * BM + ai * HALF + wr * 64 + m * 16 + fr) * rows;
#pragma unroll
                for (int bj = 0; bj < 2; ++bj) { const int key = u.pn * BM + bj * HALF + wc * 32 + 8 * fq, off = (key & ~63) + 4 * ((key & 63) >> 3);
                    *(unsigned*)(rowp + off) = pk4_fp8(acc[ai][bj][m][0]); *(unsigned*)(rowp + off + 32) = pk4_fp8(acc[ai][bj][m][1]); } }
    }
};
struct EpiQRope {
    static constexpr bool PERM = false, AFTER_DRAIN = false;
    unsigned char* Q; const float* cosT; const float* sinT; float qscale;
    __device__ __forceinline__ void operator()(const f32x4 (&acc)[2][2][4][2], const Unit& u, int wr, int wc, int fr, int fq) const {
        const int w0 = (u.pn * BM + wc * 32) % 192, w1 = (u.pn * BM + HALF + wc * 32) % 192; const bool rot0 = w0 >= 128, rot1 = w1 >= 128, anyrot = (rot0 || rot1) && u.pm != 0;
#pragma unroll
        for (int ai = 0; ai < 2; ++ai) { f32x4 cs[4][2], sn[4][2];
            if (anyrot) {
#pragma unroll
                for (int m = 0; m < 4; ++m) { const int row = u.pm * BM + ai * HALF + wr * 64 + m * 16 + fr, t = row >= 256 ? row - 256 : 0;
                    const int p0 = (w0 >= 160) ? (t & 63) : (t >> 6), p1 = (w1 >= 160) ? (t & 63) : (t >> 6);
                    cs[m][0] = *(const f32x4*)(cosT + p0 * 16 + 4 * fq); sn[m][0] = *(const f32x4*)(sinT + p0 * 16 + 4 * fq); cs[m][1] = *(const f32x4*)(cosT + p1 * 16 + 4 * fq); sn[m][1] = *(const f32x4*)(sinT + p1 * 16 + 4 * fq); } }
#pragma unroll
            for (int m = 0; m < 4; ++m) { const int row = u.pm * BM + ai * HALF + wr * 64 + m * 16 + fr; unsigned char* rowp = Q + (size_t)row * 768;
#pragma unroll
                for (int bj = 0; bj < 2; ++bj) { const int cb = u.pn * BM + bj * HALF + wc * 32; const bool rot = (bj ? rot1 : rot0) && row >= 256;
                    f32x4 o0 = acc[ai][bj][m][0], o1 = acc[ai][bj][m][1];
                    if (rot) { const f32x4 x1 = o0, x2 = o1; o0 = x1 * cs[m][bj] - x2 * sn[m][bj]; o1 = x2 * cs[m][bj] + x1 * sn[m][bj]; }
                    o0 = o0 * qscale; o1 = o1 * qscale;
                    u32x2 w; w.x = pk4_fp8(o0); w.y = pk4_fp8(o1);
                    *(u32x2*)(rowp + cb + 8 * fq) = w; } } }
    }
};
struct EpiResid {
    static constexpr bool PERM = false, AFTER_DRAIN = false;
    const float* src_ctx; const float* src_lat; float* XL; const float* g_lat; const float* g_ctx;
    __device__ __forceinline__ void operator()(const f32x4 (&acc)[2][2][4][2], const Unit& u, int wr, int wc, int fr, int fq) const {
        const float* g = (u.pm == 0) ? g_ctx : g_lat;
        const int col0 = u.pn * BM + wc * 32 + 4 * fq;
        f32x4 gv[2][2];
#pragma unroll
        for (int bj = 0; bj < 2; ++bj)
#pragma unroll
            for (int n = 0; n < 2; ++n) gv[bj][n] = *(const f32x4*)(g + col0 + bj * HALF + n * 16);
#pragma unroll
        for (int ai = 0; ai < 2; ++ai) { f32x4 bs[4][2][2];
#pragma unroll
            for (int m = 0; m < 4; ++m) { const int row = u.pm * BM + ai * HALF + wr * 64 + m * 16 + fr;
                const float* sp = (u.pm == 0) ? src_ctx + (size_t)row * 1024 : src_lat + (size_t)(row - 256) * 1024;
#pragma unroll
                for (int bj = 0; bj < 2; ++bj)
#pragma unroll
                    for (int n = 0; n < 2; ++n) bs[m][bj][n] = *(const f32x4*)(sp + col0 + bj * HALF + n * 16); }
#pragma unroll
            for (int m = 0; m < 4; ++m) { const int row = u.pm * BM + ai * HALF + wr * 64 + m * 16 + fr; float* op = XL + (size_t)row * 1024;
#pragma unroll
                for (int bj = 0; bj < 2; ++bj)
#pragma unroll
                    for (int n = 0; n < 2; ++n) *(f32x4*)(op + col0 + bj * HALF + n * 16) = bs[m][bj][n] + gv[bj][n] * acc[ai][bj][m][n]; } }
    }
};
__device__ __forceinline__ float silu_f(float x) { return x * __builtin_amdgcn_rcpf(1.0f + __expf(-x)); }
struct EpiSwiglu {
    static constexpr bool PERM = true, AFTER_DRAIN = false;
    bf16_t* HID;
    __device__ __forceinline__ void operator()(const f32x4 (&acc)[2][2][4][2], const Unit& u, int wr, int wc, int fr, int fq) const {
        const int row0 = u.pm * BM + wr * 64 + fr, col0 = (u.pn & 7) * 128 + wc * 32 + 8 * fq;
#pragma unroll
        for (int ai = 0; ai < 2; ++ai)
#pragma unroll
            for (int m = 0; m < 4; ++m) { bf16_t* rowp = HID + (size_t)(row0 + ai * HALF + m * 16) * 1024 + col0;
                const f32x4 g0 = acc[ai][0][m][0], g1 = acc[ai][0][m][1], u0 = acc[ai][1][m][0], u1 = acc[ai][1][m][1];
                u32x4 w; w.x = cvt_pk_bf16(silu_f(g0[0]) * u0[0], silu_f(g0[1]) * u0[1]); w.y = cvt_pk_bf16(silu_f(g0[2]) * u0[2], silu_f(g0[3]) * u0[3]);
                w.z = cvt_pk_bf16(silu_f(g1[0]) * u1[0], silu_f(g1[1]) * u1[1]); w.w = cvt_pk_bf16(silu_f(g1[2]) * u1[2], silu_f(g1[3]) * u1[3]);
                *(u32x4*)rowp = w; }
    }
};
struct EpiDown {
    static constexpr bool PERM = true, AFTER_DRAIN = false;
    bf16_t* YE; const float* gate; const float* gatec;
    __device__ __forceinline__ void operator()(const f32x4 (&acc)[2][2][4][2], const Unit& u, int wr, int wc, int fr, int fq) const {
        const int col0 = (u.pn & 3) * BM + wc * 32 + 8 * fq;
        float gvs[2][4];
#pragma unroll
        for (int ai = 0; ai < 2; ++ai)
#pragma unroll
            for (int m = 0; m < 4; ++m) { const int rt = ai * HALF + wr * 64 + m * 16 + fr; gvs[ai][m] = (u.pm < 128) ? gate[u.pm * BM + rt] : gatec[(u.pm - 128) * 32 + (rt & 31)] * (rt < 32 ? 1.f : 0.f); }
#pragma unroll
        for (int ai = 0; ai < 2; ++ai)
#pragma unroll
            for (int m = 0; m < 4; ++m) { const int rt = ai * HALF + wr * 64 + m * 16 + fr;
                const float gv = gvs[ai][m];
                bf16_t* rowp = YE + (size_t)(u.pm * BM + rt) * 1024 + col0;
#pragma unroll
                for (int bj = 0; bj < 2; ++bj) { const f32x4 v0 = acc[ai][bj][m][0] * gv, v1 = acc[ai][bj][m][1] * gv;
                    u32x4 w; w.x = cvt_pk_bf16(v0[0], v0[1]); w.y = cvt_pk_bf16(v0[2], v0[3]); w.z = cvt_pk_bf16(v1[0], v1[1]); w.w = cvt_pk_bf16(v1[2], v1[3]);
                    *(u32x4*)(rowp + bj * HALF) = w; } }
    }
};
template <class Epi, class Sched, bool ALIGN_EPI = false, bool SP2 = false, bool GATHER = false>
__device__ __forceinline__ void gemm_phase(PG8_LAS unsigned char* lds, const Gemm g, const Sched& S, const Epi& E) {
    const int tid = otid(), wid = __builtin_amdgcn_readfirstlane(tid >> 6), lane = tid & 63, wr = wid >> 2, wc = wid & 3, fr = lane & 15, fq = lane >> 4;
    const int K = g.K, nt = K / BK;
    unsigned voffA[2], voffB[2];
#pragma unroll
    for (int i = 0; i < 2; ++i) { int R, C; stage_rc(tid * 16 + i * 8192, R, C); const int Rb = Epi::PERM ? ((R & ~31) + perm32(R & 31)) : R;
        voffA[i] = (unsigned)(R * K + C) * 2u; voffB[i] = (unsigned)(Rb * K + C) * 2u; }
    int rcR[2], rcC[2];
#pragma unroll
    for (int i = 0; i < 2; ++i) stage_rc(tid * 16 + i * 8192, rcR[i], rcC[i]);
    unsigned curA[2][2], nxtA[2][2];
#define PG8_GIDX(dst, unit) do { if constexpr (GATHER) { _Pragma("unroll") for (int h_ = 0; h_ < 2; ++h_) _Pragma("unroll") for (int i_ = 0; i_ < 2; ++i_) \
        dst[h_][i_] = ((unsigned)g.ridx[(unit).pm * BM + h_ * HALF + rcR[i_]] * (unsigned)K + (unsigned)rcC[i_]) * 2u; } } while (0)
#define PG8_STAGE_A(bufoff, gbase, h, usenext) do { if constexpr (GATHER) { _Pragma("unroll") for (int _i = 0; _i < 2; ++_i) \
        __builtin_amdgcn_global_load_lds((const unsigned*)((const char*)(gbase) + ((usenext) ? nxtA[h][_i] : curA[h][_i])), (PG8_LAS unsigned*)(lds + (bufoff) + ldsw + _i * 8192), 16, 0, 0); } \
        else { PG8_STAGE(bufoff, (gbase) + (h) * hstep, voffA); } } while (0)
    const size_t kstep = (size_t)(BK * 2);
    const size_t hstep = (size_t)HALF * K * 2;
    const size_t tstep = 2 * hstep;
    const unsigned ldsw = (unsigned)wid * 1024u;
    const int aoff = lds_byte(wr * 64 + fr, fq * 8), boff = lds_byte(wc * 32 + fr, fq * 8);
#define PG8_SA(b, h) (((b) * 2 + (h)) * HTB)
#define PG8_SB(b, h) ((4 + (b) * 2 + (h)) * HTB)
#define PG8_STAGE(bufoff, gbase, voff) do { _Pragma("unroll") for (int _i = 0; _i < 2; ++_i) \
        __builtin_amdgcn_global_load_lds((const unsigned*)((const char*)(gbase) + (voff)[_i]), (PG8_LAS unsigned*)(lds + (bufoff) + ldsw + _i * 8192), 16, 0, 0); } while (0)
#define PG8_LDA(dst, b, h) do { _Pragma("unroll") for (int m = 0; m < 4; ++m) _Pragma("unroll") for (int k = 0; k < 2; ++k) dst[m][k] = *(const PG8_LAS bf16x8*)(lds + PG8_SA(b, h) + aoff + m * 2048 + k * 1024); } while (0)
#define PG8_LDB(dst, b, h) do { _Pragma("unroll") for (int n = 0; n < 2; ++n) _Pragma("unroll") for (int k = 0; k < 2; ++k) dst[n][k] = *(const PG8_LAS bf16x8*)(lds + PG8_SB(b, h) + boff + n * 2048 + k * 1024); } while (0)
#define PG8_MMA(ai, bj, At, Bt) do { __builtin_amdgcn_s_setprio(1); _Pragma("unroll") for (int m = 0; m < 4; ++m) _Pragma("unroll") for (int n = 0; n < 2; ++n) _Pragma("unroll") for (int k = 0; k < 2; ++k) \
        acc[ai][bj][m][n] = __builtin_amdgcn_mfma_f32_16x16x32_bf16(Bt[n][k], At[m][k], acc[ai][bj][m][n], 0, 0, 0); __builtin_amdgcn_s_setprio(0); } while (0)
#define PG8_WAIT_V(n) asm volatile("s_waitcnt vmcnt(" #n ")" ::: "memory")
#define PG8_WAIT_L(n) asm volatile("s_waitcnt lgkmcnt(" #n ")" ::: "memory")
#define PG8_BAR __builtin_amdgcn_s_barrier()
#define PG8_SCHED __builtin_amdgcn_sched_barrier(0)
    Unit cur, nxt; int ui = 0;
    if (!S.next(0, cur)) return;
    f32x4 acc[2][2][4][2];
#pragma unroll
    for (int a = 0; a < 2; ++a)
#pragma unroll
        for (int b = 0; b < 2; ++b)
#pragma unroll
            for (int m = 0; m < 4; ++m)
#pragma unroll
                for (int n = 0; n < 2; ++n) acc[a][b][m][n] = (f32x4){0.f, 0.f, 0.f, 0.f};
    bf16x8 At[4][2], B0[2][2], B1[2][2];
    const char* cA = (const char*)g.A + (GATHER ? (size_t)0 : (size_t)cur.pm * tstep); const char* cB = (const char*)g.Bt + (size_t)cur.pn * tstep;
    PG8_GIDX(curA, cur);
    S.a_ready(cur);
    if constexpr (SP2) {
        PG8_STAGE(PG8_SB(0, 0), cB, voffB); PG8_STAGE(PG8_SB(0, 1), cB + hstep, voffB); PG8_STAGE_A(PG8_SA(0, 0), cA, 0, false); PG8_STAGE_A(PG8_SA(0, 1), cA, 1, false);
        if (wr == 1) PG8_BAR;
        PG8_WAIT_V(2); PG8_BAR;
        PG8_STAGE(PG8_SB(1, 0), cB + kstep, voffB); PG8_STAGE_A(PG8_SA(1, 0), cA + kstep, 0, false); PG8_STAGE(PG8_SB(1, 1), cB + hstep + kstep, voffB);
        PG8_WAIT_V(6); PG8_BAR;
    } else {
        PG8_STAGE(PG8_SB(0, 0), cB, voffB); PG8_STAGE_A(PG8_SA(0, 0), cA, 0, false); PG8_STAGE(PG8_SB(0, 1), cB + hstep, voffB); PG8_STAGE_A(PG8_SA(0, 1), cA, 1, false);
        if (wr == 1) PG8_BAR;
        PG8_WAIT_V(4); PG8_BAR;
        PG8_STAGE(PG8_SB(1, 0), cB + kstep, voffB); PG8_STAGE_A(PG8_SA(1, 0), cA + kstep, 0, false); PG8_STAGE(PG8_SB(1, 1), cB + hstep + kstep, voffB);
        PG8_WAIT_V(6); PG8_BAR;
    }
    for (;;) {
        const bool has_next = S.next(ui + 1, nxt);
        if (has_next) PG8_GIDX(nxtA, nxt); else { if constexpr (GATHER) { _Pragma("unroll") for (int h_ = 0; h_ < 2; ++h_) _Pragma("unroll") for (int i_ = 0; i_ < 2; ++i_) nxtA[h_][i_] = curA[h_][i_]; } }
        const char* nA = GATHER ? (const char*)g.A : (has_next ? (const char*)g.A + (size_t)nxt.pm * tstep : cA); const char* nB = has_next ? (const char*)g.Bt + (size_t)nxt.pn * tstep : cB;
#pragma unroll 1
        for (int t = 0; t < nt; t += 2) {
            const bool last = (t == nt - 2);
            const char* a1 = cA + (size_t)(t + 1) * kstep;
            const char* a2 = last ? nA : cA + (size_t)(t + 2) * kstep; const char* b2 = last ? nB : cB + (size_t)(t + 2) * kstep;
            const char* a3 = a2 + kstep; const char* b3 = b2 + kstep;
            if (last && has_next) S.a_ready(nxt);
            if constexpr (SP2) {
            PG8_LDB(B0, 0, 0); PG8_LDB(B1, 0, 1); PG8_SCHED; PG8_LDA(At, 0, 0); PG8_STAGE_A(PG8_SA(1, 1), a1, 1, false);
            PG8_WAIT_V(8); PG8_WAIT_L(0); PG8_BAR; PG8_MMA(0, 0, At, B0); PG8_MMA(0, 1, At, B1); PG8_BAR; PG8_SCHED;
            PG8_LDA(At, 0, 1); PG8_STAGE(PG8_SB(0, 0), b2, voffB); PG8_STAGE(PG8_SB(0, 1), b2 + hstep, voffB); PG8_STAGE_A(PG8_SA(0, 0), a2, 0, last);
            PG8_WAIT_V(8); PG8_WAIT_L(0); PG8_BAR; PG8_MMA(1, 0, At, B0); PG8_MMA(1, 1, At, B1); PG8_BAR; PG8_SCHED;
            PG8_LDB(B0, 1, 0); PG8_LDB(B1, 1, 1); PG8_SCHED; PG8_LDA(At, 1, 0); PG8_STAGE_A(PG8_SA(0, 1), a2, 1, last);
            PG8_WAIT_V(8); PG8_WAIT_L(0); PG8_BAR; PG8_MMA(0, 0, At, B0); PG8_MMA(0, 1, At, B1); PG8_BAR; PG8_SCHED;
            PG8_LDA(At, 1, 1); PG8_STAGE(PG8_SB(1, 0), b3, voffB); PG8_STAGE(PG8_SB(1, 1), b3 + hstep, voffB); PG8_STAGE_A(PG8_SA(1, 0), a3, 0, last);
            PG8_WAIT_V(8); PG8_WAIT_L(0); PG8_BAR; PG8_MMA(1, 0, At, B0); PG8_MMA(1, 1, At, B1); PG8_BAR; PG8_SCHED;
            } else {
            PG8_LDB(B0, 0, 0); PG8_SCHED; PG8_LDA(At, 0, 0); PG8_STAGE_A(PG8_SA(1, 1), a1, 1, false);
            PG8_WAIT_L(8); PG8_BAR; PG8_WAIT_L(0); PG8_MMA(0, 0, At, B0); PG8_BAR; PG8_SCHED;
            PG8_LDB(B1, 0, 1); PG8_STAGE(PG8_SB(0, 0), b2, voffB);
            PG8_BAR; PG8_WAIT_L(0); PG8_MMA(0, 1, At, B1); PG8_BAR;
            PG8_LDA(At, 0, 1); PG8_STAGE_A(PG8_SA(0, 0), a2, 0, last);
            PG8_BAR; PG8_WAIT_L(0); PG8_MMA(1, 0, At, B0); PG8_BAR; PG8_SCHED;
            PG8_STAGE(PG8_SB(0, 1), b2 + hstep, voffB);
            PG8_WAIT_V(6); PG8_BAR; PG8_MMA(1, 1, At, B1); PG8_BAR;
            PG8_LDB(B0, 1, 0); PG8_SCHED; PG8_LDA(At, 1, 0); PG8_STAGE_A(PG8_SA(0, 1), a2, 1, last);
            PG8_WAIT_L(8); PG8_BAR; PG8_WAIT_L(0); PG8_MMA(0, 0, At, B0); PG8_BAR; PG8_SCHED;
            PG8_LDB(B1, 1, 1); PG8_STAGE(PG8_SB(1, 0), b3, voffB);
            PG8_BAR; PG8_WAIT_L(0); PG8_MMA(0, 1, At, B1); PG8_BAR;
            PG8_LDA(At, 1, 1); PG8_STAGE_A(PG8_SA(1, 0), a3, 0, last);
            PG8_BAR; PG8_WAIT_L(0); PG8_MMA(1, 0, At, B0); PG8_BAR; PG8_SCHED;
            PG8_STAGE(PG8_SB(1, 1), b3 + hstep, voffB);
            PG8_WAIT_V(6); PG8_BAR; PG8_MMA(1, 1, At, B1); PG8_BAR;
            }
        }
        if constexpr (ALIGN_EPI) { if (wr == 0) PG8_BAR; }
        if constexpr (!Epi::AFTER_DRAIN) { E(acc, cur, wr, wc, fr, fq); S.done(cur); }
        if (!has_next) break;
#pragma unroll
        for (int a = 0; a < 2; ++a)
#pragma unroll
            for (int b = 0; b < 2; ++b)
#pragma unroll
                for (int m = 0; m < 4; ++m)
#pragma unroll
                    for (int n = 0; n < 2; ++n) acc[a][b][m][n] = (f32x4){0.f, 0.f, 0.f, 0.f};
        cur = nxt; cA = nA; cB = nB; ++ui;
        if constexpr (GATHER) { _Pragma("unroll") for (int h_ = 0; h_ < 2; ++h_) _Pragma("unroll") for (int i_ = 0; i_ < 2; ++i_) curA[h_][i_] = nxtA[h_][i_]; }
        if constexpr (ALIGN_EPI) { if (wr == 1) PG8_BAR; }
    }
    PG8_WAIT_V(0);
    if constexpr (!ALIGN_EPI) { if (wr == 0) PG8_BAR; }
    PG8_BAR;
    if constexpr (Epi::AFTER_DRAIN) { E.fused(acc, cur, wr, wc, fr, fq, lds, wid, lane); S.done(cur); }
#undef PG8_SA
#undef PG8_SB
#undef PG8_STAGE
#undef PG8_STAGE_A
#undef PG8_GIDX
#undef PG8_LDA
#undef PG8_LDB
#undef PG8_MMA
#undef PG8_WAIT_V
#undef PG8_WAIT_L
#undef PG8_BAR
#undef PG8_SCHED
}
}
namespace att {
using bf16 = unsigned short;
using i32x8 = __attribute__((ext_vector_type(8))) int;
using i32x4 = __attribute__((ext_vector_type(4))) int;
using f32x16 = __attribute__((ext_vector_type(16))) float;
using u32x4  = __attribute__((ext_vector_type(4))) unsigned;
using f32x2 = __attribute__((ext_vector_type(2))) float;
constexpr int NW = 8, QBLK = 32, KVBLK = 64;
constexpr float SCALE = 0.07216878364870322f;
constexpr float QSCALE = SCALE * 1.4426950408889634f;
constexpr float QFP8 = 4.f, KFP8 = 0.25f;
constexpr float CSH = 5.f;
constexpr float THR2 = 3.5f;
constexpr int LDQ = 768, LDO = 1024;
constexpr int SHM_V = 128 * 64, SHM_K = KVBLK * 128, SHM_KR = KVBLK * 64;
constexpr int STAGE = SHM_V + SHM_K + SHM_KR  , NSLOT = 4, SL_K = SHM_V, SL_KR = SHM_V + SHM_K;
constexpr int OFF_WS = NSLOT * STAGE, SHM_ATTN = OFF_WS + NW * 64 * 4;
#define SBAR() do {} while (0)
__device__ __forceinline__ int crow(int r, int hi) { return (r & 3) + 8 * (r >> 2) + 4 * hi; }
__device__ __forceinline__ int pk4f8(float a, float b, float c, float d) { int w = __builtin_amdgcn_cvt_pk_fp8_f32(a, b, 0, false); return __builtin_amdgcn_cvt_pk_fp8_f32(c, d, w, true); }
__device__ __forceinline__ i32x8 mk8(i32x4 lo, i32x4 hi) { return (i32x8){lo[0], lo[1], lo[2], lo[3], hi[0], hi[1], hi[2], hi[3]}; }
#define MX_(A, B, C) __builtin_amdgcn_mfma_scale_f32_32x32x64_f8f6f4(A, B, C, 0, 0, 0, 0, 0, 0)
#define LD8_(base, a0, a1, off) mk8(*reinterpret_cast<const i32x4*>((base) + (a0) + (off)), *reinterpret_cast<const i32x4*>((base) + (a1) + (off)))
#define SPLAT_(x) (f32x16){x, x, x, x, x, x, x, x, x, x, x, x, x, x, x, x}
__device__ __forceinline__ void qkt(f32x16& p0, f32x16& p1, const char* Ks, const char* KRs, const i32x8* qr, const int (&ka)[4], const int (&ra)[2], float ninit) {
  p0 = SPLAT_(ninit); p1 = p0;
  { const i32x8 b0 = LD8_(Ks, ka[0], ka[1], 0), b1 = LD8_(Ks, ka[0], ka[1], 4096); p0 = MX_(b0, qr[0], p0); p1 = MX_(b1, qr[0], p1); }
  { const i32x8 b0 = LD8_(Ks, ka[2], ka[3], 0), b1 = LD8_(Ks, ka[2], ka[3], 4096); p0 = MX_(b0, qr[1], p0); p1 = MX_(b1, qr[1], p1); }
  { const i32x8 b0 = LD8_(KRs, ra[0], ra[1], 0), b1 = LD8_(KRs, ra[0], ra[1], 2048); p0 = MX_(b0, qr[2], p0); p1 = MX_(b1, qr[2], p1); }
}
__device__ __forceinline__ void partialSM_first(f32x16& p0, f32x16& p1, float& m_reg, float& alpha) {
  float pmax = p0[0]; for (int r = 1; r < 16; ++r) pmax = fmaxf(pmax, p0[r]); for (int r = 0; r < 16; ++r) pmax = fmaxf(pmax, p1[r]);
  { auto rr = __builtin_amdgcn_permlane32_swap(__float_as_uint(pmax), __float_as_uint(pmax), false, false);
    pmax = fmaxf(__uint_as_float(rr[0]), __uint_as_float(rr[1])); }
  const float delta = (fabsf(pmax - CSH) <= THR2) ? 0.f : pmax - CSH; m_reg = delta; alpha = 1.f;
  if (__any(delta != 0.f)) { for (int r = 0; r < 16; ++r) p0[r] -= delta; for (int r = 0; r < 16; ++r) p1[r] -= delta; }
  for (int r = 0; r < 16; ++r) p0[r] = __builtin_amdgcn_exp2f(p0[r]);
}
#define PK8_(P, B) pk4f8(P[B], P[B + 1], P[B + 2], P[B + 3])
__device__ __forceinline__ void finishSM(f32x16& p0, f32x16& p1, float alpha, float& l_reg, i32x8& pa) {
  for (int r = 0; r < 16; ++r) p1[r] = __builtin_amdgcn_exp2f(p1[r]);
  float ps = 0; for (int r = 0; r < 16; ++r) ps += p0[r]; for (int r = 0; r < 16; ++r) ps += p1[r];
  { auto rr = __builtin_amdgcn_permlane32_swap(__float_as_uint(ps), __float_as_uint(ps), false, false);
    ps = __uint_as_float(rr[0]) + __uint_as_float(rr[1]); }
  l_reg = l_reg * alpha + ps;
  pa = (i32x8){PK8_(p0, 0), PK8_(p0, 4), PK8_(p0, 8), PK8_(p0, 12), PK8_(p1, 0), PK8_(p1, 4), PK8_(p1, 8), PK8_(p1, 12)};
}
__device__ __forceinline__ void pv_d0(f32x16* o, const char* Vs, const int (&va)[2], i32x8 pa) {
#pragma unroll
  for (int d = 0; d < 4; ++d) { const i32x8 v = LD8_(Vs, va[0], va[1], d * 2048); o[d] = MX_(pa, v, o[d]); }
}
#define EX_(i) p1[i] = __builtin_amdgcn_exp2f(p1[i])
#define P2_(P, B) (f32x2){P[B], P[B + 1]}
template <int ABL> __device__ __forceinline__ void qk_fin(f32x16& n0, f32x16& n1, const char* Ks, const char* KRs, const i32x8* qr, const int (&ka)[4], const int (&ra)[2], float ninit,
                                       f32x16& p0, f32x16& p1, float alpha, float& l_reg, i32x8& pa) {
  i32x8 e0, e1, f0, f1; f32x2 s2 = {0.f, 0.f}; int c0 = 0, c1 = 0, c2 = 0, c3 = 0, c4 = 0, c5 = 0, c6 = 0, c7 = 0;
  SBAR();
  e0 = LD8_(Ks, ka[0], ka[1], 0); e1 = LD8_(Ks, ka[0], ka[1], 4096);
  f0 = LD8_(Ks, ka[2], ka[3], 0); f1 = LD8_(Ks, ka[2], ka[3], 4096);
  n0 = SPLAT_(ninit); n1 = n0;
  n0 = MX_(e0, qr[0], n0); n1 = MX_(e1, qr[0], n1);
  if constexpr (!(ABL & 1)) { EX_(0); EX_(1); EX_(2); EX_(3); EX_(4); EX_(5);
    s2 = P2_(p0, 0) + P2_(p0, 2); s2 += P2_(p0, 4); s2 += P2_(p0, 6); s2 += P2_(p0, 8); s2 += P2_(p0, 10); s2 += P2_(p0, 12); s2 += P2_(p0, 14);
    c0 = PK8_(p0, 0); c1 = PK8_(p0, 4); }
  SBAR();
  e0 = LD8_(KRs, ra[0], ra[1], 0); e1 = LD8_(KRs, ra[0], ra[1], 2048);
  n0 = MX_(f0, qr[1], n0); n1 = MX_(f1, qr[1], n1);
  if constexpr (!(ABL & 1)) { EX_(6); EX_(7); EX_(8); EX_(9); EX_(10); EX_(11);
    s2 += P2_(p1, 0); s2 += P2_(p1, 2); s2 += P2_(p1, 4); c2 = PK8_(p0, 8); c3 = PK8_(p0, 12); c4 = PK8_(p1, 0); }
  SBAR();
  n0 = MX_(e0, qr[2], n0); n1 = MX_(e1, qr[2], n1);
  if constexpr (!(ABL & 1)) { EX_(12); EX_(13); EX_(14); EX_(15);
    s2 += P2_(p1, 6); s2 += P2_(p1, 8); s2 += P2_(p1, 10); s2 += P2_(p1, 12); s2 += P2_(p1, 14); c5 = PK8_(p1, 4); c6 = PK8_(p1, 8); c7 = PK8_(p1, 12);
    float ps = s2[0] + s2[1];
    { auto rr = __builtin_amdgcn_permlane32_swap(__float_as_uint(ps), __float_as_uint(ps), false, false); ps = __uint_as_float(rr[0]) + __uint_as_float(rr[1]); }
    l_reg = l_reg * alpha + ps;
    pa = (i32x8){c0, c1, c2, c3, c4, c5, c6, c7}; }
  SBAR();
  if constexpr (ABL & 1) { asm volatile("" :: "v"(n0), "v"(n1)); }
}
#define WAITL_() do { asm volatile("s_waitcnt lgkmcnt(0)" ::: "memory"); SBAR(); } while (0)
template <int ABL> __device__ __forceinline__ void pv_par(f32x16* o, const char* Vs, const int (&va)[2], i32x8 pa, f32x16& n0, f32x16& n1, float& m_reg, float& alpha) {
  i32x8 A, B;
  SBAR();
  A = LD8_(Vs, va[0], va[1], 0);
  float pmax = n0[0];
  if constexpr (!(ABL & 1)) {
#pragma unroll
  for (int r = 1; r < 16; ++r) pmax = fmaxf(pmax, n0[r]);
#pragma unroll
  for (int r = 0; r < 16; ++r) pmax = fmaxf(pmax, n1[r]);
  }
  WAITL_();
  B = LD8_(Vs, va[0], va[1], 2048); o[0] = MX_(pa, A, o[0]);
  float delta = 0.f; bool adj = false; alpha = 1.f;
  if constexpr (!(ABL & 1)) {
  { auto rr = __builtin_amdgcn_permlane32_swap(__float_as_uint(pmax), __float_as_uint(pmax), false, false); pmax = fmaxf(__uint_as_float(rr[0]), __uint_as_float(rr[1])); }
  if (__builtin_expect(!__all(pmax <= CSH + THR2), 0)) { delta = fmaxf(pmax - CSH, 0.f); alpha = __builtin_amdgcn_exp2f(-delta); m_reg += delta; adj = true; }
  }
  WAITL_();
  A = LD8_(Vs, va[0], va[1], 4096); o[1] = MX_(pa, B, o[1]);
  if constexpr (!(ABL & 1)) { if (adj) {
#pragma unroll
  for (int r = 0; r < 16; ++r) n0[r] -= delta;
  } }
  WAITL_();
  B = LD8_(Vs, va[0], va[1], 6144); o[2] = MX_(pa, A, o[2]);
  if constexpr (!(ABL & 1)) { if (adj) {
#pragma unroll
  for (int r = 0; r < 16; ++r) n1[r] -= delta;
  } }
  WAITL_();
  o[3] = MX_(pa, B, o[3]);
  if constexpr (!(ABL & 1)) {
#pragma unroll
  for (int r = 0; r < 16; ++r) n0[r] = __builtin_amdgcn_exp2f(n0[r]);
  }
  SBAR();
}
__device__ __forceinline__ void glds16(const void* gsrc, unsigned lds_dst) { unsigned keep;
  asm volatile("s_mov_b32 %0, m0\n\ts_mov_b32 m0, %2\n\ts_nop 0\n\tglobal_load_lds_dwordx4 %1, off\n\ts_mov_b32 m0, %0" : "=&s"(keep) : "v"(gsrc), "s"(lds_dst) : "memory"); }
#define WAIT_BAR_ALL() asm volatile("s_waitcnt vmcnt(0) lgkmcnt(0)\n\ts_barrier" ::: "memory")
template <int SDEPTH, int ABL = 0>
__device__ __forceinline__ void attn_body(const unsigned char* Qb, const unsigned char* Kn, const unsigned char* Kr, const unsigned char* Vt, int vpitch, bf16* Ob, int seq, char* lds) {
  const int tid = otid(), wid = __builtin_amdgcn_readfirstlane(tid >> 6), lane = tid & 63, r32 = lane & 31, hi = lane >> 5;
  float* ws = (float*)(lds + OFF_WS) + wid * 64; float* li_l = ws; float* al_l = ws + 32;
  float m_reg = 0.f, l_reg = 0; f32x16 o[4] = {}; i32x8 qr[3];
  { const unsigned char* Qw = Qb + (long)(wid * QBLK + r32) * LDQ + hi * 32;
#pragma unroll
    for (int s = 0; s < 3; ++s) qr[s] = mk8(*reinterpret_cast<const i32x4*>(Qw + 64 * s), *reinterpret_cast<const i32x4*>(Qw + 64 * s + 16)); }
  int ka[4], ra[2], va[2];
#pragma unroll
  for (int q = 0; q < 4; ++q) ka[q] = r32 * 128 + (((4 * (q >> 1) + 2 * hi + (q & 1)) ^ ((r32 >> 1) & 7)) << 4);
#pragma unroll
  for (int q = 0; q < 2; ++q) { ra[q] = r32 * 64 + (((2 * hi + q) ^ ((r32 >> 2) & 3)) << 4); va[q] = ra[q]; }
  int okA, ovA, orA;
  { const int row = 8 * wid + (lane >> 3), c = (lane & 7) ^ ((row >> 1) & 7); okA = row * 128 + c * 16; }
  { const int row = 16 * wid + (lane >> 2), c = (lane & 3) ^ ((row >> 2) & 3); ovA = row * vpitch + c * 16; orA = row * 64 + c * 16; }
  const unsigned lds0 = (unsigned)(uintptr_t)lds;
#define DMA_TILE(k0, so) do { const unsigned d_ = (unsigned)__builtin_amdgcn_readfirstlane((int)(lds0 + (unsigned)(so) + (unsigned)wid * 1024u)); \
    glds16(Kn + (long)(k0) * 128 + okA, d_ + SL_K); glds16(Vt + (k0) + ovA, d_); if (wid < 4) glds16(Kr + (long)(k0) * 64 + orA, d_ + SL_KR); } while (0)
#define RESC(a) do { if (__any((a) < 1.f)) { if (hi == 0) al_l[r32] = (a); asm volatile("s_waitcnt lgkmcnt(0)" ::: "memory"); \
    for (int d = 0; d < 4; ++d) for (int r = 0; r < 16; ++r) o[d][r] *= al_l[crow(r, hi)]; } } while (0)
  f32x16 pA0, pA1, pB0, pB1; float alA, alB; i32x8 pa; const int NT = seq / KVBLK;
#define SLOT(t) (((t) & 3) * STAGE)
  const bool grpB = wid >= 4;
  DMA_TILE(0, 0); DMA_TILE(KVBLK, STAGE);
  WAIT_BAR_ALL();
  DMA_TILE(2 * KVBLK, 2 * STAGE);
  qkt(pA0, pA1, lds + SL_K, lds + SL_KR, qr, ka, ra, CSH); partialSM_first(pA0, pA1, m_reg, alA);
#define BARDMA(tn) do { if constexpr (!(ABL & 2)) { WAIT_BAR_ALL(); if ((tn) < NT) DMA_TILE((tn) * KVBLK, SLOT(tn)); } } while (0)
  for (int t = 0; t + 3 < NT; t += 2) {
    qk_fin<ABL>(pB0, pB1, lds + SLOT(t + 1) + SL_K, lds + SLOT(t + 1) + SL_KR, qr, ka, ra, CSH - m_reg, pA0, pA1, alA, l_reg, pa);
    if (grpB) BARDMA(t + 3);
    pv_par<ABL>(o, lds + SLOT(t), va, pa, pB0, pB1, m_reg, alB);
    RESC(alB); if (!grpB) BARDMA(t + 3);
    qk_fin<ABL>(pA0, pA1, lds + SLOT(t + 2) + SL_K, lds + SLOT(t + 2) + SL_KR, qr, ka, ra, CSH - m_reg, pB0, pB1, alB, l_reg, pa);
    if (grpB) BARDMA(t + 4);
    pv_par<ABL>(o, lds + SLOT(t + 1), va, pa, pA0, pA1, m_reg, alA);
    RESC(alA); if (!grpB) BARDMA(t + 4);
  }
  qk_fin<ABL>(pB0, pB1, lds + SLOT(NT - 1) + SL_K, lds + SLOT(NT - 1) + SL_KR, qr, ka, ra, CSH - m_reg, pA0, pA1, alA, l_reg, pa);
  pv_par<ABL>(o, lds + SLOT(NT - 2), va, pa, pB0, pB1, m_reg, alB);
  RESC(alB);
  finishSM(pB0, pB1, alB, l_reg, pa); SBAR();
  pv_d0(o, lds + SLOT(NT - 1), va, pa);
  if (hi == 0) li_l[r32] = l_reg; asm volatile("s_waitcnt lgkmcnt(0)" ::: "memory");
  float rli[16];
#pragma unroll
  for (int r = 0; r < 16; ++r) rli[r] = __builtin_amdgcn_rcpf(li_l[crow(r, hi)]);
  bf16* Ow = Ob + (long)(wid * QBLK) * LDO;
#pragma unroll
  for (int r = 0; r < 16; ++r) { int orow = crow(r, hi);
#pragma unroll
    for (int d0 = 0; d0 < 4; ++d0) { const float v = o[d0][r] * rli[r]; unsigned u = __float_as_uint(v); u = (u + 0x7fffu + ((u >> 16) & 1u)) >> 16; Ow[(long)orow * LDO + d0 * 32 + r32] = (bf16)u; } }
  asm volatile("s_waitcnt lgkmcnt(0)\n\ts_barrier" ::: "memory");
#undef DMA_TILE
#undef RESC
#undef SLOT
#undef BARDMA
}
#undef SBAR
}
#define LAS __attribute__((address_space(3)))
typedef unsigned short bf16_t;
typedef float v4f __attribute__((ext_vector_type(4)));
typedef float v2f __attribute__((ext_vector_type(2)));
typedef unsigned v4u __attribute__((ext_vector_type(4)));
typedef unsigned v2u __attribute__((ext_vector_type(2)));
typedef short s8v __attribute__((ext_vector_type(8)));
typedef float f16v __attribute__((ext_vector_type(16)));

constexpr int DM = 1024, SEQ = 16384, NCTX = 256, NR = SEQ + NCTX  , NCHUNK = NR / 128  ;
constexpr int INC = 1728, INP = 1792, QLR = 384, KVLR = 256, NHEAD = 4, NEXP = 16, FFD = 1024, CAP = 2048, CAPC = 32;
constexpr float EPSN = 1e-6f;
constexpr size_t MiB = 1u << 20;
constexpr size_t WS_CTL = 0, WS_MOD = 1 * MiB, WS_ROPE = WS_MOD + 128 * 1024, WS_SGUW = WS_MOD + 256 * 1024, WS_LRUW = WS_MOD + 512 * 1024, WS_WRH = WS_MOD + 768 * 1024, WS_WRL = WS_MOD + 832 * 1024;
constexpr size_t WS_CHS = 2 * MiB, WS_PROBT = 3 * MiB, WS_IDX = 5 * MiB, WS_IDXC = WS_IDX + 128 * 1024, WS_GATE = WS_IDX + 256 * 1024, WS_GATEC = WS_GATE + 128 * 1024, WS_INV = 6 * MiB;
constexpr size_t WS_WIN = 8 * MiB, WS_WUQ = 12 * MiB, WS_WUKV = 13 * MiB, WS_WOUT = 14 * MiB, WS_WGU = 16 * MiB, WS_WD = 80 * MiB;
constexpr size_t WS_XL = 112 * MiB, WS_H = 177 * MiB, WS_A = 210 * MiB;
constexpr size_t WS_PROJ = WS_A, WS_CQN = 267 * MiB, WS_CKVN = 280 * MiB, WS_Q = 289 * MiB, WS_KN = 314 * MiB, WS_V = 331 * MiB, WS_KR = 348 * MiB, WS_MIX = 351 * MiB, WS_HL = 384 * MiB, WS_ACUM = 417 * MiB;
constexpr size_t WS_XS = WS_A, WS_HID = 282 * MiB, WS_YE = 354 * MiB, WS_END = 450 * MiB;
static_assert(WS_PROJ + (size_t)NR * INP * 2 <= WS_CQN && WS_CQN + (size_t)NR * QLR * 2 <= WS_CKVN && WS_CKVN + (size_t)NR * KVLR * 2 <= WS_Q && WS_Q + (size_t)NR * 768 * 2 <= WS_KN, "ws map 1");
static_assert(WS_KN + (size_t)4 * NR * 128 * 2 <= WS_V && WS_V + (size_t)4 * NR * 128 * 2 <= WS_KR && WS_KR + (size_t)NR * 64 * 2 <= WS_MIX && WS_MIX + (size_t)NR * 1024 * 2 <= WS_HL, "ws map 2");
static_assert(WS_HL + (size_t)2 * NR * 256 * 4 <= WS_ACUM && WS_ACUM + (size_t)2 * NR * 256 * 4 <= WS_END, "ws map 3");
static_assert(WS_XS + (size_t)(128 + 16) * 256 * 1024 * 2 <= WS_HID && WS_HID + (size_t)144 * 256 * 1024 * 2 <= WS_YE && WS_YE + (size_t)144 * 256 * 1024 * 2 <= WS_END, "ws map 4");
static_assert(WS_XL + (size_t)NR * 1024 * 4 <= WS_H && WS_H + (size_t)NR * 1024 * 2 <= WS_A && WS_WGU + (size_t)16 * 2048 * 1024 * 2 <= WS_WD && WS_WD + (size_t)16 * 1024 * 1024 * 2 <= WS_XL, "ws map 5");
constexpr int LDS_BYTES = 163840;

struct Params {
    const float *x, *c, *ctx, *c_ctx, *norm1_g, *w_mod, *b_mod, *w_in, *sgu_w, *sgu_b, *conv_w, *conv_b, *lru_wa, *lru_ba, *lru_wx, *lru_bx, *lru_lambda,
                *q_norm_g, *w_uq, *kv_norm_g, *w_ukv, *w_out, *norm2_g, *w_router, *w_gate, *w_up, *w_down, *final_norm_g;
    float* out; unsigned char* ws;
};

__device__ __forceinline__ float bf2f(bf16_t v) { return __uint_as_float((unsigned)v << 16); }
__device__ __forceinline__ unsigned f2bf(float f) { unsigned u = __float_as_uint(f); return (u + 0x7fffu + ((u >> 16) & 1u)) >> 16; }
__device__ __forceinline__ unsigned pk2(float lo, float hi) { return f2bf(lo) | (f2bf(hi) << 16); }
__device__ __forceinline__ float wave_sum(float v) {
#pragma unroll
    for (int o = 1; o < 64; o <<= 1) v += __shfl_xor(v, o);
    return v;
}
__device__ __forceinline__ float gelu_tanh(float x) { const float u = 0.7978845608028654f * (x + 0.044715f * x * x * x); const float e = __expf(2.f * u); return x * (1.f - __builtin_amdgcn_rcpf(e + 1.f)); }
__device__ __forceinline__ float sigmoid_f(float x) { return __builtin_amdgcn_rcpf(1.f + __expf(-x)); }
__device__ __forceinline__ void lds_barrier() { asm volatile("s_waitcnt lgkmcnt(0)\n\ts_barrier" ::: "memory"); }
__device__ __forceinline__ int crow16(int r, int hi) { return (r & 3) + 8 * (r >> 2) + 4 * hi; }

__device__ __forceinline__ void sincos_d(double x, double& s, double& c) {
    const double kd = rint(x * 0.6366197723675814); const int k = (int)kd;
    double y = fma(-kd, 1.5707963267948966, x); y = fma(-kd, 6.123233995736766e-17, y);
    const double y2 = y * y;
    const double sp = y * (1.0 + y2 * (-1.0 / 6 + y2 * (1.0 / 120 + y2 * (-1.0 / 5040 + y2 * (1.0 / 362880 + y2 * (-1.0 / 39916800 + y2 * (1.0 / 6227020800.0)))))));
    const double cp = 1.0 + y2 * (-0.5 + y2 * (1.0 / 24 + y2 * (-1.0 / 720 + y2 * (1.0 / 40320 + y2 * (-1.0 / 3628800 + y2 * (1.0 / 479001600.0 + y2 * (-1.0 / 87178291200.0)))))));
    const int q = k & 3;
    s = (q == 0) ? sp : (q == 1) ? cp : (q == 2) ? -sp : -cp;
    c = (q == 0) ? cp : (q == 1) ? -sp : (q == 2) ? -cp : sp;
}

__device__ __forceinline__ void tr_item(const float* W, int K, int N, bf16_t* WT, int k0, int n0, long drow0, LAS float* scr, int lane) {
#pragma unroll 8
    for (int i = 0; i < 32; ++i) { const int kk = 2 * i + (lane >> 5); scr[kk * 33 + (lane & 31)] = W[(size_t)(k0 + kk) * N + n0 + (lane & 31)]; }
    asm volatile("s_waitcnt lgkmcnt(0)" ::: "memory");
    const int c = lane & 7;
#pragma unroll
    for (int j = 0; j < 4; ++j) { const int n = (lane >> 3) + 8 * j; const LAS float* s = scr + (8 * c) * 33 + n;
        v4u o; o.x = pk2(s[0 * 33], s[1 * 33]); o.y = pk2(s[2 * 33], s[3 * 33]); o.z = pk2(s[4 * 33], s[5 * 33]); o.w = pk2(s[6 * 33], s[7 * 33]);
        *(v4u*)(WT + (size_t)(drow0 + n) * K + k0 + 8 * c) = o; }
    asm volatile("s_waitcnt lgkmcnt(0)" ::: "memory");
}
struct CvtItem { const float* W; bf16_t* WT; int K, N, k0, n0; long drow0, drow_mul; int kvs; };
__device__ __forceinline__ bool cvt_item(const Params& P, int l, int it, CvtItem& c) {
    unsigned char* ws = P.ws;
    constexpr int I_IN = 8 * 7, I_UQ = 3 * 3, I_UKV = 2 * 4, I_OUT = 8 * 4, I_E = 16 * 32;
    c.drow0 = 0; c.drow_mul = 128; c.kvs = 0;
    if (it < I_IN) { c.W = P.w_in + (size_t)l * 1024 * INC; c.WT = (bf16_t*)(ws + WS_WIN); c.K = 1024; c.N = INC; c.k0 = (it / 7) * 128; c.n0 = (it % 7) * 256; return true; } it -= I_IN;
    if (it < I_UQ) { c.W = P.w_uq + (size_t)l * QLR * 768; c.WT = (bf16_t*)(ws + WS_WUQ); c.K = QLR; c.N = 768; c.k0 = (it / 3) * 128; c.n0 = (it % 3) * 256; return true; } it -= I_UQ;
    if (it < I_UKV) { c.W = P.w_ukv + (size_t)l * KVLR * 1024; c.WT = (bf16_t*)(ws + WS_WUKV); c.K = KVLR; c.N = 1024; c.k0 = (it / 4) * 128; c.n0 = (it % 4) * 256; c.kvs = 1; return true; } it -= I_UKV;
    if (it < I_OUT) { c.W = P.w_out + (size_t)l * 1024 * 1024; c.WT = (bf16_t*)(ws + WS_WOUT); c.K = 1024; c.N = 1024; c.k0 = (it / 4) * 128; c.n0 = (it % 4) * 256; return true; } it -= I_OUT;
    if (it >= 3 * I_E) return false;
    const int mat = it / I_E, q = it % I_E, e = q / 32, w = q % 32; const size_t eoff = ((size_t)l * 16 + e) * 1024 * 1024;
    c.K = 1024; c.N = 1024; c.k0 = (w / 4) * 128; c.n0 = (w % 4) * 256;
    if (mat == 0)      { c.W = P.w_gate + eoff; c.WT = (bf16_t*)(ws + WS_WGU); c.drow0 = (long)e * 2048; c.drow_mul = 256; }
    else if (mat == 1) { c.W = P.w_up + eoff;   c.WT = (bf16_t*)(ws + WS_WGU); c.drow0 = (long)e * 2048 + 128; c.drow_mul = 256; }
    else               { c.W = P.w_down + eoff; c.WT = (bf16_t*)(ws + WS_WD);  c.drow0 = (long)e * 1024; }
    return true;
}
__device__ __forceinline__ void convert_weights(const Params& P, LAS unsigned char* lds, int l, int vcu, int G) {
    const int tid = otid(), lane = tid & 63, wave = __builtin_amdgcn_readfirstlane(tid >> 6);
    LAS unsigned* img = (LAS unsigned*)lds;
    CvtItem c; int it = vcu; bool have = cvt_item(P, l, it, c);
    v4f v[16];
#define CVT_LOAD() do { const bool ok_ = c.n0 + 4 * lane < c.N; const float* src_ = c.W + (size_t)(c.k0 + wave * 16) * c.N + c.n0 + 4 * lane; \
    _Pragma("unroll") for (int i_ = 0; i_ < 16; ++i_) v[i_] = ok_ ? *(const v4f*)(src_ + (size_t)i_ * c.N) : (v4f){0.f, 0.f, 0.f, 0.f}; } while (0)
    if (have) CVT_LOAD();
    while (have) {
#pragma unroll
        for (int i = 0; i < 8; ++i)
#pragma unroll
            for (int j = 0; j < 4; ++j) img[(4 * lane + j) * 65 + wave * 8 + i] = pk2(v[2 * i][j], v[2 * i + 1][j]);
        __syncthreads();
        const CvtItem cur = c; it += G; have = cvt_item(P, l, it, c);
        if (have) CVT_LOAD();
#pragma unroll
        for (int rr = 0; rr < 8; ++rr) { const int n = (wave * 8 + rr) * 4 + (lane >> 4), ch = lane & 15;
            const LAS unsigned* s = img + n * 65 + 4 * ch; v4u o; o.x = s[0]; o.y = s[1]; o.z = s[2]; o.w = s[3];
            if (cur.n0 + n < cur.N) { const int ng = cur.n0 + n; const long dr = cur.kvs ? (long)(((ng >> 7) & 1) * 512 + (ng >> 8) * 128 + (ng & 127)) : cur.drow0 + (ng >> 7) * cur.drow_mul + (ng & 127);
                *(v4u*)(cur.WT + (size_t)dr * cur.K + cur.k0 + 8 * ch) = o; } }
        __syncthreads();
    }
#undef CVT_LOAD
    unsigned char* ws = P.ws; LAS float* scr = (LAS float*)(lds + wave * 16384);
    for (int it3 = vcu * 8 + wave; it3 < 64; it3 += G * 8) {
        const int e = it3 >> 1, k0 = (it3 & 1) * 512; bf16_t* wh = (bf16_t*)(ws + WS_WRH) + (size_t)e * 1024 + k0; bf16_t* wl = (bf16_t*)(ws + WS_WRL) + (size_t)e * 1024 + k0;
#pragma unroll
        for (int i = 0; i < 8; ++i) { const int k = 64 * i + lane; float w = 0.f; if (e < 16) w = P.w_router[((size_t)l * 1024 + k0 + k) * 16 + e];
            const unsigned h = f2bf(w); wh[k] = (bf16_t)h; wl[k] = (bf16_t)f2bf(w - __uint_as_float(h << 16)); } }
    for (int it2 = vcu * 8 + wave; it2 < 64 + 64 + 32; it2 += G * 8) {
        if (it2 < 64) { v4u z = {0u, 0u, 0u, 0u}; bf16_t* p = (bf16_t*)(ws + WS_WIN) + (size_t)(INC + it2) * 1024; *(v4u*)(p + lane * 8) = z; *(v4u*)(p + 512 + lane * 8) = z; }
        else if (it2 < 128) { const int pc = it2 - 64; const float* s = P.sgu_w + (size_t)l * 65536 + pc * 1024; bf16_t* d = (bf16_t*)(ws + WS_SGUW) + pc * 1024;
#pragma unroll
            for (int j = 0; j < 4; ++j) { const v4f x = *(const v4f*)(s + 256 * j + 4 * lane); v2u o; o.x = pk2(x[0], x[1]); o.y = pk2(x[2], x[3]); *(v2u*)(d + 256 * j + 4 * lane) = o; } }
        else { const int q = it2 - 128, mi = q >> 1, half = q & 1, d = mi >> 3, m = (mi >> 2) & 1, nb = mi & 3;
            const float* W = (m ? P.lru_wx : P.lru_wa) + (((size_t)l * 2 + d) * 4 + nb) * 4096;
            tr_item(W, 64, 64, (bf16_t*)(ws + WS_LRUW), 0, half * 32, (long)mi * 64 + half * 32, scr, lane); }
    }
}
#define GAS __attribute__((address_space(1)))
typedef GAS unsigned gu32;
#define XB_TMO      128
#define XB_XCNT(j)  (256  + 64 * (j))
#define XB_XSUB(j)  (1280 + 64 * (j))
#define XB_XGEN(j)  (2304 + 64 * (j))
#define XB_TOP      3328
#define XB_TOPGEN   3392
#define XCD_BAR_WORDS 3456
#define XB_SPIN_CAP (1u << 18)

__device__ __forceinline__ unsigned xb_ld(unsigned* p)              { return __hip_atomic_load(p, __ATOMIC_RELAXED, __HIP_MEMORY_SCOPE_AGENT); }
__device__ __forceinline__ unsigned xb_add(unsigned* p, unsigned v) { return __hip_atomic_fetch_add(p, v, __ATOMIC_RELAXED, __HIP_MEMORY_SCOPE_AGENT); }
__device__ __forceinline__ unsigned xb_xcc_id() { return (unsigned)__builtin_amdgcn_s_getreg((3 << 11) | 20) & 0xFu; }
#define XB_SPIN(cond, bar) do { unsigned _sp = 0; while (cond) { __builtin_amdgcn_s_sleep(1); \
    if ((++_sp & 255u) == 0u) { if (xb_ld(&(bar)[XB_TMO])) break; if (_sp > XB_SPIN_CAP) { atomicAdd(&(bar)[XB_TMO], 1u); break; } } } } while (0)

struct XcdBarrier {
    unsigned* bar; unsigned x;
    volatile LAS unsigned* st;
};

__device__ __forceinline__ XcdBarrier xcd_barrier_post(unsigned* bar, volatile LAS unsigned* st) {
    XcdBarrier b; b.bar = bar; b.x = xb_xcc_id(); b.st = st;
    if (otid() == 0) (void)xb_add(&bar[XB_XCNT(b.x)], 1u);
    return b;
}
__device__ __forceinline__ void xcd_barrier_complete(unsigned* bar, unsigned x, unsigned& nloc, unsigned& nx) {
    const unsigned G = gridDim.x * gridDim.y * gridDim.z;
    unsigned sum, cnt, mine, sp = 0u;
    for (;;) {
        sum = 0u; cnt = 0u; mine = 0u;
#pragma unroll
        for (unsigned j = 0; j < 16; ++j) { const unsigned c = xb_ld(&bar[XB_XCNT(j)]); sum += c; cnt += (c > 0u) ? 1u : 0u; mine = (j == x) ? c : mine; }
        if (sum == G) break;
        __builtin_amdgcn_s_sleep(1);
        if ((++sp & 255u) == 0u) { if (xb_ld(&bar[XB_TMO])) break; if (sp > XB_SPIN_CAP) { atomicAdd(&bar[XB_TMO], 1u); break; } }
    }
    nloc = mine > 0u ? mine : 1u; nx = cnt > 0u ? cnt : 1u;
}

__device__ __forceinline__ void xcd_barrier(const XcdBarrier& b) {
    asm volatile("s_waitcnt vmcnt(0)" ::: "memory");
    __syncthreads();
    if (otid() == 0) {
        unsigned* bar = b.bar;
        __builtin_amdgcn_s_waitcnt(0);
        unsigned nloc = b.st[0], nx = b.st[1];
        if (nloc == 0u) { xcd_barrier_complete(bar, b.x, nloc, nx); b.st[0] = nloc; b.st[1] = nx; }
        const unsigned old = xb_add(&bar[XB_XSUB(b.x)], 1u);
        const unsigned gen = old / nloc;
        if (old + 1u == (gen + 1u) * nloc) {
            __builtin_amdgcn_fence(__ATOMIC_RELEASE, "agent");
            asm volatile("s_waitcnt vmcnt(0)" ::: "memory");
            const unsigned og = xb_add(&bar[XB_TOP], 1u);
            const unsigned tg = og / nx;
            if (og + 1u == (tg + 1u) * nx) xb_add(&bar[XB_TOPGEN], 1u);
            else XB_SPIN(xb_ld(&bar[XB_TOPGEN]) == tg, bar);
            __builtin_amdgcn_fence(__ATOMIC_ACQUIRE, "agent");
            xb_add(&bar[XB_XGEN(b.x)], 1u);
            asm volatile("s_waitcnt vmcnt(0)" ::: "memory");
        } else {
            XB_SPIN(xb_ld(&bar[XB_XGEN(b.x)]) == gen, bar);
            __builtin_amdgcn_fence(__ATOMIC_ACQUIRE, "agent");
            asm volatile("s_waitcnt vmcnt(0)" ::: "memory");
        }
    }
    __syncthreads();
}
__device__ __forceinline__ void row_norm_mod_bf16(const float* xrow, const float* g, const float* sh, const float* sc, bf16_t* orow, int lane) {
    v4f v[4]; float ss = 0.f;
#pragma unroll
    for (int j = 0; j < 4; ++j) { v[j] = *(const v4f*)(xrow + 256 * j + 4 * lane); ss += (v[j][0] * v[j][0] + v[j][1] * v[j][1]) + (v[j][2] * v[j][2] + v[j][3] * v[j][3]); }
    const float rstd = 1.0f / sqrtf(wave_sum(ss) * (1.0f / 1024.0f) + EPSN);
#pragma unroll
    for (int j = 0; j < 4; ++j) { const int c = 256 * j + 4 * lane; const v4f gv = *(const v4f*)(g + c), shv = *(const v4f*)(sh + c), scv = *(const v4f*)(sc + c);
        const v4f y = ((v[j] * rstd) * gv) * (1.0f + scv) + shv; v2u o; o.x = pk2(y[0], y[1]); o.y = pk2(y[2], y[3]); *(v2u*)(orow + c) = o; }
}

__device__ __forceinline__ void phase0(const Params& P, LAS unsigned char* lds, int vcu, int G) {
    const int tid = otid(), lane = tid & 63, wave = tid >> 6;
    float* MOD = (float*)(P.ws + WS_MOD);
    if (vcu < 192) {
        LAS float* sv = (LAS float*)(lds + 131072); LAS float* red = (LAS float*)(lds + 131072 + 8192);
        for (int i = tid; i < 1024; i += 512) { const float a = P.c[i], b = P.c_ctx[i]; sv[i] = a / (1.f + expf(-a)); sv[1024 + i] = b / (1.f + expf(-b)); }
        __syncthreads();
        for (int it = vcu; it < 192; it += G) {
            const int l = it / 96, cg = it % 96; const float* W = P.w_mod + (size_t)l * 1024 * 6144 + cg * 64 + lane;
            float al = 0.f, ac = 0.f; const int k0 = wave * 128;
            for (int kb = 0; kb < 128; kb += 32) { float wv[32];
#pragma unroll
                for (int k = 0; k < 32; ++k) wv[k] = W[(size_t)(k0 + kb + k) * 6144];
#pragma unroll
                for (int k = 0; k < 32; ++k) { al += sv[k0 + kb + k] * wv[k]; ac += sv[1024 + k0 + kb + k] * wv[k]; } }
            red[(wave * 2 + 0) * 64 + lane] = al; red[(wave * 2 + 1) * 64 + lane] = ac;
            __syncthreads();
            if (wave < 2) { float s = 0.f;
#pragma unroll
                for (int w8 = 0; w8 < 8; ++w8) s += red[(w8 * 2 + wave) * 64 + lane];
                const int col = cg * 64 + lane; MOD[(l * 2 + wave) * 6144 + col] = s + P.b_mod[l * 6144 + col]; }
            __syncthreads();
        }
    }
    if (vcu == G - 1) {
        float* cosT = (float*)(P.ws + WS_ROPE); float* sinT = cosT + 4096;
        for (int i = tid; i < 4096; i += 512) { const int p = i >> 4, f = i & 15; const float inv = exp2f(-(float)f * (13.287712379549449f / 16.0f)); const float ang = (float)p * inv;
            double s, c; sincos_d((double)ang, s, c); cosT[i] = (float)c; sinT[i] = (float)s; }
    }
    convert_weights(P, lds, 0, vcu, G);
}
__device__ __forceinline__ void phase_norm1_l0(const Params& P, int gw, int NGW) {
    const int lane = otid() & 63; const float* MOD = (const float*)(P.ws + WS_MOD); bf16_t* H = (bf16_t*)(P.ws + WS_H);
    for (int r0 = gw; r0 < NR; r0 += 2 * NGW) {
        v4f v[2][4]; float ss[2];
#pragma unroll
        for (int u = 0; u < 2; ++u) { const int r = (r0 + u * NGW < NR) ? r0 + u * NGW : r0; const float* src = r < NCTX ? P.ctx + (size_t)r * 1024 : P.x + (size_t)(r - NCTX) * 1024; ss[u] = 0.f;
#pragma unroll
            for (int j = 0; j < 4; ++j) { v[u][j] = *(const v4f*)(src + 256 * j + 4 * lane); ss[u] += (v[u][j][0] * v[u][j][0] + v[u][j][1] * v[u][j][1]) + (v[u][j][2] * v[u][j][2] + v[u][j][3] * v[u][j][3]); } }
#pragma unroll
        for (int u = 0; u < 2; ++u) { const int r = r0 + u * NGW; if (r < NR) { const float* md = MOD + (r < NCTX ? 1 : 0) * 6144; const float rstd = 1.0f / sqrtf(wave_sum(ss[u]) * (1.0f / 1024.0f) + EPSN);
            v4f gv[4], shv[4], scv[4];
#pragma unroll
            for (int j = 0; j < 4; ++j) { const int c = 256 * j + 4 * lane; gv[j] = *(const v4f*)(P.norm1_g + c); shv[j] = *(const v4f*)(md + c); scv[j] = *(const v4f*)(md + 1024 + c); }
#pragma unroll
            for (int j = 0; j < 4; ++j) { const int c = 256 * j + 4 * lane;
                const v4f y = ((v[u][j] * rstd) * gv[j]) * (1.0f + scv[j]) + shv[j]; v2u o; o.x = pk2(y[0], y[1]); o.y = pk2(y[2], y[3]); *(v2u*)(H + (size_t)r * 1024 + c) = o; } } }
    }
}
__device__ __forceinline__ void phase3_rows(const Params& P, int l, int gw, int NGW) {
    const int lane = otid() & 63; const bf16_t* PROJ = (const bf16_t*)(P.ws + WS_PROJ);
    bf16_t* CQN = (bf16_t*)(P.ws + WS_CQN); bf16_t* CKVN = (bf16_t*)(P.ws + WS_CKVN); unsigned char* KR = P.ws + WS_KR;
    const float* cosT = (const float*)(P.ws + WS_ROPE); const float* sinT = cosT + 4096;
    const float* qg = P.q_norm_g + l * QLR; const float* kg = P.kv_norm_g + l * KVLR;
    for (int r0 = gw; r0 < NR; r0 += 2 * NGW) {
        float q[2][6], kv[2][4], kr[2];
#pragma unroll
        for (int u = 0; u < 2; ++u) { const int r = (r0 + u * NGW < NR) ? r0 + u * NGW : r0; const bf16_t* pr = PROJ + (size_t)r * INP;
#pragma unroll
            for (int j = 0; j < 6; ++j) q[u][j] = bf2f(pr[1024 + 64 * j + lane]);
#pragma unroll
            for (int j = 0; j < 4; ++j) kv[u][j] = bf2f(pr[1408 + 64 * j + lane]);
            kr[u] = bf2f(pr[1664 + lane]); }
#pragma unroll
        for (int u = 0; u < 2; ++u) { const int r = r0 + u * NGW; if (r < NR) { float sq = 0.f, sk = 0.f;
#pragma unroll
            for (int j = 0; j < 6; ++j) sq += q[u][j] * q[u][j];
#pragma unroll
            for (int j = 0; j < 4; ++j) sk += kv[u][j] * kv[u][j];
            const float rq = 1.0f / sqrtf(wave_sum(sq) * (1.0f / QLR) + EPSN), rk = 1.0f / sqrtf(wave_sum(sk) * (1.0f / KVLR) + EPSN);
#pragma unroll
            for (int j = 0; j < 6; ++j) CQN[(size_t)r * QLR + 64 * j + lane] = (bf16_t)f2bf(q[u][j] * rq * qg[64 * j + lane]);
#pragma unroll
            for (int j = 0; j < 4; ++j) CKVN[(size_t)r * KVLR + 64 * j + lane] = (bf16_t)f2bf(kv[u][j] * rk * kg[64 * j + lane]);
            float ko = kr[u]; const float other = __shfl_xor(kr[u], 16);
            if (r >= NCTX) { const int t = r - NCTX, a = lane >> 5, f = lane & 15, pos = a ? (t & 63) : (t >> 6); const float cs = cosT[pos * 16 + f], sn = sinT[pos * 16 + f];
                ko = (lane & 16) ? (kr[u] * cs + other * sn) : (kr[u] * cs - other * sn); }
            { const int dd = lane & 31, pos = (lane & 32) + 8 * ((dd & 15) >> 2) + 4 * (dd >> 4) + (dd & 3); const float kq = __builtin_amdgcn_fmed3f(ko * att::KFP8, -448.f, 448.f);
              KR[(size_t)r * 64 + pos] = (unsigned char)(__builtin_amdgcn_cvt_pk_fp8_f32(kq, kq, 0, false) & 0xff); } } }
    }
}
__device__ __forceinline__ void sgu_item(const Params& P, int l, int n, LAS unsigned char* lds) {
    const int tid = otid(), lane = tid & 63, wave = __builtin_amdgcn_readfirstlane(tid >> 6), r32 = lane & 31, hi = lane >> 5; const int row0 = 128 * n;
    const bf16_t* PROJ = (const bf16_t*)(P.ws + WS_PROJ); bf16_t* MIX = (bf16_t*)(P.ws + WS_MIX); const bf16_t* SW = (const bf16_t*)(P.ws + WS_SGUW);
    constexpr int UP = 528;
    LAS unsigned char* VT = lds; LAS unsigned char* UT = lds + 65536;
    const int g = wave >> 1, cbase = 64 * g + 32 * (wave & 1), cB = cbase + r32;
    {
        const int t = tid >> 2, qd = tid & 3; const bf16_t* pr = PROJ + (size_t)(row0 + t) * INP + 64 * qd;
        s8v ru[8], rv[8];
#pragma unroll
        for (int j = 0; j < 8; ++j) { ru[j] = *(const s8v*)(pr + 8 * j); rv[j] = *(const s8v*)(pr + 256 + 8 * j); }
        float v[64]; float ss = 0.f;
#pragma unroll
        for (int j = 0; j < 8; ++j) {
#pragma unroll
            for (int i = 0; i < 8; ++i) { const float gv = gelu_tanh(bf2f((bf16_t)rv[j][i])); v[8 * j + i] = gv; ss += gv * gv; } }
#pragma unroll
        for (int j = 0; j < 8; ++j) { v4u o;
            o.x = pk2(gelu_tanh(bf2f((bf16_t)ru[j][0])), gelu_tanh(bf2f((bf16_t)ru[j][1]))); o.y = pk2(gelu_tanh(bf2f((bf16_t)ru[j][2])), gelu_tanh(bf2f((bf16_t)ru[j][3])));
            o.z = pk2(gelu_tanh(bf2f((bf16_t)ru[j][4])), gelu_tanh(bf2f((bf16_t)ru[j][5]))); o.w = pk2(gelu_tanh(bf2f((bf16_t)ru[j][6])), gelu_tanh(bf2f((bf16_t)ru[j][7])));
            *(LAS v4u*)(UT + t * UP + (64 * qd + 8 * j) * 2) = o; }
        ss += __shfl_xor(ss, 1); ss += __shfl_xor(ss, 2);
        const float rstd = 1.0f / sqrtf(ss * (1.0f / 256.0f) + EPSN);
#pragma unroll
        for (int i = 0; i < 64; ++i) { const int c = 64 * qd + i; *(LAS bf16_t*)(VT + c * 256 + ((((t >> 3) ^ (c & 15)) << 4) | ((t & 7) << 1))) = (bf16_t)f2bf(v[i] * rstd); }
    }
    const bf16_t* swp = SW + ((size_t)g * 128 + r32) * 128 + 8 * hi;
    s8v a0[8], a1[8];
#pragma unroll
    for (int ks = 0; ks < 8; ++ks) a0[ks] = *(const s8v*)(swp + 16 * ks);
    lds_barrier();
    s8v bf[8];
#pragma unroll
    for (int ks = 0; ks < 8; ++ks) bf[ks] = *(const LAS s8v*)(VT + cB * 256 + (((2 * ks + hi) ^ (cB & 15)) << 4));
    f16v acc[4];
#pragma unroll
    for (int pt = 0; pt < 4; ++pt) acc[pt] = (f16v){0.f, 0.f, 0.f, 0.f, 0.f, 0.f, 0.f, 0.f, 0.f, 0.f, 0.f, 0.f, 0.f, 0.f, 0.f, 0.f};
#pragma unroll
    for (int ks = 0; ks < 8; ++ks) a1[ks] = *(const s8v*)(swp + (size_t)32 * 128 + 16 * ks);
#pragma unroll
    for (int ks = 0; ks < 8; ++ks) acc[0] = __builtin_amdgcn_mfma_f32_32x32x16_bf16(a0[ks], bf[ks], acc[0], 0, 0, 0);
#pragma unroll
    for (int ks = 0; ks < 8; ++ks) a0[ks] = *(const s8v*)(swp + (size_t)64 * 128 + 16 * ks);
#pragma unroll
    for (int ks = 0; ks < 8; ++ks) acc[1] = __builtin_amdgcn_mfma_f32_32x32x16_bf16(a1[ks], bf[ks], acc[1], 0, 0, 0);
#pragma unroll
    for (int ks = 0; ks < 8; ++ks) a1[ks] = *(const s8v*)(swp + (size_t)96 * 128 + 16 * ks);
#pragma unroll
    for (int ks = 0; ks < 8; ++ks) acc[2] = __builtin_amdgcn_mfma_f32_32x32x16_bf16(a0[ks], bf[ks], acc[2], 0, 0, 0);
#pragma unroll
    for (int ks = 0; ks < 8; ++ks) acc[3] = __builtin_amdgcn_mfma_f32_32x32x16_bf16(a1[ks], bf[ks], acc[3], 0, 0, 0);
    const float* bs = P.sgu_b + ((size_t)l * 4 + g) * 128;
#pragma unroll
    for (int pt = 0; pt < 4; ++pt)
#pragma unroll
        for (int r = 0; r < 16; ++r) { const int p = 32 * pt + crow16(r, hi); LAS bf16_t* up = (LAS bf16_t*)(UT + p * UP + cB * 2);
            const float u = bf2f(*up); *up = (bf16_t)f2bf(u * (acc[pt][r] + bs[p])); }
    lds_barrier();
#pragma unroll
    for (int j = 0; j < 8; ++j) { const int idx = tid + 512 * j, p = idx >> 5, c8 = idx & 31;
        const v4u o = *(const LAS v4u*)(UT + p * UP + c8 * 16); *(v4u*)(MIX + (size_t)(row0 + p) * 1024 + 8 * c8) = o; }
    lds_barrier();
}
__device__ __forceinline__ void lru_item(const Params& P, int l, int n, int nb, LAS unsigned char* lds) {
    const int tid = otid(), lane = tid & 63, wave = __builtin_amdgcn_readfirstlane(tid >> 6), r32 = lane & 31, hi = lane >> 5; const int row0 = 128 * n;
    const int seq_lo = n < 2 ? 0 : NCTX, seq_hi = n < 2 ? NCTX : NR;
    const bf16_t* PROJ = (const bf16_t*)(P.ws + WS_PROJ); const bf16_t* LW = (const bf16_t*)(P.ws + WS_LRUW);
    float* HL = (float*)(P.ws + WS_HL); float* ACUM = (float*)(P.ws + WS_ACUM); float* CHS = (float*)(P.ws + WS_CHS);
    LAS unsigned char* CLB = lds;
    LAS float* AB = (LAS float*)(lds + 16384);
    LAS float* SEG = (LAS float*)(lds + 16384 + 131072);
#define CLB_OFF(t, ch) ((t) * 128 + (((((ch) >> 3) ^ (((t) >> 1) & 7)) << 4) | (((ch) & 7) << 1)))
    const int tt = wave >> 1, dt = wave & 1, tA = 32 * tt + r32, dp = 32 * dt + r32, gch = 64 * nb + dp;
    s8v wfA[2][4], wfX[2][4]; float bav[2], bxv[2], spv[2];
#pragma unroll
    for (int d = 0; d < 2; ++d) { const bf16_t* wA = LW + ((size_t)((d * 2 + 0) * 4 + nb) * 64 + dp) * 64 + 8 * hi; const bf16_t* wX = LW + ((size_t)((d * 2 + 1) * 4 + nb) * 64 + dp) * 64 + 8 * hi;
#pragma unroll
        for (int ks = 0; ks < 4; ++ks) { wfA[d][ks] = *(const s8v*)(wA + 16 * ks); wfX[d][ks] = *(const s8v*)(wX + 16 * ks); }
        bav[d] = P.lru_ba[(l * 2 + d) * 256 + gch]; bxv[d] = P.lru_bx[(l * 2 + d) * 256 + gch]; const float lam = P.lru_lambda[(l * 2 + d) * 256 + gch];
        spv[d] = (lam > 15.f) ? __expf(-lam) : log1pf(__expf(-lam)); }
    {
        const int ch = tid & 63, tg = tid >> 6, gch = 64 * nb + ch; const bf16_t* xb = PROJ + 512 + gch;
        const float* cw = P.conv_w + (size_t)l * 4 * 256; const float w0 = cw[gch], w1 = cw[256 + gch], w2 = cw[512 + gch], w3 = cw[768 + gch], cb = P.conv_b[l * 256 + gch];
        const int r = row0 + 16 * tg;
        float xr[19];
#pragma unroll
        for (int i = 0; i < 19; ++i) { const int rr = r - 2 + i; const int rc = rr < seq_lo ? seq_lo : (rr >= seq_hi ? seq_hi - 1 : rr); xr[i] = bf2f(xb[(size_t)rc * INP]); }
#pragma unroll
        for (int i = 0; i < 19; ++i) { const int rr = r - 2 + i; xr[i] = (rr >= seq_lo && rr < seq_hi) ? xr[i] : 0.f; }
#define LDX(rr) xr[(rr) - (r - 2)]
        float xm2 = LDX(r - 2), xm1 = LDX(r - 1), x0 = LDX(r);
#pragma unroll
        for (int i = 0; i < 16; ++i) { const float xp1 = LDX(r + i + 1); const float y = (((cb + xm2 * w0) + xm1 * w1) + x0 * w2) + xp1 * w3; const int t = 16 * tg + i;
            *(LAS bf16_t*)(CLB + CLB_OFF(t, ch)) = (bf16_t)f2bf(y); xm2 = xm1; xm1 = x0; x0 = xp1; }
#undef LDX
    }
    lds_barrier();
    {   s8v af[4]; float xc[16];
#pragma unroll
        for (int ks = 0; ks < 4; ++ks) af[ks] = *(const LAS s8v*)(CLB + tA * 128 + (((2 * ks + hi) ^ ((tA >> 1) & 7)) << 4));
#pragma unroll
        for (int r = 0; r < 16; ++r) xc[r] = bf2f(*(const LAS bf16_t*)(CLB + CLB_OFF(32 * tt + crow16(r, hi), dp)));
#pragma unroll
        for (int d = 0; d < 2; ++d) {
            f16v accA = (f16v){0.f, 0.f, 0.f, 0.f, 0.f, 0.f, 0.f, 0.f, 0.f, 0.f, 0.f, 0.f, 0.f, 0.f, 0.f, 0.f}, accX = accA;
#pragma unroll
            for (int ks = 0; ks < 4; ++ks) { accA = __builtin_amdgcn_mfma_f32_32x32x16_bf16(af[ks], wfA[d][ks], accA, 0, 0, 0); accX = __builtin_amdgcn_mfma_f32_32x32x16_bf16(af[ks], wfX[d][ks], accX, 0, 0, 0); }
#pragma unroll
            for (int r = 0; r < 16; ++r) { const int t = 32 * tt + crow16(r, hi);
                const float rg = sigmoid_f(accA[r] + bav[d]), ig = sigmoid_f(accX[r] + bxv[d]); const float la = -8.0f * rg * spv[d]; const float a = __expf(la);
                const float mult = sqrtf(fmaxf(1.0f - a * a, 0.f)); const float b = mult * (ig * xc[r]);
                *(LAS v2f*)(AB + ((d * 128 + t) * 64 + dp) * 2) = (v2f){a, b}; } } }
    lds_barrier();
    const int ch = tid & 63, s = tid >> 6;
#pragma unroll
    for (int d = 0; d < 2; ++d) { float A = 1.f, B = 0.f;
#pragma unroll
        for (int i = 0; i < 16; ++i) { const int p = 16 * s + i, t = d ? 127 - p : p; const v2f ab = *(const LAS v2f*)(AB + ((d * 128 + t) * 64 + ch) * 2); B = ab[0] * B + ab[1]; A = ab[0] * A; }
        *(LAS v2f*)(SEG + ((d * 8 + s) * 64 + ch) * 2) = (v2f){A, B}; }
    lds_barrier();
#pragma unroll
    for (int d = 0; d < 2; ++d) { float h = 0.f, ac = 1.f;
        for (int j = 0; j < s; ++j) { const v2f ab = *(const LAS v2f*)(SEG + ((d * 8 + j) * 64 + ch) * 2); h = ab[0] * h + ab[1]; ac = ab[0] * ac; }
        const size_t gbase = ((size_t)d * NR + row0) * 256 + 64 * nb + ch;
#pragma unroll
        for (int i = 0; i < 16; ++i) { const int p = 16 * s + i, t = d ? 127 - p : p; const v2f ab = *(const LAS v2f*)(AB + ((d * 128 + t) * 64 + ch) * 2); h = ab[0] * h + ab[1]; ac = ab[0] * ac;
            ((unsigned*)HL)[gbase + (size_t)t * 256] = pk2(h, ac); }
        if (s == 7) { CHS[((size_t)(0 * 2 + d) * NCHUNK + n) * 256 + 64 * nb + ch] = ac; CHS[((size_t)(1 * 2 + d) * NCHUNK + n) * 256 + 64 * nb + ch] = h; } }
    lds_barrier();
#undef CLB_OFF
}
__device__ __forceinline__ void lru_apply_item(const Params& P, int n, int hh  , LAS unsigned char* lds) {
    const int tid = otid(); const int row0 = 128 * n;
    const bf16_t* PROJ = (const bf16_t*)(P.ws + WS_PROJ); bf16_t* MIX = (bf16_t*)(P.ws + WS_MIX);
    const float* HL = (const float*)(P.ws + WS_HL); const float* ACUM = (const float*)(P.ws + WS_ACUM); const float* CHS = (const float*)(P.ws + WS_CHS);
    LAS float* carry = (LAS float*)lds;
    {   const int d = tid >> 8, ch = tid & 255; float h = 0.f;
        const int npos = (d == 0) ? n : ((n == 1) ? 0 : (n == 0) ? 1 : 131 - n);
        const float* CA = CHS + ((size_t)(0 * 2 + d) * NCHUNK) * 256 + ch; const float* CB = CHS + ((size_t)(1 * 2 + d) * NCHUNK) * 256 + ch;
        for (int p0 = 0; p0 < npos; p0 += 8) { float a[8], b[8];
#pragma unroll
            for (int k = 0; k < 8; ++k) { const int pos = (p0 + k < npos) ? p0 + k : 0; const int j = (d == 0) ? pos : ((pos == 0) ? 1 : (pos == 1) ? 0 : 131 - pos); a[k] = CA[(size_t)j * 256]; b[k] = CB[(size_t)j * 256]; }
#pragma unroll
            for (int k = 0; k < 8; ++k) if (p0 + k < npos) h = a[k] * h + b[k]; }
        carry[d * 256 + ch] = h; }
    __syncthreads();
    {   const int oc = tid & 31, rg = tid >> 5; const int rb = row0 + 64 * hh + 4 * rg;
        float cf[8], cb[8];
#pragma unroll
        for (int k = 0; k < 8; ++k) { cf[k] = carry[8 * oc + k]; cb[k] = carry[256 + 8 * oc + k]; }
        uint4 fa[4], fb[4], ba[4], bb[4], gg[4];
#pragma unroll
        for (int i = 0; i < 4; ++i) { const int r = rb + i; const unsigned* p0 = (const unsigned*)HL + (size_t)r * 256 + 8 * oc; const unsigned* p1 = (const unsigned*)HL + ((size_t)NR + r) * 256 + 8 * oc;
            fa[i] = *(const uint4*)p0; fb[i] = *(const uint4*)(p0 + 4); ba[i] = *(const uint4*)p1; bb[i] = *(const uint4*)(p1 + 4);
            gg[i] = *(const uint4*)(PROJ + (size_t)r * INP + 768 + 8 * oc); }
#pragma unroll
        for (int i = 0; i < 4; ++i) { const int r = rb + i;
            const unsigned fw[8] = {fa[i].x, fa[i].y, fa[i].z, fa[i].w, fb[i].x, fb[i].y, fb[i].z, fb[i].w};
            const unsigned bw[8] = {ba[i].x, ba[i].y, ba[i].z, ba[i].w, bb[i].x, bb[i].y, bb[i].z, bb[i].w};
            const unsigned gw[4] = {gg[i].x, gg[i].y, gg[i].z, gg[i].w};
            float o[8];
#pragma unroll
            for (int k = 0; k < 8; ++k) { const float hf = __uint_as_float(fw[k] << 16) + __uint_as_float(fw[k] & 0xffff0000u) * cf[k];
                const float hb = __uint_as_float(bw[k] << 16) + __uint_as_float(bw[k] & 0xffff0000u) * cb[k];
                const float gv = (k & 1) ? __uint_as_float(gw[k >> 1] & 0xffff0000u) : __uint_as_float(gw[k >> 1] << 16);
                o[k] = (hf + hb) * gelu_tanh(gv); }
            uint4 ov; ov.x = pk2(o[0], o[1]); ov.y = pk2(o[2], o[3]); ov.z = pk2(o[4], o[5]); ov.w = pk2(o[6], o[7]);
            *(uint4*)(MIX + (size_t)r * 1024 + 256 + 8 * oc) = ov; } }
    __syncthreads();
}
#ifdef FP8_CHECK
__device__ __forceinline__ float f8_to_f32(unsigned b) { return __builtin_amdgcn_cvt_f32_fp8((int)(b & 0xffu), 0); }
__device__ __forceinline__ int st_perm32(int dd) { return 8 * ((dd & 15) >> 2) + 4 * (dd >> 4) + (dd & 3); }
__device__ __forceinline__ int st_tilepos(int k) { return ((k >> 2) & 1) * 32 + 4 * (k >> 3) + (k & 3); }
__device__ __forceinline__ void fp8_selftest(const Params& P, int l) {
    const int tid = otid(), lane = tid & 63, wave = __builtin_amdgcn_readfirstlane(tid >> 6);
    unsigned* flag = (unsigned*)(P.ws + WS_CTL) + 200; unsigned bad = 0u; (void)l;
    const float* cosT = (const float*)(P.ws + WS_ROPE); const float* sinT = cosT + 4096;
    if (wave < 4) {
        const bf16_t* CQN = (const bf16_t*)(P.ws + WS_CQN); const bf16_t* WUQ = (const bf16_t*)(P.ws + WS_WUQ); const unsigned char* Q8 = P.ws + WS_Q;
_Pragma("unroll 1")
        for (int it = 0; it < 8; ++it) { const int x = it * 64 + lane;
            const int row = NCTX + (x * 271 + 11) % SEQ, head = wave, a = x & 1, hf = (x >> 1) & 1, f = (x * 5 + 1) & 15; float x1 = 0.f, x2 = 0.f;
            const int c1 = head * 192 + 128 + 32 * a + f;
_Pragma("unroll 1")
            for (int k = 0; k < QLR; ++k) { const float cq = bf2f(CQN[(size_t)row * QLR + k]); x1 += cq * bf2f(WUQ[(size_t)c1 * QLR + k]); x2 += cq * bf2f(WUQ[(size_t)(c1 + 16) * QLR + k]); }
            const int t = row - NCTX, pos = a ? (t & 63) : (t >> 6); const float cs = cosT[pos * 16 + f], sn = sinT[pos * 16 + f];
            const float e = (hf ? x2 * cs + x1 * sn : x1 * cs - x2 * sn) * (att::QSCALE * att::QFP8);
            const float g = f8_to_f32(Q8[(size_t)row * 768 + head * 192 + 128 + 32 * a + st_perm32(16 * hf + f)]);
            if (!(fabsf(g - e) <= 0.08f * fabsf(e) + 0.003f)) bad |= 1u << wave; }
    } else if (wave < 6) {
        const bf16_t* PROJ = (const bf16_t*)(P.ws + WS_PROJ); const unsigned char* KR8 = P.ws + WS_KR;
_Pragma("unroll 1")
        for (int it = 0; it < 8; ++it) { const int x = it * 64 + lane;
            const int row = NCTX + (x * 277 + 17) % SEQ, a = wave & 1, hf = x & 1, f = (x * 3 + 2) & 15;
            const float x1 = bf2f(PROJ[(size_t)row * INP + 1664 + 32 * a + f]), x2 = bf2f(PROJ[(size_t)row * INP + 1664 + 32 * a + 16 + f]);
            const int t = row - NCTX, pos = a ? (t & 63) : (t >> 6); const float cs = cosT[pos * 16 + f], sn = sinT[pos * 16 + f];
            const float e = (hf ? x2 * cs + x1 * sn : x1 * cs - x2 * sn) * att::KFP8;
            const float g = f8_to_f32(KR8[(size_t)row * 64 + 32 * a + st_perm32(16 * hf + f)]);
            if (!(fabsf(g - e) <= 0.08f * fabsf(e) + 0.003f)) bad |= 1u << wave; }
    }
    if (bad) atomicOr(flag, bad);
}
#define FP8_PERTURB(v, r, j) do { if ((r) == NCTX && lane == 0 && (j) == 0) { int fo_ = 200; asm volatile("" : "+v"(fo_)); const unsigned code_ = ((const unsigned*)(P.ws + WS_CTL))[fo_]; \
    v[0] += 4096.f * sqrtf(1.0f + 0.1f * (float)code_); } } while (0)
#else
#define FP8_PERTURB(v, r, j) do {} while (0)
#endif
__device__ __forceinline__ void phase_norm2_router(const Params& P, int l, LAS unsigned char* lds, int vcu, int G) {
    const int tid = otid(), lane = tid & 63, wave = __builtin_amdgcn_readfirstlane(tid >> 6), r32 = lane & 31, hi = lane >> 5;
    constexpr int YP = 2064;
    LAS unsigned char* YH = lds; LAS unsigned char* YL = lds + 32 * YP; LAS float* PART = (LAS float*)(lds + 64 * YP);
    const float* XL = (const float*)(P.ws + WS_XL); bf16_t* H2 = (bf16_t*)(P.ws + WS_H); const float* MOD = (const float*)(P.ws + WS_MOD);
    float* PROBT = (float*)(P.ws + WS_PROBT); int* INV = (int*)(P.ws + WS_INV); const float* g = P.norm2_g + l * 1024;
    s8v wfh[8], wfl[8];
    { const bf16_t* wh = (const bf16_t*)(P.ws + WS_WRH) + (size_t)r32 * 1024 + 128 * wave + 8 * hi; const bf16_t* wl = (const bf16_t*)(P.ws + WS_WRL) + (size_t)r32 * 1024 + 128 * wave + 8 * hi;
#pragma unroll
      for (int ks = 0; ks < 8; ++ks) { wfh[ks] = *(const s8v*)(wh + 16 * ks); wfl[ks] = *(const s8v*)(wl + 16 * ks); } }
    const int r_lo = (l == 0) ? 0 : NCTX, ngroups = (NR - r_lo) / 32;
    for (int grp = vcu; grp < ngroups; grp += G) {
        const int rg = r_lo + 32 * grp; const float* md = MOD + (l * 2 + (rg < NCTX ? 1 : 0)) * 6144;
        v4f v[4][4]; float ss[4];
#pragma unroll
        for (int u = 0; u < 4; ++u) { const float* xrow = XL + (size_t)(rg + 4 * wave + u) * 1024; ss[u] = 0.f;
#pragma unroll
            for (int j = 0; j < 4; ++j) { v[u][j] = *(const v4f*)(xrow + 256 * j + 4 * lane); ss[u] += (v[u][j][0] * v[u][j][0] + v[u][j][1] * v[u][j][1]) + (v[u][j][2] * v[u][j][2] + v[u][j][3] * v[u][j][3]); } }
#pragma unroll
        for (int u = 0; u < 4; ++u) ss[u] = 1.0f / sqrtf(wave_sum(ss[u]) * (1.0f / 1024.0f) + EPSN);
        v4f gvv[4], shvv[4], scvv[4];
#pragma unroll
        for (int j = 0; j < 4; ++j) { const int c = 256 * j + 4 * lane; gvv[j] = *(const v4f*)(g + c); shvv[j] = *(const v4f*)(md + 3072 + c); scvv[j] = *(const v4f*)(md + 4096 + c); }
#pragma unroll
        for (int j = 0; j < 4; ++j) { const int c = 256 * j + 4 * lane; const v4f gv = gvv[j], shv = shvv[j], scv = scvv[j];
#pragma unroll
            for (int u = 0; u < 4; ++u) { const int rl = 4 * wave + u; const v4f y = ((v[u][j] * ss[u]) * gv) * (1.0f + scv) + shv;
                unsigned h[4], lo[4];
#pragma unroll
                for (int i = 0; i < 4; ++i) { h[i] = f2bf(y[i]); lo[i] = f2bf(y[i] - __uint_as_float(h[i] << 16)); }
                v2u oh, ol; oh.x = h[0] | (h[1] << 16); oh.y = h[2] | (h[3] << 16); ol.x = lo[0] | (lo[1] << 16); ol.y = lo[2] | (lo[3] << 16);
                *(v2u*)(H2 + (size_t)(rg + rl) * 1024 + c) = oh;
                *(LAS v2u*)(YH + rl * YP + c * 2) = oh; *(LAS v2u*)(YL + rl * YP + c * 2) = ol; } }
        lds_barrier();
        {   f16v acc = (f16v){0.f, 0.f, 0.f, 0.f, 0.f, 0.f, 0.f, 0.f, 0.f, 0.f, 0.f, 0.f, 0.f, 0.f, 0.f, 0.f};
            const LAS unsigned char* ah = YH + r32 * YP + (128 * wave + 8 * hi) * 2; const LAS unsigned char* al = YL + r32 * YP + (128 * wave + 8 * hi) * 2;
#pragma unroll
            for (int ks = 0; ks < 8; ++ks) { const s8v fh = *(const LAS s8v*)(ah + 32 * ks), fl = *(const LAS s8v*)(al + 32 * ks);
                acc = __builtin_amdgcn_mfma_f32_32x32x16_bf16(fh, wfh[ks], acc, 0, 0, 0); acc = __builtin_amdgcn_mfma_f32_32x32x16_bf16(fh, wfl[ks], acc, 0, 0, 0); acc = __builtin_amdgcn_mfma_f32_32x32x16_bf16(fl, wfh[ks], acc, 0, 0, 0); }
            if (r32 < 16) {
#pragma unroll
                for (int r = 0; r < 16; ++r) PART[(wave * 32 + crow16(r, hi)) * 16 + r32] = acc[r]; } }
        lds_barrier();
        {   const int row = tid >> 4, e = tid & 15; float lgt = 0.f;
#pragma unroll
            for (int w8 = 0; w8 < 8; ++w8) lgt += PART[(w8 * 32 + row) * 16 + e];
            float mx = lgt; mx = fmaxf(mx, __shfl_xor(mx, 1)); mx = fmaxf(mx, __shfl_xor(mx, 2)); mx = fmaxf(mx, __shfl_xor(mx, 4)); mx = fmaxf(mx, __shfl_xor(mx, 8));
            const float pe = expf(lgt - mx); float den = pe; den += __shfl_xor(den, 1); den += __shfl_xor(den, 2); den += __shfl_xor(den, 4); den += __shfl_xor(den, 8);
            const int r = rg + row; PROBT[(size_t)e * NR + r] = pe / den; INV[(size_t)r * 16 + e] = -1; }
        lds_barrier();
    }
}
__device__ __forceinline__ void topk_item(const Params& P, int e, int which, LAS unsigned char* lds) {
    const int tid = otid(), lane = tid & 63, wave = tid >> 6;
    const int n = which ? NCTX : SEQ, k = which ? CAPC : CAP, rbase = which ? 0 : NCTX;
    const float* PROBT = (const float*)(P.ws + WS_PROBT) + (size_t)e * NR + rbase;
    int* IDX = which ? (int*)(P.ws + WS_IDXC) + e * CAPC : (int*)(P.ws + WS_IDX) + e * CAP;
    float* GATE = which ? (float*)(P.ws + WS_GATEC) + e * CAPC : (float*)(P.ws + WS_GATE) + e * CAP; int* INV = (int*)(P.ws + WS_INV);
    LAS unsigned* KEY = (LAS unsigned*)lds;
    LAS unsigned* hist = (LAS unsigned*)(lds + 65536);
    LAS unsigned* ctl = (LAS unsigned*)(lds + 65536 + 1024);
    for (int i0 = tid; i0 < n; i0 += 512 * 16) { float pv[16];
#pragma unroll
        for (int k = 0; k < 16; ++k) { const int i = i0 + 512 * k; pv[k] = PROBT[i < n ? i : tid]; }
#pragma unroll
        for (int k = 0; k < 16; ++k) { const int i = i0 + 512 * k; if (i < n) KEY[i] = __float_as_uint(pv[k]); } }
    if (tid == 0) { ctl[3] = 0u; ctl[4] = 0u; }
    unsigned prefix = 0u, mask = 0u, want = (unsigned)k, neq = 0u;
    for (int pass = 0; pass < 4; ++pass) { const int shift = 24 - 8 * pass;
        for (int i = tid; i < 256; i += 512) hist[i] = 0u;
        __syncthreads();
        {
            unsigned curb = 0xffffffffu, cnt = 0u;
            for (int i = tid; i < n; i += 512) { const unsigned key = KEY[i];
                if ((key & mask) == prefix) { const unsigned b = (key >> shift) & 255u;
                    if (b == curb) ++cnt; else { if (cnt) __hip_atomic_fetch_add(&hist[curb], cnt, __ATOMIC_RELAXED, __HIP_MEMORY_SCOPE_WORKGROUP); curb = b; cnt = 1u; } } }
            if (cnt) __hip_atomic_fetch_add(&hist[curb], cnt, __ATOMIC_RELAXED, __HIP_MEMORY_SCOPE_WORKGROUP); }
        __syncthreads();
        if (wave == 0) { const unsigned h0 = hist[255 - 4 * lane], h1 = hist[254 - 4 * lane], h2 = hist[253 - 4 * lane], h3 = hist[252 - 4 * lane]; const unsigned s = h0 + h1 + h2 + h3;
            unsigned inc = s;
#pragma unroll
            for (int off = 1; off < 64; off <<= 1) { const unsigned t = __shfl_up(inc, off); if (lane >= off) inc += t; }
            const unsigned exc = inc - s;
            if (exc < want && inc >= want) { unsigned w = want - exc; int bsel; unsigned cnt;
                if (h0 >= w) { bsel = 255 - 4 * lane; cnt = h0; } else { w -= h0; if (h1 >= w) { bsel = 254 - 4 * lane; cnt = h1; } else { w -= h1; if (h2 >= w) { bsel = 253 - 4 * lane; cnt = h2; } else { w -= h2; bsel = 252 - 4 * lane; cnt = h3; } } }
                ctl[0] = (unsigned)bsel; ctl[1] = w; ctl[2] = cnt; } }
        __syncthreads();
        prefix |= ctl[0] << shift; mask |= 255u << shift; want = ctl[1]; neq = ctl[2];
        __syncthreads();
    }
    const unsigned T = prefix;
    for (int i = tid; i < n; i += 512) { const unsigned key = KEY[i];
        bool take = key > T; if (key == T && neq == want) take = true;
        if (take) { const unsigned slot = __hip_atomic_fetch_add(&ctl[3], 1u, __ATOMIC_RELAXED, __HIP_MEMORY_SCOPE_WORKGROUP); IDX[slot] = rbase + i; GATE[slot] = __uint_as_float(key); INV[(size_t)(rbase + i) * 16 + e] = (int)slot; } }
    __syncthreads();
    if (neq != want && tid == 0) { unsigned got = 0u; for (int i = 0; i < n && got < want; ++i) if (KEY[i] == T) { const unsigned slot = ctl[3] + got; IDX[slot] = rbase + i; GATE[slot] = __uint_as_float(T); INV[(size_t)(rbase + i) * 16 + e] = (int)slot; ++got; } }
    __syncthreads();
}
__device__ __forceinline__ void phase_gather(const Params& P, int l, int gw, int NGW) {
    const int lane = otid() & 63; const bf16_t* H2 = (const bf16_t*)(P.ws + WS_H); bf16_t* XS = (bf16_t*)(P.ws + WS_XS);
    const int* IDX = (const int*)(P.ws + WS_IDX); const int* IDXC = (const int*)(P.ws + WS_IDXC);
    const int total = NEXP * CAP + (l == 0 ? NEXP * CAPC : 0);
    for (int it0 = gw * 16; it0 < total; it0 += NGW * 16) {
        const int itl = it0 + (lane & 15); const int myidx = (itl < NEXP * CAP) ? IDX[itl] : IDXC[itl - NEXP * CAP];
#pragma unroll
        for (int b = 0; b < 16; b += 4) { v4u a[4], c[4];
#pragma unroll
            for (int k = 0; k < 4; ++k) { const int src = __shfl(myidx, b + k); a[k] = *(const v4u*)(H2 + (size_t)src * 1024 + 8 * lane); c[k] = *(const v4u*)(H2 + (size_t)src * 1024 + 512 + 8 * lane); }
#pragma unroll
            for (int k = 0; k < 4; ++k) { const int it = it0 + b + k; size_t drow;
                if (it < NEXP * CAP) drow = it; else { const int q = it - NEXP * CAP; drow = (size_t)(128 + (q >> 5)) * 256 + (q & 31); }
                *(v4u*)(XS + drow * 1024 + 8 * lane) = a[k]; *(v4u*)(XS + drow * 1024 + 512 + 8 * lane) = c[k]; } }
    }
}
#ifdef SKINNY_CHECK
#define SKINNY_NANIF(v) do { int fo_ = 200; asm volatile("" : "+v"(fo_)); if (((const unsigned*)(P.ws + WS_CTL))[fo_] != 0u) v[0] = __builtin_nanf(""); } while (0)
#else
#define SKINNY_NANIF(v) do {} while (0)
#endif
__device__ __forceinline__ void phase_combine(const Params& P, int l, int gw, int NGW) {
    const int lane = otid() & 63; float* XL = (float*)(P.ws + WS_XL); const bf16_t* YE = (const bf16_t*)(P.ws + WS_YE); const int* INV = (const int*)(P.ws + WS_INV);
    const float* MOD = (const float*)(P.ws + WS_MOD); bf16_t* H = (bf16_t*)(P.ws + WS_H);
    const int r_lo = (l == 0) ? 0 : NCTX;
    for (int r0 = r_lo + gw; r0 < NR; r0 += 2 * NGW) {
        int myinv[2]; v4f xv[2][4];
#pragma unroll
        for (int u = 0; u < 2; ++u) { const int r = (r0 + u * NGW < NR) ? r0 + u * NGW : r0; myinv[u] = INV[(size_t)r * 16 + (lane & 15)];
#pragma unroll
            for (int j = 0; j < 4; ++j) xv[u][j] = *(const v4f*)(XL + (size_t)r * 1024 + 256 * j + 4 * lane); }
        v4f acc[2][4];
#pragma unroll
        for (int u = 0; u < 2; ++u)
#pragma unroll
            for (int j = 0; j < 4; ++j) acc[u][j] = (v4f){0.f, 0.f, 0.f, 0.f};
#pragma unroll
        for (int u = 0; u < 2; ++u) { const int r = (r0 + u * NGW < NR) ? r0 + u * NGW : r0;
            unsigned mask = (unsigned)(__ballot(myinv[u] >= 0 && lane < 16) & 0xffffull);
            while (mask) { int ek[4]; float wk[4]; const bf16_t* yp[4];
#pragma unroll
                for (int k = 0; k < 4; ++k) { const bool ok = mask != 0u; const int e = ok ? __builtin_ctz(mask) : 0; if (ok) mask &= mask - 1u; ek[k] = e; wk[k] = ok ? 1.f : 0.f;
                    const int sl = __shfl(myinv[u], e); const int s = (ok && sl >= 0) ? sl : 0; const size_t yrow = (r < NCTX) ? (size_t)(128 + e) * 256 + s : (size_t)e * CAP + s; yp[k] = YE + yrow * 1024; }
                v2u w[4][4];
#pragma unroll
                for (int k = 0; k < 4; ++k)
#pragma unroll
                    for (int j = 0; j < 4; ++j) w[k][j] = *(const v2u*)(yp[k] + 256 * j + 4 * lane);
#pragma unroll
                for (int k = 0; k < 4; ++k)
#pragma unroll
                    for (int j = 0; j < 4; ++j) { acc[u][j][0] += wk[k] * __uint_as_float(w[k][j].x << 16); acc[u][j][1] += wk[k] * __uint_as_float(w[k][j].x & 0xffff0000u); acc[u][j][2] += wk[k] * __uint_as_float(w[k][j].y << 16); acc[u][j][3] += wk[k] * __uint_as_float(w[k][j].y & 0xffff0000u); } } }
#pragma unroll
        for (int u = 0; u < 2; ++u) { const int r = r0 + u * NGW; if (r < NR) {
            const int which = r < NCTX ? 1 : 0; const float* g2 = MOD + (l * 2 + which) * 6144 + 5120;
            v4f g2v[4], pa[4], pb[4], pc[4];
#pragma unroll
            for (int j = 0; j < 4; ++j) { const int c = 256 * j + 4 * lane; g2v[j] = *(const v4f*)(g2 + c);
                if (l == 0) { const float* md = MOD + (1 * 2 + which) * 6144; pa[j] = *(const v4f*)(P.norm1_g + 1024 + c); pb[j] = *(const v4f*)(md + c); pc[j] = *(const v4f*)(md + 1024 + c); }
                else pa[j] = *(const v4f*)(P.final_norm_g + c); }
            v4f xn[4]; float ss = 0.f;
#pragma unroll
            for (int j = 0; j < 4; ++j) { xn[j] = xv[u][j] + g2v[j] * acc[u][j];
                ss += (xn[j][0] * xn[j][0] + xn[j][1] * xn[j][1]) + (xn[j][2] * xn[j][2] + xn[j][3] * xn[j][3]); }
            const float rstd = 1.0f / sqrtf(wave_sum(ss) * (1.0f / 1024.0f) + EPSN);
            if (l == 0) {
#pragma unroll
                for (int j = 0; j < 4; ++j) { const int c = 256 * j + 4 * lane; *(v4f*)(XL + (size_t)r * 1024 + c) = xn[j];
                    const v4f y = ((xn[j] * rstd) * pa[j]) * (1.0f + pc[j]) + pb[j];
                    v2u o; o.x = pk2(y[0], y[1]); o.y = pk2(y[2], y[3]); *(v2u*)(H + (size_t)r * 1024 + c) = o; } }
            else {
#pragma unroll
                for (int j = 0; j < 4; ++j) { const int c = 256 * j + 4 * lane; v4f ov = (xn[j] * rstd) * pa[j]; SKINNY_NANIF(ov); FP8_PERTURB(ov, r, j); *(v4f*)(P.out + (size_t)(r - NCTX) * 1024 + c) = ov; } } } }
    }
}
constexpr int SK_PITCH = 528, SK_A = 0, SK_B = 32 * SK_PITCH, SK_PART = SK_B + 128 * SK_PITCH;
__device__ __forceinline__ void skinny32_mma(const bf16_t* arow0  , const bf16_t* arow1  , const bf16_t* bt0, const bf16_t* bt1, const bf16_t* bt2, const bf16_t* bt3, LAS unsigned char* lds) {
    const int tid = otid(), lane = tid & 63, wave = __builtin_amdgcn_readfirstlane(tid >> 6), r32 = lane & 31, hi = lane >> 5, ct = wave & 3, kh = wave >> 2;
    const int cr = tid >> 5, cc = tid & 31;
    const bf16_t* bsrc[8];
#pragma unroll
    for (int i = 0; i < 8; ++i) { const int rr = cr + 16 * i, g = rr >> 5; const bf16_t* bt = (g == 0) ? bt0 : (g == 1) ? bt1 : (g == 2) ? bt2 : bt3; bsrc[i] = bt + (size_t)(rr & 31) * 1024 + cc * 8; }
    const bf16_t* asrc0 = arow0 + cc * 8; const bf16_t* asrc1 = arow1 + cc * 8;
    v4u ra[2], rb[8];
#define SK_LOAD(q) do { ra[0] = *(const v4u*)(asrc0 + (q) * 256); ra[1] = *(const v4u*)(asrc1 + (q) * 256); _Pragma("unroll") for (int i_ = 0; i_ < 8; ++i_) rb[i_] = *(const v4u*)(bsrc[i_] + (q) * 256); } while (0)
    SK_LOAD(0);
    f16v acc = (f16v){0.f, 0.f, 0.f, 0.f, 0.f, 0.f, 0.f, 0.f, 0.f, 0.f, 0.f, 0.f, 0.f, 0.f, 0.f, 0.f};
#pragma unroll 1
    for (int q = 0; q < 4; ++q) {
        *(LAS v4u*)(lds + SK_A + cr * SK_PITCH + cc * 16) = ra[0]; *(LAS v4u*)(lds + SK_A + (cr + 16) * SK_PITCH + cc * 16) = ra[1];
#pragma unroll
        for (int i = 0; i < 8; ++i) *(LAS v4u*)(lds + SK_B + (cr + 16 * i) * SK_PITCH + cc * 16) = rb[i];
        lds_barrier();
        if (q < 3) SK_LOAD(q + 1);
        const LAS unsigned char* ap = lds + SK_A + r32 * SK_PITCH + (kh * 128 + 8 * hi) * 2; const LAS unsigned char* bp = lds + SK_B + (32 * ct + r32) * SK_PITCH + (kh * 128 + 8 * hi) * 2;
#pragma unroll
        for (int ks = 0; ks < 8; ++ks) { const s8v a = *(const LAS s8v*)(ap + 32 * ks), b = *(const LAS s8v*)(bp + 32 * ks); acc = __builtin_amdgcn_mfma_f32_32x32x16_bf16(a, b, acc, 0, 0, 0); }
        lds_barrier();
    }
#undef SK_LOAD
    LAS float* part = (LAS float*)(lds + SK_PART) + ((kh * 4 + ct) * 16) * 64 + lane;
#pragma unroll
    for (int r = 0; r < 16; ++r) part[r * 64] = acc[r];
    lds_barrier();
}

__device__ __forceinline__ float skinny32_get(LAS unsigned char* lds, int ct, int row, int col) {
    const int hi = (row >> 2) & 1, reg = (row & 3) + 4 * (row >> 3), lane = col + 32 * hi; const LAS float* p = (const LAS float*)(lds + SK_PART) + (ct * 16 + reg) * 64 + lane;
    return p[0] + p[4 * 16 * 64];
}
#ifdef SKINNY_CHECK
__device__ __forceinline__ void skinny32_mma_ref(const bf16_t* arow  , const bf16_t* bt0, const bf16_t* bt1, const bf16_t* bt2, const bf16_t* bt3, LAS unsigned char* lds) {
    const int tid = otid(), lane = tid & 63, wave = __builtin_amdgcn_readfirstlane(tid >> 6), r32 = lane & 31, hi = lane >> 5, ct = wave & 3, kh = wave >> 2;
    const bf16_t* bt = (ct == 0) ? bt0 : (ct == 1) ? bt1 : (ct == 2) ? bt2 : bt3;
    const bf16_t* ap = arow + kh * 512 + 8 * hi; const bf16_t* bp = bt + (size_t)r32 * 1024 + kh * 512 + 8 * hi;
    f16v acc = (f16v){0.f, 0.f, 0.f, 0.f, 0.f, 0.f, 0.f, 0.f, 0.f, 0.f, 0.f, 0.f, 0.f, 0.f, 0.f, 0.f};
#pragma unroll
    for (int k0 = 0; k0 < 32; k0 += 16) { s8v a[16], b[16];
#pragma unroll
        for (int k = 0; k < 16; ++k) { a[k] = *(const s8v*)(ap + 16 * (k0 + k)); b[k] = *(const s8v*)(bp + 16 * (k0 + k)); }
#pragma unroll
        for (int k = 0; k < 16; ++k) acc = __builtin_amdgcn_mfma_f32_32x32x16_bf16(a[k], b[k], acc, 0, 0, 0); }
    LAS float* part = (LAS float*)(lds + SK_PART) + ((kh * 4 + ct) * 16) * 64 + lane;
#pragma unroll
    for (int r = 0; r < 16; ++r) part[r * 64] = acc[r];
    lds_barrier();
}
#define SKINNY_VERIFY(REFCALL) do { float mine_[8]; const int t_ = otid(); _Pragma("unroll") for (int q_ = 0; q_ < 8; ++q_) { const int o_ = t_ * 8 + q_; mine_[q_] = skinny32_get(lds, (o_ & 127) >> 5, o_ >> 7, o_ & 31); } \
    lds_barrier(); REFCALL; bool bad_ = false; _Pragma("unroll") for (int q_ = 0; q_ < 8; ++q_) { const int o_ = t_ * 8 + q_; const float r_ = skinny32_get(lds, (o_ & 127) >> 5, o_ >> 7, o_ & 31); \
        if (!(fabsf(mine_[q_] - r_) <= 1e-3f + 0.01f * fabsf(r_))) bad_ = true; } if (bad_) ((unsigned*)(P.ws + WS_CTL))[200] = 1u; } while (0)
#else
#define SKINNY_VERIFY(REFCALL) do {} while (0)
#endif
__device__ __forceinline__ void ctx_gateup_item(const Params& P, int e, int j, LAS unsigned char* lds) {
    const bf16_t* H2 = (const bf16_t*)(P.ws + WS_H); const int* IDXC = (const int*)(P.ws + WS_IDXC); bf16_t* HID = (bf16_t*)(P.ws + WS_HID) + (size_t)(128 + e) * 256 * 1024;
    const bf16_t* W = (const bf16_t*)(P.ws + WS_WGU) + ((size_t)e * 2048 + (j >> 1) * 256 + (j & 1) * 64) * 1024;
    skinny32_mma(H2 + (size_t)IDXC[e * CAPC + (otid() >> 5)] * 1024, H2 + (size_t)IDXC[e * CAPC + 16 + (otid() >> 5)] * 1024, W, W + 32 * 1024, W + 128 * 1024, W + 160 * 1024, lds);
    SKINNY_VERIFY(skinny32_mma_ref(H2 + (size_t)IDXC[e * CAPC + (otid() & 31)] * 1024, W, W + 32 * 1024, W + 128 * 1024, W + 160 * 1024, lds));
    const int tid = otid();
#pragma unroll
    for (int q = 0; q < 4; ++q) { const int o = tid * 4 + q, row = o >> 6, col = o & 63;
        const float g = skinny32_get(lds, col >> 5, row, col & 31), u = skinny32_get(lds, 2 + (col >> 5), row, col & 31);
        HID[(size_t)row * 1024 + 64 * j + col] = (bf16_t)f2bf(g * __builtin_amdgcn_rcpf(1.0f + __expf(-g)) * u); }
    lds_barrier();
}
__device__ __forceinline__ void ctx_down_item(const Params& P, int e, int j, LAS unsigned char* lds) {
    const bf16_t* HID = (const bf16_t*)(P.ws + WS_HID) + (size_t)(128 + e) * 256 * 1024; bf16_t* YE = (bf16_t*)(P.ws + WS_YE) + (size_t)(128 + e) * 256 * 1024;
    const bf16_t* W = (const bf16_t*)(P.ws + WS_WD) + ((size_t)e * 1024 + 128 * j) * 1024; const float* gatec = (const float*)(P.ws + WS_GATEC) + e * CAPC;
    skinny32_mma(HID + (size_t)(otid() >> 5) * 1024, HID + (size_t)(16 + (otid() >> 5)) * 1024, W, W + 32 * 1024, W + 64 * 1024, W + 96 * 1024, lds);
    SKINNY_VERIFY(skinny32_mma_ref(HID + (size_t)(otid() & 31) * 1024, W, W + 32 * 1024, W + 64 * 1024, W + 96 * 1024, lds));
    const int tid = otid();
    const float gq = gatec[(tid * 8) >> 7];
#pragma unroll
    for (int q = 0; q < 8; ++q) { const int o = tid * 8 + q, row = o >> 7, col = o & 127;
        YE[(size_t)row * 1024 + 128 * j + col] = (bf16_t)f2bf(skinny32_get(lds, col >> 5, row, col & 31) * gq); }
    lds_barrier();
}
__device__ __forceinline__ void ctx_wout_item(const Params& P, int rb, int cb, LAS unsigned char* lds) {
    const bf16_t* MIX = (const bf16_t*)(P.ws + WS_MIX) + (size_t)rb * 32 * 1024; const bf16_t* W = (const bf16_t*)(P.ws + WS_WOUT) + (size_t)cb * 128 * 1024;
    float* XL = (float*)(P.ws + WS_XL); const float* g1c = (const float*)(P.ws + WS_MOD) + (0 * 2 + 1) * 6144 + 2048;
    skinny32_mma(MIX + (size_t)(otid() >> 5) * 1024, MIX + (size_t)(16 + (otid() >> 5)) * 1024, W, W + 32 * 1024, W + 64 * 1024, W + 96 * 1024, lds);
    SKINNY_VERIFY(skinny32_mma_ref(MIX + (size_t)(otid() & 31) * 1024, W, W + 32 * 1024, W + 64 * 1024, W + 96 * 1024, lds));
    const int tid = otid();
    {   const int o0 = tid * 8, row = o0 >> 7, col0 = 128 * cb + (o0 & 127); const size_t gi0 = (size_t)(32 * rb + row) * 1024 + col0;
        const v4f c0 = *(const v4f*)(P.ctx + gi0), c1 = *(const v4f*)(P.ctx + gi0 + 4), g0 = *(const v4f*)(g1c + col0), g1 = *(const v4f*)(g1c + col0 + 4);
        v4f r0, r1;
#pragma unroll
        for (int q = 0; q < 4; ++q) { r0[q] = c0[q] + g0[q] * skinny32_get(lds, ((o0 + q) & 127) >> 5, row, (o0 + q) & 31); r1[q] = c1[q] + g1[q] * skinny32_get(lds, ((o0 + 4 + q) & 127) >> 5, row, (o0 + 4 + q) & 31); }
        *(v4f*)(XL + gi0) = r0; *(v4f*)(XL + gi0 + 4) = r1; }
    lds_barrier();
}
typedef const __attribute__((address_space(4))) unsigned long long* kargp_t;
#define GRID_SYNC() do { volatile LAS unsigned* bs_ = (volatile LAS unsigned*)((LAS unsigned char*)lds_raw + LDS_BYTES - 64); XcdBarrier xb_; \
    xb_.bar = (unsigned*)(((unsigned long long)bs_[3] << 32) | (unsigned long long)bs_[2]); xb_.x = bs_[4]; xb_.st = bs_; xcd_barrier(xb_); } while (0)
#ifndef PROBE_MASK
#define PROBE_MASK 0
#endif
#define REP(k) for (int rep_ = 0; rep_ < 1 + ((PROBE_MASK >> (k)) & 1); ++rep_)
#define PH_BEGIN() Params P; { kargp_t q_ = kp; asm volatile("" : "+s"(q_)); _Pragma("unroll") for (int i_ = 0; i_ < (int)(sizeof(Params) / 8); ++i_) ((unsigned long long*)&P)[i_] = q_[i_]; } \
    unsigned char* ws = P.ws; (void)ws; const int tid = otid(), wave = __builtin_amdgcn_readfirstlane(tid >> 6); (void)wave; \
    int G_ = gridDim.x, bx_ = blockIdx.x; asm volatile("" : "+s"(G_), "+s"(bx_)); const int G = G_, bx = bx_; const int vcu = (G % 8 == 0) ? (bx % 8) * (G / 8) + bx / 8 : bx; const int gw = vcu * 8 + wave, NGW = G * 8; (void)gw; (void)NGW; \
    LAS unsigned char* lds = (LAS unsigned char*)lds_raw; (void)lds;
__global__ void __launch_bounds__(512, 2) fwd_megakernel(Params Parg) {
    extern __shared__ __attribute__((aligned(16))) unsigned char lds_raw[];
    cg::grid_group grid = cg::this_grid();
    const kargp_t kp = (kargp_t)__builtin_amdgcn_kernarg_segment_ptr();
    volatile LAS unsigned* bst = (volatile LAS unsigned*)((LAS unsigned char*)lds_raw + LDS_BYTES - 64);
    if (otid() < 2) bst[otid()] = 0u;
    __syncthreads();
    { kargp_t q_ = kp; asm volatile("" : "+s"(q_)); const XcdBarrier xb0 = xcd_barrier_post((unsigned*)((unsigned char*)q_[29] + WS_CTL) + 1024, bst);
      if (otid() == 0) { const unsigned long long pb = (unsigned long long)xb0.bar; bst[2] = (unsigned)pb; bst[3] = (unsigned)(pb >> 32); bst[4] = xb0.x; } }
    __syncthreads();
    REP(0) { PH_BEGIN(); phase0(P, lds, vcu, G); }
    grid.sync();
    { PH_BEGIN(); phase_norm1_l0(P, gw, NGW); }
    GRID_SYNC();
    for (int l = 0; l < 2; ++l) {
        asm volatile("" : "+s"(l));
        REP(1) {
            PH_BEGIN(); pg8::Gemm g{(const bf16_t*)(ws + WS_H), (const bf16_t*)(ws + WS_WIN), NR, INP, 1024}; pg8::GridOrder S{NR / 256, INP / 256, G, vcu, 0}; pg8::EpiPlainBf16 E{(bf16_t*)(ws + WS_PROJ), INP};
            pg8::gemm_phase<pg8::EpiPlainBf16, pg8::GridOrder, true, true>(lds, g, S, E); }
        GRID_SYNC();
        REP(2) {
            PH_BEGIN();
            for (int it = vcu; it < 4 * NCHUNK + NCHUNK; it += G) { if (it < 4 * NCHUNK) { REP(11) lru_item(P, l, it >> 2, it & 3, lds); } else { REP(12) sgu_item(P, l, it - 4 * NCHUNK, lds); } }
            REP(13) phase3_rows(P, l, gw, NGW); }
        GRID_SYNC();
        REP(3) {
            PH_BEGIN(); const float* cosT = (const float*)(ws + WS_ROPE);
            pg8::Gemm g{(const bf16_t*)(ws + WS_CQN), (const bf16_t*)(ws + WS_WUQ), NR, 768, QLR}; pg8::GridOrder S{NR / 256, 3, G, vcu, 0}; pg8::EpiQRope E{ws + WS_Q, cosT, cosT + 4096, att::QSCALE * att::QFP8};
            pg8::gemm_phase<pg8::EpiQRope, pg8::GridOrder, true, true>(lds, g, S, E); }
        REP(3) {
            PH_BEGIN(); pg8::Gemm g{(const bf16_t*)(ws + WS_CKVN), (const bf16_t*)(ws + WS_WUKV), NR, 512, KVLR}; pg8::GridOrder S{NR / 256, 2, G, G - 1 - vcu, 0}; pg8::EpiK8 E{ws + WS_KN, att::KFP8};
            pg8::gemm_phase<pg8::EpiK8, pg8::GridOrder, true, true>(lds, g, S, E); }
        REP(3) {
            PH_BEGIN(); pg8::Gemm g{(const bf16_t*)(ws + WS_WUKV) + 512 * KVLR, (const bf16_t*)(ws + WS_CKVN), 512, NR, KVLR}; pg8::GridOrder S{2, NR / 256, G, (125 - vcu + 2 * G) % G, 0}; pg8::EpiVT E{ws + WS_V};
            pg8::gemm_phase<pg8::EpiVT, pg8::GridOrder, true, true>(lds, g, S, E); }
        REP(3) {
            PH_BEGIN(); const int n0 = (l == 0 ? 0 : 2); for (int it = G - 1 - vcu; it < 2 * (NCHUNK - n0); it += G) lru_apply_item(P, n0 + (it >> 1), it & 1, lds); }
        GRID_SYNC();
        REP(4) {
            PH_BEGIN(); const unsigned char* Q = ws + WS_Q; const unsigned char* KN = ws + WS_KN; const unsigned char* VT = ws + WS_V; const unsigned char* KR = ws + WS_KR; bf16_t* MIX = (bf16_t*)(ws + WS_MIX);
            for (int u = vcu; u < 256 + (l == 0 ? 4 : 0); u += G) {
                const int h = (u < 256) ? (u >> 6) : (u - 256); const size_t r0 = (u < 256) ? (size_t)(NCTX + 256 * (u & 63)) : 0; const int nkeys = (u < 256) ? NR : NCTX;
                att::attn_body<1>(Q + r0 * 768 + h * 192, KN + (size_t)h * NR * 128, KR, VT + (size_t)h * 128 * NR, NR, MIX + r0 * 1024 + 512 + h * 128, nkeys, (char*)lds_raw); } }
#ifdef PROBE_ATTN_ABL
        {
            PH_BEGIN(); const unsigned char* Q = ws + WS_Q; const unsigned char* KN = ws + WS_KN; const unsigned char* VT = ws + WS_V; const unsigned char* KR = ws + WS_KR; bf16_t* SCR = (bf16_t*)(ws + WS_HL);
            for (int u = vcu; u < 256; u += G) { const int h = u >> 6; const size_t r0 = (size_t)(NCTX + 256 * (u & 63));
                att::attn_body<1, PROBE_ATTN_ABL>(Q + r0 * 768 + h * 192, KN + (size_t)h * NR * 128, KR, VT + (size_t)h * 128 * NR, NR, SCR + r0 * 1024 + 512 + h * 128, NR, (char*)lds_raw); } }
#endif
        GRID_SYNC();
        for (int rep_ = 0; rep_ < 1 + (((PROBE_MASK >> 5) & 1) && l == 0); ++rep_) {
            PH_BEGIN(); float* XL = (float*)(ws + WS_XL); const float* MOD = (const float*)(ws + WS_MOD);
            pg8::Gemm g{(const bf16_t*)(ws + WS_MIX), (const bf16_t*)(ws + WS_WOUT), NR, 1024, 1024}; pg8::GridOrder S{64, 4, G, vcu, 1};
            pg8::EpiResid E{l == 0 ? P.ctx : XL, l == 0 ? P.x : XL + (size_t)NCTX * 1024, XL, MOD + (l * 2 + 0) * 6144 + 2048, MOD + (l * 2 + 1) * 6144 + 2048};
            pg8::gemm_phase<pg8::EpiResid, pg8::GridOrder, true, true>(lds, g, S, E);
            if (l == 0) for (int it = G - 1 - vcu; it < 64; it += G) ctx_wout_item(P, it >> 3, it & 7, lds); }
        GRID_SYNC();
        REP(6) { PH_BEGIN(); phase_norm2_router(P, l, lds, vcu, G); }
#ifdef FP8_CHECK
        if (l == FP8_CHECK - 1) { PH_BEGIN(); if (vcu == 0) fp8_selftest(P, l); }
#endif
#ifdef PROBE_P7
        { PH_BEGIN(); phase_p7_probe<PROBE_P7>(P, l, lds, gw, NGW); }
#endif
        GRID_SYNC();
        REP(7) { PH_BEGIN(); for (int it = vcu; it < (l == 0 ? 32 : 16); it += G) topk_item(P, it & 15, it >> 4, lds); }
        GRID_SYNC();
        REP(9) {   PH_BEGIN(); pg8::Gemm g{(const bf16_t*)(ws + WS_H), (const bf16_t*)(ws + WS_WGU), 144 * 256, 0, 1024, (const int*)(ws + WS_IDX)}; pg8::MoeOrder S{8, G, vcu, 0}; pg8::EpiSwiglu E{(bf16_t*)(ws + WS_HID)};
            pg8::gemm_phase<pg8::EpiSwiglu, pg8::MoeOrder, true, true, true>(lds, g, S, E);
            if (l == 0) for (int it = vcu; it < 256; it += G) ctx_gateup_item(P, it >> 4, it & 15, lds); }
        GRID_SYNC();
        REP(10) {   PH_BEGIN(); pg8::Gemm g{(const bf16_t*)(ws + WS_HID), (const bf16_t*)(ws + WS_WD), 144 * 256, 0, 1024}; pg8::MoeOrder S{4, G, vcu, 0}; pg8::EpiDown E{(bf16_t*)(ws + WS_YE), (const float*)(ws + WS_GATE), (const float*)(ws + WS_GATEC)};
            pg8::gemm_phase<pg8::EpiDown, pg8::MoeOrder, true, true>(lds, g, S, E);
            if (l == 0) for (int it = G - 1 - vcu; it < 128; it += G) ctx_down_item(P, it >> 3, it & 7, lds); }
        GRID_SYNC();
        { PH_BEGIN(); phase_combine(P, l, gw, NGW); if (l == 0) convert_weights(P, lds, 1, vcu, G); }
        if (l == 0) GRID_SYNC();
    }
}

extern "C" void kernel_launch(void* const* d_in, const int* in_sizes, int n_in, void* d_out, int out_size, void* d_ws, size_t ws_size, hipStream_t stream) {
    static int grid = 0;
    if (grid == 0) {
        if (n_in != 28 || out_size != SEQ * DM || ws_size < WS_END) { fprintf(stderr, "kernel_launch: unexpected shapes (n_in %d out %d ws %zu, need ws >= %zu); nothing launched\n", n_in, out_size, ws_size, (size_t)WS_END); grid = -1; return; }
        int dev = 0, cus = 0, per_cu = 0;
        hipGetDevice(&dev); hipDeviceGetAttribute(&cus, hipDeviceAttributeMultiprocessorCount, dev);
        if (hipFuncSetAttribute((const void*)fwd_megakernel, hipFuncAttributeMaxDynamicSharedMemorySize, LDS_BYTES) != hipSuccess) { fprintf(stderr, "kernel_launch: hipFuncSetAttribute failed\n"); grid = -1; return; }
        if (hipOccupancyMaxActiveBlocksPerMultiprocessor(&per_cu, (const void*)fwd_megakernel, 512, LDS_BYTES) != hipSuccess || per_cu < 1) { fprintf(stderr, "kernel_launch: occupancy query failed (%d)\n", per_cu); (void)hipGetLastError(); per_cu = 1; }
        grid = cus;
        if (grid > cus * per_cu) grid = cus * per_cu;
        if (grid > 256) grid = 256;
    }
    if (grid < 0) return;
    Params p{};
    const float** pp = (const float**)&p;
    for (int i = 0; i < 28; ++i) pp[i] = (const float*)d_in[i];
    p.out = (float*)d_out; p.ws = (unsigned char*)d_ws;
    (void)hipMemsetAsync((char*)d_ws + WS_CTL, 0, 1 * MiB, stream);
    void* args[] = {&p};
    const hipError_t e = hipLaunchCooperativeKernel((const void*)fwd_megakernel, dim3(grid), dim3(512), args, LDS_BYTES, stream);
    if (e != hipSuccess) fprintf(stderr, "kernel_launch: cooperative launch failed: %s (grid %d)\n", hipGetErrorString(e), grid);
}
```

```cpp
#include <hip/hip_runtime.h>
#include <hip/hip_cooperative_groups.h>
#include <hip/hip_bf16.h>
#include <cstdio>
#include <cstdint>
namespace cg = cooperative_groups;
__device__ __forceinline__ int otid() { int t = threadIdx.x; asm volatile("" : "+v"(t)); return t; }
namespace pg8 {
#define PG8_LAS __attribute__((address_space(3)))
typedef unsigned short bf16_t;
typedef short bf16x8 __attribute__((ext_vector_type(8)));
typedef float f32x4 __attribute__((ext_vector_type(4)));
typedef unsigned u32x4 __attribute__((ext_vector_type(4)));
constexpr int BM = 256, BK = 64, HALF = 128, HTB = HALF * BK * 2  , STAGE_BYTES = 8 * HTB, NXCD = 8, WGM = 8;

__host__ __device__ __forceinline__ int lds_byte(int r, int c) { const int st = (r >> 4) * 2 + (c >> 5), rr = r & 15, cc = c & 31, ob = rr * 64 + cc * 2; return st * 1024 + (ob ^ (((ob >> 9) & 1) << 5)); }
__host__ __device__ __forceinline__ void stage_rc(int b, int& R, int& C) { const int st = b / 1024, sb = b % 1024, swz = sb ^ (((sb >> 9) & 1) << 5); R = (st >> 1) * 16 + swz / 64; C = (st & 1) * 32 + (swz % 64) / 2; }
__host__ __device__ __forceinline__ int perm32(int rho) { const int n = rho >> 4, i = rho & 15; return 8 * (i >> 2) + 4 * n + (i & 3); }

struct Unit { int pm, pn; };
struct Gemm { const bf16_t* A; const bf16_t* Bt; int M, N, K; const int* ridx; };

struct StaticOrder {
    int nM, nN, nwg, G, c;
    __host__ __device__ void init(int M, int N, int G_, int c_) { nM = M / BM; nN = N / BM; nwg = nM * nN; G = G_; c = c_; }
    __host__ __device__ bool next(int i, Unit& u) const {
        const long L = (long)i * G + c; if (L >= nwg) return false;
        int wgid = (int)L; { const int q = nwg / NXCD, r = nwg % NXCD, xcd = wgid % NXCD, off = wgid / NXCD; wgid = (xcd < r ? xcd * (q + 1) : r * (q + 1) + (xcd - r) * q) + off; }
        const int nig = WGM * nN, gid = wgid / nig, fm = gid * WGM, gsz = (nM - fm) < WGM ? (nM - fm) : WGM;
        u.pm = fm + ((wgid % nig) % gsz); u.pn = (wgid % nig) / gsz; return true;
    }
    __device__ __forceinline__ void a_ready(const Unit&) const {}
    __device__ __forceinline__ void done(const Unit&) const {}
};

__device__ __forceinline__ unsigned cvt_pk_bf16(float lo, float hi) { unsigned r; asm volatile("v_cvt_pk_bf16_f32 %0, %1, %2" : "=v"(r) : "v"(lo), "v"(hi)); return r; }
typedef float f32x2 __attribute__((ext_vector_type(2)));
typedef unsigned u32x2 __attribute__((ext_vector_type(2)));
struct GridOrder {
    int nM, nN, G, c, pm0;
    __device__ __forceinline__ bool next(int i, Unit& u) const {
        const int L = i * G + c; if (L >= nM * nN) return false;
        const int nig = 8 * nN, gid = L / nig, fm = gid * 8, gsz = (nM - fm) < 8 ? (nM - fm) : 8, w = L % nig;
        u.pm = pm0 + fm + (w % gsz); u.pn = w / gsz; return true;
    }
    __device__ __forceinline__ void a_ready(const Unit&) const {}
    __device__ __forceinline__ void done(const Unit&) const {}
};
struct MoeOrder {
    int ncol, G, c, nctx;
    __device__ __forceinline__ bool next(int i, Unit& u) const {
        const int L = i * G + c, per = 8 * ncol, nlat = 16 * per;
        if (L < nlat) { const int e = L / per, w = L % per; u.pm = e * 8 + (w & 7); u.pn = e * ncol + (w >> 3); return true; }
        const int L2 = L - nlat; if (L2 >= nctx * ncol) return false;
        const int e = L2 / ncol; u.pm = 128 + e; u.pn = e * ncol + (L2 % ncol); return true;
    }
    __device__ __forceinline__ void a_ready(const Unit&) const {}
    __device__ __forceinline__ void done(const Unit&) const {}
};
struct EpiPlainBf16 {
    static constexpr bool PERM = true, AFTER_DRAIN = false;
    bf16_t* O; int ldc;
    __device__ __forceinline__ void operator()(const f32x4 (&acc)[2][2][4][2], const Unit& u, int wr, int wc, int fr, int fq) const {
        const int row0 = u.pm * BM + wr * 64 + fr, col0 = u.pn * BM + wc * 32 + 8 * fq;
#pragma unroll
        for (int ai = 0; ai < 2; ++ai)
#pragma unroll
            for (int m = 0; m < 4; ++m) { bf16_t* rowp = O + (size_t)(row0 + ai * HALF + m * 16) * ldc + col0;
#pragma unroll
                for (int bj = 0; bj < 2; ++bj) { const f32x4 v0 = acc[ai][bj][m][0], v1 = acc[ai][bj][m][1];
                    u32x4 w; w.x = cvt_pk_bf16(v0[0], v0[1]); w.y = cvt_pk_bf16(v0[2], v0[3]); w.z = cvt_pk_bf16(v1[0], v1[1]); w.w = cvt_pk_bf16(v1[2], v1[3]);
                    *(u32x4*)(rowp + bj * HALF) = w; } }
    }
};
__device__ __forceinline__ unsigned pk4_fp8(f32x4 v) {
    const float a = __builtin_amdgcn_fmed3f(v[0], -448.f, 448.f), b = __builtin_amdgcn_fmed3f(v[1], -448.f, 448.f), c = __builtin_amdgcn_fmed3f(v[2], -448.f, 448.f), d = __builtin_amdgcn_fmed3f(v[3], -448.f, 448.f);
    int w = __builtin_amdgcn_cvt_pk_fp8_f32(a, b, 0, false); w = __builtin_amdgcn_cvt_pk_fp8_f32(c, d, w, true); return (unsigned)w; }
struct EpiK8 {
    static constexpr bool PERM = false, AFTER_DRAIN = false;
    static constexpr int rows = 16640;
    unsigned char* K8; float ksc;
    __device__ __forceinline__ void operator()(const f32x4 (&acc)[2][2][4][2], const Unit& u, int wr, int wc, int fr, int fq) const {
#pragma unroll
        for (int ai = 0; ai < 2; ++ai)
#pragma unroll
            for (int m = 0; m < 4; ++m) { const int row = u.pm * BM + ai * HALF + wr * 64 + m * 16 + fr;
#pragma unroll
                for (int bj = 0; bj < 2; ++bj) { u32x2 w; w.x = pk4_fp8(acc[ai][bj][m][0] * ksc); w.y = pk4_fp8(acc[ai][bj][m][1] * ksc);
                    *(u32x2*)(K8 + ((size_t)(2 * u.pn + bj) * rows + row) * 128 + wc * 32 + 8 * fq) = w; } }
    }
};
struct EpiVT {
    static constexpr bool PERM = true, AFTER_DRAIN = false;
    static constexpr int rows = 16640;
    unsigned char* VT;
    __device__ __forceinline__ void operator()(const f32x4 (&acc)[2][2][4][2], const Unit& u, int wr, int wc, int fr, int fq) const {
#pragma unroll
        for (int ai = 0; ai < 2; ++ai)
#pragma unroll
            for (int m = 0; m < 4; ++m) { unsigned char* rowp = VT + (size_t)(u.pm * BM + ai * HALF + wr * 64 + m * 16 + fr) * rows;
#pragma unroll
                for (int bj = 0; bj < 2; ++bj) { const int key = u.pn * BM + bj * HALF + wc * 32 + 8 * fq, off = (key & ~63) + 4 * ((key & 63) >> 3);
                    *(unsigned*)(rowp + off) = pk4_fp8(acc[ai][bj][m][0]); *(unsigned*)(rowp + off + 32) = pk4_fp8(acc[ai][bj][m][1]); } }
    }
};
struct EpiQRope {
    static constexpr bool PERM = false, AFTER_DRAIN = false;
    unsigned char* Q; const float* cosT; const float* sinT; float qscale;
    __device__ __forceinline__ void operator()(const f32x4 (&acc)[2][2][4][2], const Unit& u, int wr, int wc, int fr, int fq) const {
        const int w0 = (u.pn * BM + wc * 32) % 192, w1 = (u.pn * BM + HALF + wc * 32) % 192; const bool rot0 = w0 >= 128, rot1 = w1 >= 128, anyrot = (rot0 || rot1) && u.pm != 0;
#pragma unroll
        for (int ai = 0; ai < 2; ++ai) { f32x4 cs[4][2], sn[4][2];
            if (anyrot) {
#pragma unroll
                for (int m = 0; m < 4; ++m) { const int row = u.pm * BM + ai * HALF + wr * 64 + m * 16 + fr, t = row >= 256 ? row - 256 : 0;
                    const int p0 = (w0 >= 160) ? (t & 63) : (t >> 6), p1 = (w1 >= 160) ? (t & 63) : (t >> 6);
                    cs[m][0] = *(const f32x4*)(cosT + p0 * 16 + 4 * fq); sn[m][0] = *(const f32x4*)(sinT + p0 * 16 + 4 * fq); cs[m][1] = *(const f32x4*)(cosT + p1 * 16 + 4 * fq); sn[m][1] = *(const f32x4*)(sinT + p1 * 16 + 4 * fq); } }
#pragma unroll
            for (int m = 0; m < 4; ++m) { const int row = u.pm * BM + ai * HALF + wr * 64 + m * 16 + fr; unsigned char* rowp = Q + (size_t)row * 768;
#pragma unroll
                for (int bj = 0; bj < 2; ++bj) { const int cb = u.pn * BM + bj * HALF + wc * 32; const bool rot = (bj ? rot1 : rot0) && row >= 256;
                    f32x4 o0 = acc[ai][bj][m][0], o1 = acc[ai][bj][m][1];
                    if (rot) { const f32x4 x1 = o0, x2 = o1; o0 = x1 * cs[m][bj] - x2 * sn[m][bj]; o1 = x2 * cs[m][bj] + x1 * sn[m][bj]; }
                    o0 = o0 * qscale; o1 = o1 * qscale;
                    u32x2 w; w.x = pk4_fp8(o0); w.y = pk4_fp8(o1);
                    *(u32x2*)(rowp + cb + 8 * fq) = w; } } }
    }
};
struct EpiResid {
    static constexpr bool PERM = false, AFTER_DRAIN = false;
    const float* src_ctx; const float* src_lat; float* XL; const float* g_lat; const float* g_ctx;
    __device__ __forceinline__ void operator()(const f32x4 (&acc)[2][2][4][2], const Unit& u, int wr, int wc, int fr, int fq) const {
        const float* g = (u.pm == 0) ? g_ctx : g_lat;
        const int col0 = u.pn * BM + wc * 32 + 4 * fq;
        f32x4 gv[2][2];
#pragma unroll
        for (int bj = 0; bj < 2; ++bj)
#pragma unroll
            for (int n = 0; n < 2; ++n) gv[bj][n] = *(const f32x4*)(g + col0 + bj * HALF + n * 16);
#pragma unroll
        for (int ai = 0; ai < 2; ++ai) { f32x4 bs[4][2][2];
#pragma unroll
            for (int m = 0; m < 4; ++m) { const int row = u.pm * BM + ai * HALF + wr * 64 + m * 16 + fr;
                const float* sp = (u.pm == 0) ? src_ctx + (size_t)row * 1024 : src_lat + (size_t)(row - 256) * 1024;
#pragma unroll
                for (int bj = 0; bj < 2; ++bj)
#pragma unroll
                    for (int n = 0; n < 2; ++n) bs[m][bj][n] = *(const f32x4*)(sp + col0 + bj * HALF + n * 16); }
#pragma unroll
            for (int m = 0; m < 4; ++m) { const int row = u.pm * BM + ai * HALF + wr * 64 + m * 16 + fr; float* op = XL + (size_t)row * 1024;
#pragma unroll
                for (int bj = 0; bj < 2; ++bj)
#pragma unroll
                    for (int n = 0; n < 2; ++n) *(f32x4*)(op + col0 + bj * HALF + n * 16) = bs[m][bj][n] + gv[bj][n] * acc[ai][bj][m][n]; } }
    }
};
__device__ __forceinline__ float silu_f(float x) { return x * __builtin_amdgcn_rcpf(1.0f + __expf(-x)); }
struct EpiSwiglu {
    static constexpr bool PERM = true, AFTER_DRAIN = false;
    bf16_t* HID;
    __device__ __forceinline__ void operator()(const f32x4 (&acc)[2][2][4][2], const Unit& u, int wr, int wc, int fr, int fq) const {
        const int row0 = u.pm * BM + wr * 64 + fr, col0 = (u.pn & 7) * 128 + wc * 32 + 8 * fq;
#pragma unroll
        for (int ai = 0; ai < 2; ++ai)
#pragma unroll
            for (int m = 0; m < 4; ++m) { bf16_t* rowp = HID + (size_t)(row0 + ai * HALF + m * 16) * 1024 + col0;
                const f32x4 g0 = acc[ai][0][m][0], g1 = acc[ai][0][m][1], u0 = acc[ai][1][m][0], u1 = acc[ai][1][m][1];
                u32x4 w; w.x = cvt_pk_bf16(silu_f(g0[0]) * u0[0], silu_f(g0[1]) * u0[1]); w.y = cvt_pk_bf16(silu_f(g0[2]) * u0[2], silu_f(g0[3]) * u0[3]);
                w.z = cvt_pk_bf16(silu_f(g1[0]) * u1[0], silu_f(g1[1]) * u1[1]); w.w = cvt_pk_bf16(silu_f(g1[2]) * u1[2], silu_f(g1[3]) * u1[3]);
                *(u32x4*)rowp = w; }
    }
};
struct EpiDown {
    static constexpr bool PERM = true, AFTER_DRAIN = false;
    bf16_t* YE; const float* gate; const float* gatec;
    __device__ __forceinline__ void operator()(const f32x4 (&acc)[2][2][4][2], const Unit& u, int wr, int wc, int fr, int fq) const {
        const int col0 = (u.pn & 3) * BM + wc * 32 + 8 * fq;
        float gvs[2][4];
#pragma unroll
        for (int ai = 0; ai < 2; ++ai)
#pragma unroll
            for (int m = 0; m < 4; ++m) { const int rt = ai * HALF + wr * 64 + m * 16 + fr; gvs[ai][m] = (u.pm < 128) ? gate[u.pm * BM + rt] : gatec[(u.pm - 128) * 32 + (rt & 31)] * (rt < 32 ? 1.f : 0.f); }
#pragma unroll
        for (int ai = 0; ai < 2; ++ai)
#pragma unroll
            for (int m = 0; m < 4; ++m) { const int rt = ai * HALF + wr * 64 + m * 16 + fr;
                const float gv = gvs[ai][m];
                bf16_t* rowp = YE + (size_t)(u.pm * BM + rt) * 1024 + col0;
#pragma unroll
                for (int bj = 0; bj < 2; ++bj) { const f32x4 v0 = acc[ai][bj][m][0] * gv, v1 = acc[ai][bj][m][1] * gv;
                    u32x4 w; w.x = cvt_pk_bf16(v0[0], v0[1]); w.y = cvt_pk_bf16(v0[2], v0[3]); w.z = cvt_pk_bf16(v1[0], v1[1]); w.w = cvt_pk_bf16(v1[2], v1[3]);
                    *(u32x4*)(rowp + bj * HALF) = w; } }
    }
};
template <class Epi, class Sched, bool ALIGN_EPI = false, bool SP2 = false, bool GATHER = false>
__device__ __forceinline__ void gemm_phase(PG8_LAS unsigned char* lds, const Gemm g, const Sched& S, const Epi& E) {
    const int tid = otid(), wid = __builtin_amdgcn_readfirstlane(tid >> 6), lane = tid & 63, wr = wid >> 2, wc = wid & 3, fr = lane & 15, fq = lane >> 4;
    const int K = g.K, nt = K / BK;
    unsigned voffA[2], voffB[2];
#pragma unroll
    for (int i = 0; i < 2; ++i) { int R, C; stage_rc(tid * 16 + i * 8192, R, C); const int Rb = Epi::PERM ? ((R & ~31) + perm32(R & 31)) : R;
        voffA[i] = (unsigned)(R * K + C) * 2u; voffB[i] = (unsigned)(Rb * K + C) * 2u; }
    int rcR[2], rcC[2];
#pragma unroll
    for (int i = 0; i < 2; ++i) stage_rc(tid * 16 + i * 8192, rcR[i], rcC[i]);
    unsigned curA[2][2], nxtA[2][2];
#define PG8_GIDX(dst, unit) do { if constexpr (GATHER) { _Pragma("unroll") for (int h_ = 0; h_ < 2; ++h_) _Pragma("unroll") for (int i_ = 0; i_ < 2; ++i_) \
        dst[h_][i_] = ((unsigned)g.ridx[(unit).pm * BM + h_ * HALF + rcR[i_]] * (unsigned)K + (unsigned)rcC[i_]) * 2u; } } while (0)
#define PG8_STAGE_A(bufoff, gbase, h, usenext) do { if constexpr (GATHER) { _Pragma("unroll") for (int _i = 0; _i < 2; ++_i) \
        __builtin_amdgcn_global_load_lds((const unsigned*)((const char*)(gbase) + ((usenext) ? nxtA[h][_i] : curA[h][_i])), (PG8_LAS unsigned*)(lds + (bufoff) + ldsw + _i * 8192), 16, 0, 0); } \
        else { PG8_STAGE(bufoff, (gbase) + (h) * hstep, voffA); } } while (0)
    const size_t kstep = (size_t)(BK * 2);
    const size_t hstep = (size_t)HALF * K * 2;
    const size_t tstep = 2 * hstep;
    const unsigned ldsw = (unsigned)wid * 1024u;
    const int aoff = lds_byte(wr * 64 + fr, fq * 8), boff = lds_byte(wc * 32 + fr, fq * 8);
#define PG8_SA(b, h) (((b) * 2 + (h)) * HTB)
#define PG8_SB(b, h) ((4 + (b) * 2 + (h)) * HTB)
#define PG8_STAGE(bufoff, gbase, voff) do { _Pragma("unroll") for (int _i = 0; _i < 2; ++_i) \
        __builtin_amdgcn_global_load_lds((const unsigned*)((const char*)(gbase) + (voff)[_i]), (PG8_LAS unsigned*)(lds + (bufoff) + ldsw + _i * 8192), 16, 0, 0); } while (0)
#define PG8_LDA(dst, b, h) do { _Pragma("unroll") for (int m = 0; m < 4; ++m) _Pragma("unroll") for (int k = 0; k < 2; ++k) dst[m][k] = *(const PG8_LAS bf16x8*)(lds + PG8_SA(b, h) + aoff + m * 2048 + k * 1024); } while (0)
#define PG8_LDB(dst, b, h) do { _Pragma("unroll") for (int n = 0; n < 2; ++n) _Pragma("unroll") for (int k = 0; k < 2; ++k) dst[n][k] = *(const PG8_LAS bf16x8*)(lds + PG8_SB(b, h) + boff + n * 2048 + k * 1024); } while (0)
#define PG8_MMA(ai, bj, At, Bt) do { __builtin_amdgcn_s_setprio(1); _Pragma("unroll") for (int m = 0; m < 4; ++m) _Pragma("unroll") for (int n = 0; n < 2; ++n) _Pragma("unroll") for (int k = 0; k < 2; ++k) \
        acc[ai][bj][m][n] = __builtin_amdgcn_mfma_f32_16x16x32_bf16(Bt[n][k], At[m][k], acc[ai][bj][m][n], 0, 0, 0); __builtin_amdgcn_s_setprio(0); } while (0)
#define PG8_WAIT_V(n) asm volatile("s_waitcnt vmcnt(" #n ")" ::: "memory")
#define PG8_WAIT_L(n) asm volatile("s_waitcnt lgkmcnt(" #n ")" ::: "memory")
#define PG8_BAR __builtin_amdgcn_s_barrier()
#define PG8_SCHED __builtin_amdgcn_sched_barrier(0)
    Unit cur, nxt; int ui = 0;
    if (!S.next(0, cur)) return;
    f32x4 acc[2][2][4][2];
#pragma unroll
    for (int a = 0; a < 2; ++a)
#pragma unroll
        for (int b = 0; b < 2; ++b)
#pragma unroll
            for (int m = 0; m < 4; ++m)
#pragma unroll
                for (int n = 0; n < 2; ++n) acc[a][b][m][n] = (f32x4){0.f, 0.f, 0.f, 0.f};
    bf16x8 At[4][2], B0[2][2], B1[2][2];
    const char* cA = (const char*)g.A + (GATHER ? (size_t)0 : (size_t)cur.pm * tstep); const char* cB = (const char*)g.Bt + (size_t)cur.pn * tstep;
    PG8_GIDX(curA, cur);
    S.a_ready(cur);
    if constexpr (SP2) {
        PG8_STAGE(PG8_SB(0, 0), cB, voffB); PG8_STAGE(PG8_SB(0, 1), cB + hstep, voffB); PG8_STAGE_A(PG8_SA(0, 0), cA, 0, false); PG8_STAGE_A(PG8_SA(0, 1), cA, 1, false);
        if (wr == 1) PG8_BAR;
        PG8_WAIT_V(2); PG8_BAR;
        PG8_STAGE(PG8_SB(1, 0), cB + kstep, voffB); PG8_STAGE_A(PG8_SA(1, 0), cA + kstep, 0, false); PG8_STAGE(PG8_SB(1, 1), cB + hstep + kstep, voffB);
        PG8_WAIT_V(6); PG8_BAR;
    } else {
        PG8_STAGE(PG8_SB(0, 0), cB, voffB); PG8_STAGE_A(PG8_SA(0, 0), cA, 0, false); PG8_STAGE(PG8_SB(0, 1), cB + hstep, voffB); PG8_STAGE_A(PG8_SA(0, 1), cA, 1, false);
        if (wr == 1) PG8_BAR;
        PG8_WAIT_V(4); PG8_BAR;
        PG8_STAGE(PG8_SB(1, 0), cB + kstep, voffB); PG8_STAGE_A(PG8_SA(1, 0), cA + kstep, 0, false); PG8_STAGE(PG8_SB(1, 1), cB + hstep + kstep, voffB);
        PG8_WAIT_V(6); PG8_BAR;
    }
    for (;;) {
        const bool has_next = S.next(ui + 1, nxt);
        if (has_next) PG8_GIDX(nxtA, nxt); else { if constexpr (GATHER) { _Pragma("unroll") for (int h_ = 0; h_ < 2; ++h_) _Pragma("unroll") for (int i_ = 0; i_ < 2; ++i_) nxtA[h_][i_] = curA[h_][i_]; } }
        const char* nA = GATHER ? (const char*)g.A : (has_next ? (const char*)g.A + (size_t)nxt.pm * tstep : cA); const char* nB = has_next ? (const char*)g.Bt + (size_t)nxt.pn * tstep : cB;
#pragma unroll 1
        for (int t = 0; t < nt; t += 2) {
            const bool last = (t == nt - 2);
            const char* a1 = cA + (size_t)(t + 1) * kstep;
            const char* a2 = last ? nA : cA + (size_t)(t + 2) * kstep; const char* b2 = last ? nB : cB + (size_t)(t + 2) * kstep;
            const char* a3 = a2 + kstep; const char* b3 = b2 + kstep;
            if (last && has_next) S.a_ready(nxt);
            if constexpr (SP2) {
            PG8_LDB(B0, 0, 0); PG8_LDB(B1, 0, 1); PG8_SCHED; PG8_LDA(At, 0, 0); PG8_STAGE_A(PG8_SA(1, 1), a1, 1, false);
            PG8_WAIT_V(8); PG8_WAIT_L(0); PG8_BAR; PG8_MMA(0, 0, At, B0); PG8_MMA(0, 1, At, B1); PG8_BAR; PG8_SCHED;
            PG8_LDA(At, 0, 1); PG8_STAGE(PG8_SB(0, 0), b2, voffB); PG8_STAGE(PG8_SB(0, 1), b2 + hstep, voffB); PG8_STAGE_A(PG8_SA(0, 0), a2, 0, last);
            PG8_WAIT_V(8); PG8_WAIT_L(0); PG8_BAR; PG8_MMA(1, 0, At, B0); PG8_MMA(1, 1, At, B1); PG8_BAR; PG8_SCHED;
            PG8_LDB(B0, 1, 0); PG8_LDB(B1, 1, 1); PG8_SCHED; PG8_LDA(At, 1, 0); PG8_STAGE_A(PG8_SA(0, 1), a2, 1, last);
            PG8_WAIT_V(8); PG8_WAIT_L(0); PG8_BAR; PG8_MMA(0, 0, At, B0); PG8_MMA(0, 1, At, B1); PG8_BAR; PG8_SCHED;
            PG8_LDA(At, 1, 1); PG8_STAGE(PG8_SB(1, 0), b3, voffB); PG8_STAGE(PG8_SB(1, 1), b3 + hstep, voffB); PG8_STAGE_A(PG8_SA(1, 0), a3, 0, last);
            PG8_WAIT_V(8); PG8_WAIT_L(0); PG8_BAR; PG8_MMA(1, 0, At, B0); PG8_MMA(1, 1, At, B1); PG8_BAR; PG8_SCHED;
            } else {
            PG8_LDB(B0, 0, 0); PG8_SCHED; PG8_LDA(At, 0, 0); PG8_STAGE_A(PG8_SA(1, 1), a1, 1, false);
            PG8_WAIT_L(8); PG8_BAR; PG8_WAIT_L(0); PG8_MMA(0, 0, At, B0); PG8_BAR; PG8_SCHED;
            PG8_LDB(B1, 0, 1); PG8_STAGE(PG8_SB(0, 0), b2, voffB);
            PG8_BAR; PG8_WAIT_L(0); PG8_MMA(0, 1, At, B1); PG8_BAR;
            PG8_LDA(At, 0, 1); PG8_STAGE_A(PG8_SA(0, 0), a2, 0, last);
            PG8_BAR; PG8_WAIT_L(0); PG8_MMA(1, 0, At, B0); PG8_BAR; PG8_SCHED;
            PG8_STAGE(PG8_SB(0, 1), b2 + hstep, voffB);
            PG8_WAIT_V(6); PG8_BAR; PG8_MMA(1, 1, At, B1); PG8_BAR;
            PG8_LDB(B0, 1, 0); PG8_SCHED; PG8_LDA(At, 1, 0); PG8_STAGE_A(PG8_SA(0, 1), a2, 1, last);
            PG8_WAIT_L(8); PG8_BAR; PG8_WAIT_L(0); PG8_MMA(0, 0, At, B0); PG8_BAR; PG8_SCHED;
            PG8_LDB(B1, 1, 1); PG8_STAGE(PG8_SB(1, 0), b3, voffB);
            PG8_BAR; PG8_WAIT_L(0); PG8_MMA(0, 1, At, B1); PG8_BAR;
            PG8_LDA(At, 1, 1); PG8_STAGE_A(PG8_SA(1, 0), a3, 0, last);
            PG8_BAR; PG8_WAIT_L(0); PG8_MMA(1, 0, At, B0); PG8_BAR; PG8_SCHED;
            PG8_STAGE(PG8_SB(1, 1), b3 + hstep, voffB);
            PG8_WAIT_V(6); PG8_BAR; PG8_MMA(1, 1, At, B1); PG8_BAR;
            }
        }
        if constexpr (ALIGN_EPI) { if (wr == 0) PG8_BAR; }
        if constexpr (!Epi::AFTER_DRAIN) { E(acc, cur, wr, wc, fr, fq); S.done(cur); }
        if (!has_next) break;
#pragma unroll
        for (int a = 0; a < 2; ++a)
#pragma unroll
            for (int b = 0; b < 2; ++b)
#pragma unroll
                for (int m = 0; m < 4; ++m)
#pragma unroll
                    for (int n = 0; n < 2; ++n) acc[a][b][m][n] = (f32x4){0.f, 0.f, 0.f, 0.f};
        cur = nxt; cA = nA; cB = nB; ++ui;
        if constexpr (GATHER) { _Pragma("unroll") for (int h_ = 0; h_ < 2; ++h_) _Pragma("unroll") for (int i_ = 0; i_ < 2; ++i_) curA[h_][i_] = nxtA[h_][i_]; }
        if constexpr (ALIGN_EPI) { if (wr == 1) PG8_BAR; }
    }
    PG8_WAIT_V(0);
    if constexpr (!ALIGN_EPI) { if (wr == 0) PG8_BAR; }
    PG8_BAR;
    if constexpr (Epi::AFTER_DRAIN) { E.fused(acc, cur, wr, wc, fr, fq, lds, wid, lane); S.done(cur); }
#undef PG8_SA
#undef PG8_SB
#undef PG8_STAGE
#undef PG8_STAGE_A
#undef PG8_GIDX
#undef PG8_LDA
#undef PG8_LDB
#undef PG8_MMA
#undef PG8_WAIT_V
#undef PG8_WAIT_L
#undef PG8_BAR
#undef PG8_SCHED
}
}
namespace att {
using bf16 = unsigned short;
using i32x8 = __attribute__((ext_vector_type(8))) int;
using i32x4 = __attribute__((ext_vector_type(4))) int;
using f32x16 = __attribute__((ext_vector_type(16))) float;
using u32x4  = __attribute__((ext_vector_type(4))) unsigned;
using f32x2 = __attribute__((ext_vector_type(2))) float;
constexpr int NW = 8, QBLK = 32, KVBLK = 64;
constexpr float SCALE = 0.07216878364870322f;
constexpr float QSCALE = SCALE * 1.4426950408889634f;
constexpr float QFP8 = 4.f, KFP8 = 0.25f;
constexpr float CSH = 5.f;
constexpr float THR2 = 3.5f;
constexpr int LDQ = 768, LDO = 1024;
constexpr int SHM_V = 128 * 64, SHM_K = KVBLK * 128, SHM_KR = KVBLK * 64;
constexpr int STAGE = SHM_V + SHM_K + SHM_KR  , NSLOT = 6, SL_K = SHM_V, SL_KR = SHM_V + SHM_K;
constexpr int OFF_WS = NSLOT * STAGE, SHM_ATTN = OFF_WS + NW * 64 * 4;
#define SBAR() __builtin_amdgcn_sched_barrier(0)
__device__ __forceinline__ int crow(int r, int hi) { return (r & 3) + 8 * (r >> 2) + 4 * hi; }
__device__ __forceinline__ int pk4f8(float a, float b, float c, float d) { int w = __builtin_amdgcn_cvt_pk_fp8_f32(a, b, 0, false); return __builtin_amdgcn_cvt_pk_fp8_f32(c, d, w, true); }
__device__ __forceinline__ i32x8 mk8(i32x4 lo, i32x4 hi) { return (i32x8){lo[0], lo[1], lo[2], lo[3], hi[0], hi[1], hi[2], hi[3]}; }
#define MX_(A, B, C) __builtin_amdgcn_mfma_scale_f32_32x32x64_f8f6f4(A, B, C, 0, 0, 0, 0, 0, 0)
#define LD8_(base, a0, a1, off) mk8(*reinterpret_cast<const i32x4*>((base) + (a0) + (off)), *reinterpret_cast<const i32x4*>((base) + (a1) + (off)))
#define SPLAT_(x) (f32x16){x, x, x, x, x, x, x, x, x, x, x, x, x, x, x, x}
__device__ __forceinline__ void qkt(f32x16& p0, f32x16& p1, const char* Ks, const char* KRs, const i32x8* qr, const int (&ka)[4], const int (&ra)[2], float ninit) {
  p0 = SPLAT_(ninit); p1 = p0;
  { const i32x8 b0 = LD8_(Ks, ka[0], ka[1], 0), b1 = LD8_(Ks, ka[0], ka[1], 4096); p0 = MX_(b0, qr[0], p0); p1 = MX_(b1, qr[0], p1); }
  { const i32x8 b0 = LD8_(Ks, ka[2], ka[3], 0), b1 = LD8_(Ks, ka[2], ka[3], 4096); p0 = MX_(b0, qr[1], p0); p1 = MX_(b1, qr[1], p1); }
  { const i32x8 b0 = LD8_(KRs, ra[0], ra[1], 0), b1 = LD8_(KRs, ra[0], ra[1], 2048); p0 = MX_(b0, qr[2], p0); p1 = MX_(b1, qr[2], p1); }
}
__device__ __forceinline__ void partialSM_first(f32x16& p0, f32x16& p1, float& m_reg, float& alpha) {
  float pmax = p0[0]; for (int r = 1; r < 16; ++r) pmax = fmaxf(pmax, p0[r]); for (int r = 0; r < 16; ++r) pmax = fmaxf(pmax, p1[r]);
  { auto rr = __builtin_amdgcn_permlane32_swap(__float_as_uint(pmax), __float_as_uint(pmax), false, false);
    pmax = fmaxf(__uint_as_float(rr[0]), __uint_as_float(rr[1])); }
  const float delta = (fabsf(pmax - CSH) <= THR2) ? 0.f : pmax - CSH; m_reg = delta; alpha = 1.f;
  if (__any(delta != 0.f)) { for (int r = 0; r < 16; ++r) p0[r] -= delta; for (int r = 0; r < 16; ++r) p1[r] -= delta; }
  for (int r = 0; r < 16; ++r) p0[r] = __builtin_amdgcn_exp2f(p0[r]);
}
#define PK8_(P, B) pk4f8(P[B], P[B + 1], P[B + 2], P[B + 3])
__device__ __forceinline__ void finishSM(f32x16& p0, f32x16& p1, float alpha, float& l_reg, i32x8& pa) {
  for (int r = 0; r < 16; ++r) p1[r] = __builtin_amdgcn_exp2f(p1[r]);
  float ps = 0; for (int r = 0; r < 16; ++r) ps += p0[r]; for (int r = 0; r < 16; ++r) ps += p1[r];
  { auto rr = __builtin_amdgcn_permlane32_swap(__float_as_uint(ps), __float_as_uint(ps), false, false);
    ps = __uint_as_float(rr[0]) + __uint_as_float(rr[1]); }
  l_reg = l_reg * alpha + ps;
  pa = (i32x8){PK8_(p0, 0), PK8_(p0, 4), PK8_(p0, 8), PK8_(p0, 12), PK8_(p1, 0), PK8_(p1, 4), PK8_(p1, 8), PK8_(p1, 12)};
}
__device__ __forceinline__ void pv_d0(f32x16* o, const char* Vs, const int (&va)[2], i32x8 pa) {
#pragma unroll
  for (int d = 0; d < 4; ++d) { const i32x8 v = LD8_(Vs, va[0], va[1], d * 2048); o[d] = MX_(pa, v, o[d]); }
}
#define EX_(i) p1[i] = (ABL & 4) ? p1[i] * 0.5f : __builtin_amdgcn_exp2f(p1[i])
#define P2_(P, B) (f32x2){P[B], P[B + 1]}
template <int ABL> __device__ __forceinline__ void qk_fin(f32x16& n0, f32x16& n1, const char* Ks, const char* KRs, const i32x8* qr, const int (&ka)[4], const int (&ra)[2], float ninit,
                                       f32x16& p0, f32x16& p1, float alpha, float& l_reg, i32x8& pa, i32x8& e0, i32x8& e1, i32x8& A, i32x8& B, const char* VsN, const int (&va)[2]) {
  i32x8 f0, f1; f32x2 s2 = {0.f, 0.f}; int c0 = 0, c1 = 0, c2 = 0, c3 = 0, c4 = 0, c5 = 0, c6 = 0, c7 = 0;
  SBAR();
  f0 = LD8_(Ks, ka[2], ka[3], 0); f1 = LD8_(Ks, ka[2], ka[3], 4096);
  n0 = SPLAT_(ninit); n1 = n0;
  SBAR();
  n0 = MX_(e0, qr[0], n0); SBAR();
  if constexpr (!(ABL & 1)) { EX_(0); EX_(1); EX_(2); EX_(3); EX_(4); EX_(5); s2 = P2_(p0, 0) + P2_(p0, 2); s2 += P2_(p0, 4); s2 += P2_(p0, 6); }
  SBAR();
  n1 = MX_(e1, qr[0], n1); SBAR();
  e0 = LD8_(KRs, ra[0], ra[1], 0); e1 = LD8_(KRs, ra[0], ra[1], 2048);
  if constexpr (!(ABL & 1)) { s2 += P2_(p0, 8); s2 += P2_(p0, 10); s2 += P2_(p0, 12); s2 += P2_(p0, 14); c0 = PK8_(p0, 0); c1 = PK8_(p0, 4); c2 = PK8_(p0, 8); asm volatile("" : "+v"(c0), "+v"(c1), "+v"(c2)); }
  SBAR();
  n0 = MX_(f0, qr[1], n0); SBAR();
  if constexpr (!(ABL & 1)) { EX_(6); EX_(7); EX_(8); EX_(9); EX_(10); EX_(11); c3 = PK8_(p0, 12); asm volatile("" : "+v"(c3)); s2 += P2_(p1, 0); s2 += P2_(p1, 2); }
  SBAR();
  n1 = MX_(f1, qr[1], n1); SBAR();
  if constexpr (!(ABL & 1)) { EX_(12); EX_(13); EX_(14); EX_(15); s2 += P2_(p1, 4); c4 = PK8_(p1, 0); c5 = PK8_(p1, 4); asm volatile("" : "+v"(c4), "+v"(c5)); }
  SBAR();
  n0 = MX_(e0, qr[2], n0); SBAR();
  if constexpr (!(ABL & 1)) { s2 += P2_(p1, 6); s2 += P2_(p1, 8); s2 += P2_(p1, 10); s2 += P2_(p1, 12); s2 += P2_(p1, 14); c6 = PK8_(p1, 8); c7 = PK8_(p1, 12); asm volatile("" : "+v"(c6), "+v"(c7)); }
  SBAR();
  n1 = MX_(e1, qr[2], n1); SBAR();
  A = LD8_(VsN, va[0], va[1], 0); B = LD8_(VsN, va[0], va[1], 2048);
  if constexpr (!(ABL & 1)) { float ps = s2[0] + s2[1];
    { auto rr = __builtin_amdgcn_permlane32_swap(__float_as_uint(ps), __float_as_uint(ps), false, false); ps = __uint_as_float(rr[0]) + __uint_as_float(rr[1]); }
    l_reg = l_reg * alpha + ps;
    pa = (i32x8){c0, c1, c2, c3, c4, c5, c6, c7}; }
  SBAR();
  if constexpr (ABL & 1) { asm volatile("" :: "v"(n0), "v"(n1)); }
}
template <int ABL> __device__ __forceinline__ void pv_par(f32x16* o, const char* Vs, const int (&va)[2], i32x8 pa, f32x16& n0, f32x16& n1, float& m_reg, float& alpha, i32x8& A, i32x8& B, i32x8& e0, i32x8& e1, const char* KsN, const int (&ka)[4]) {
  SBAR();
  o[0] = MX_(pa, A, o[0]); SBAR();
  A = LD8_(Vs, va[0], va[1], 4096);
  SBAR();
  o[1] = MX_(pa, B, o[1]); SBAR();
  B = LD8_(Vs, va[0], va[1], 6144);
  float pmax = n0[0];
  if constexpr (!(ABL & 1)) {
#pragma unroll
  for (int r = 1; r < 16; ++r) pmax = fmaxf(pmax, n0[r]);
  }
  SBAR();
  o[2] = MX_(pa, A, o[2]); SBAR();
  float delta = 0.f; bool adj = false; alpha = 1.f;
  if constexpr (!(ABL & 1)) {
#pragma unroll
  for (int r = 0; r < 16; ++r) pmax = fmaxf(pmax, n1[r]);
  { auto rr = __builtin_amdgcn_permlane32_swap(__float_as_uint(pmax), __float_as_uint(pmax), false, false); pmax = fmaxf(__uint_as_float(rr[0]), __uint_as_float(rr[1])); }
  if (__builtin_expect(!__all(pmax <= CSH + THR2), 0)) { delta = fmaxf(pmax - CSH, 0.f); alpha = __builtin_amdgcn_exp2f(-delta); m_reg += delta; adj = true; }
  }
  SBAR();
  o[3] = MX_(pa, B, o[3]); SBAR();
  e0 = LD8_(KsN, ka[0], ka[1], 0); e1 = LD8_(KsN, ka[0], ka[1], 4096);
  if constexpr (!(ABL & 1)) { if (adj) {
#pragma unroll
  for (int r = 0; r < 16; ++r) n0[r] -= delta;
#pragma unroll
  for (int r = 0; r < 16; ++r) n1[r] -= delta;
  }
#pragma unroll
  for (int r = 0; r < 16; ++r) n0[r] = (ABL & 4) ? n0[r] * 0.5f : __builtin_amdgcn_exp2f(n0[r]);
  }
  SBAR();
}
__device__ __forceinline__ void glds16(const void* gsrc, unsigned lds_dst) { unsigned keep;
  asm volatile("s_mov_b32 %0, m0\n\ts_mov_b32 m0, %2\n\ts_nop 0\n\tglobal_load_lds_dwordx4 %1, off\n\ts_mov_b32 m0, %0" : "=&s"(keep) : "v"(gsrc), "s"(lds_dst) : "memory"); }
#define WAIT_BAR_ALL() asm volatile("s_waitcnt vmcnt(0) lgkmcnt(0)\n\ts_barrier" ::: "memory")
template <int SDEPTH, int ABL = 0>
__device__ __forceinline__ void attn_body(const unsigned char* Qb, const unsigned char* Kn, const unsigned char* Kr, const unsigned char* Vt, int vpitch, bf16* Ob, int seq, char* lds) {
  const int tid = otid(), wid = __builtin_amdgcn_readfirstlane(tid >> 6), lane = tid & 63, r32 = lane & 31, hi = lane >> 5;
  float* ws = (float*)(lds + OFF_WS) + wid * 64; float* li_l = ws; float* al_l = ws + 32;
  float m_reg = 0.f, l_reg = 0; f32x16 o[4] = {}; i32x8 qr[3];
  { const unsigned char* Qw = Qb + (long)(wid * QBLK + r32) * LDQ + hi * 32;
#pragma unroll
    for (int s = 0; s < 3; ++s) qr[s] = mk8(*reinterpret_cast<const i32x4*>(Qw + 64 * s), *reinterpret_cast<const i32x4*>(Qw + 64 * s + 16)); }
  int ka[4], ra[2], va[2];
#pragma unroll
  for (int q = 0; q < 4; ++q) ka[q] = r32 * 128 + (((4 * (q >> 1) + 2 * hi + (q & 1)) ^ ((r32 >> 1) & 7)) << 4);
#pragma unroll
  for (int q = 0; q < 2; ++q) { ra[q] = r32 * 64 + (((2 * hi + q) ^ ((r32 >> 2) & 3)) << 4); va[q] = ra[q]; }
  int okA, ovA, orA;
  { const int row = 8 * wid + (lane >> 3), c = (lane & 7) ^ ((row >> 1) & 7); okA = row * 128 + c * 16; }
  { const int row = 16 * wid + (lane >> 2), c = (lane & 3) ^ ((row >> 2) & 3); ovA = row * vpitch + c * 16; orA = row * 64 + c * 16; }
  const unsigned lds0 = (unsigned)(uintptr_t)lds;
#define DMA_TILE(k0, so) do { const unsigned d_ = (unsigned)__builtin_amdgcn_readfirstlane((int)(lds0 + (unsigned)(so) + (unsigned)wid * 1024u)); \
    glds16(Kn + (long)(k0) * 128 + okA, d_ + SL_K); glds16(Vt + (k0) + ovA, d_); if (wid < 4) glds16(Kr + (long)(k0) * 64 + orA, d_ + SL_KR); } while (0)
#define RESC(a) do { if (__any((a) < 1.f)) { if (hi == 0) al_l[r32] = (a); asm volatile("s_waitcnt lgkmcnt(0)" ::: "memory"); \
    for (int d = 0; d < 4; ++d) for (int r = 0; r < 16; ++r) o[d][r] *= al_l[crow(r, hi)]; } } while (0)
  f32x16 pA0, pA1, pB0, pB1; float alA, alB; i32x8 pa; const int NT = seq / KVBLK;
#define SLOT(t) (((t) % 6) * STAGE)
  const bool grpB = wid >= 4;
  DMA_TILE(0, 0); DMA_TILE(KVBLK, STAGE); DMA_TILE(2 * KVBLK, 2 * STAGE); DMA_TILE(3 * KVBLK, 3 * STAGE);
  WAIT_BAR_ALL();
  if (4 < NT) DMA_TILE(4 * KVBLK, 4 * STAGE);
  qkt(pA0, pA1, lds + SL_K, lds + SL_KR, qr, ka, ra, CSH); partialSM_first(pA0, pA1, m_reg, alA);
#define BARDMA(tn) do { if constexpr (!(ABL & 2)) { if ((tn) - 1 < NT) { if (wid < 4) asm volatile("s_waitcnt vmcnt(3) lgkmcnt(0)\n\ts_barrier" ::: "memory"); else asm volatile("s_waitcnt vmcnt(2) lgkmcnt(0)\n\ts_barrier" ::: "memory"); } \
    else WAIT_BAR_ALL(); if ((tn) < NT) DMA_TILE((tn) * KVBLK, SLOT(tn)); } } while (0)
  i32x8 fe0, fe1, fA, fB;
  fe0 = LD8_(lds + SLOT(1) + SL_K, ka[0], ka[1], 0); fe1 = LD8_(lds + SLOT(1) + SL_K, ka[0], ka[1], 4096);
  for (int t = 0; t + 3 < NT; t += 2) {
    qk_fin<ABL>(pB0, pB1, lds + SLOT(t + 1) + SL_K, lds + SLOT(t + 1) + SL_KR, qr, ka, ra, CSH - m_reg, pA0, pA1, alA, l_reg, pa, fe0, fe1, fA, fB, lds + SLOT(t), va);
    if (grpB) BARDMA(t + 5);
    pv_par<ABL>(o, lds + SLOT(t), va, pa, pB0, pB1, m_reg, alB, fA, fB, fe0, fe1, lds + SLOT(t + 2) + SL_K, ka);
    RESC(alB); if (!grpB) BARDMA(t + 5);
    qk_fin<ABL>(pA0, pA1, lds + SLOT(t + 2) + SL_K, lds + SLOT(t + 2) + SL_KR, qr, ka, ra, CSH - m_reg, pB0, pB1, alB, l_reg, pa, fe0, fe1, fA, fB, lds + SLOT(t + 1), va);
    if (grpB) BARDMA(t + 6);
    pv_par<ABL>(o, lds + SLOT(t + 1), va, pa, pA0, pA1, m_reg, alA, fA, fB, fe0, fe1, lds + SLOT(t + 3) + SL_K, ka);
    RESC(alA); if (!grpB) BARDMA(t + 6);
  }
  qk_fin<ABL>(pB0, pB1, lds + SLOT(NT - 1) + SL_K, lds + SLOT(NT - 1) + SL_KR, qr, ka, ra, CSH - m_reg, pA0, pA1, alA, l_reg, pa, fe0, fe1, fA, fB, lds + SLOT(NT - 2), va);
  pv_par<ABL>(o, lds + SLOT(NT - 2), va, pa, pB0, pB1, m_reg, alB, fA, fB, fe0, fe1, lds + SLOT(NT - 1) + SL_K, ka);
  RESC(alB);
  finishSM(pB0, pB1, alB, l_reg, pa); SBAR();
  pv_d0(o, lds + SLOT(NT - 1), va, pa);
  if (hi == 0) li_l[r32] = l_reg; asm volatile("s_waitcnt lgkmcnt(0)" ::: "memory");
  float rli[16];
#pragma unroll
  for (int r = 0; r < 16; ++r) rli[r] = __builtin_amdgcn_rcpf(li_l[crow(r, hi)]);
  bf16* Ow = Ob + (long)(wid * QBLK) * LDO;
#pragma unroll
  for (int r = 0; r < 16; ++r) { int orow = crow(r, hi);
#pragma unroll
    for (int d0 = 0; d0 < 4; ++d0) { const float v = o[d0][r] * rli[r]; unsigned u = __float_as_uint(v); u = (u + 0x7fffu + ((u >> 16) & 1u)) >> 16; Ow[(long)orow * LDO + d0 * 32 + r32] = (bf16)u; } }
  asm volatile("s_waitcnt lgkmcnt(0)\n\ts_barrier" ::: "memory");
#undef DMA_TILE
#undef RESC
#undef SLOT
#undef BARDMA
}
#undef SBAR
}
#define LAS __attribute__((address_space(3)))
typedef unsigned short bf16_t;
typedef float v4f __attribute__((ext_vector_type(4)));
typedef float v2f __attribute__((ext_vector_type(2)));
typedef unsigned v4u __attribute__((ext_vector_type(4)));
typedef unsigned v2u __attribute__((ext_vector_type(2)));
typedef short s8v __attribute__((ext_vector_type(8)));
typedef float f16v __attribute__((ext_vector_type(16)));

constexpr int DM = 1024, SEQ = 16384, NCTX = 256, NR = SEQ + NCTX  , NCHUNK = NR / 128  ;
constexpr int INC = 1728, INP = 1792, QLR = 384, KVLR = 256, NHEAD = 4, NEXP = 16, FFD = 1024, CAP = 2048, CAPC = 32;
constexpr float EPSN = 1e-6f;
constexpr size_t MiB = 1u << 20;
constexpr size_t WS_CTL = 0, WS_MOD = 1 * MiB, WS_ROPE = WS_MOD + 128 * 1024, WS_SGUW = WS_MOD + 256 * 1024, WS_LRUW = WS_MOD + 512 * 1024, WS_WRH = WS_MOD + 768 * 1024, WS_WRL = WS_MOD + 832 * 1024;
constexpr size_t WS_CHS = 2 * MiB, WS_PROBT = 3 * MiB, WS_IDX = 5 * MiB, WS_IDXC = WS_IDX + 128 * 1024, WS_GATE = WS_IDX + 256 * 1024, WS_GATEC = WS_GATE + 128 * 1024, WS_INV = 6 * MiB;
constexpr size_t WS_WIN = 8 * MiB, WS_WUQ = 12 * MiB, WS_WUKV = 13 * MiB, WS_WOUT = 14 * MiB, WS_WGU = 16 * MiB, WS_WD = 80 * MiB;
constexpr size_t WS_XL = 112 * MiB, WS_H = 177 * MiB, WS_A = 210 * MiB;
constexpr size_t WS_PROJ = WS_A, WS_CQN = 267 * MiB, WS_CKVN = 280 * MiB, WS_Q = 289 * MiB, WS_KN = 314 * MiB, WS_V = 331 * MiB, WS_KR = 348 * MiB, WS_MIX = 351 * MiB, WS_HL = 384 * MiB, WS_ACUM = 417 * MiB;
constexpr size_t WS_XS = WS_A, WS_HID = 282 * MiB, WS_YE = 354 * MiB, WS_END = 450 * MiB;
static_assert(WS_PROJ + (size_t)NR * INP * 2 <= WS_CQN && WS_CQN + (size_t)NR * QLR * 2 <= WS_CKVN && WS_CKVN + (size_t)NR * KVLR * 2 <= WS_Q && WS_Q + (size_t)NR * 768 * 2 <= WS_KN, "ws map 1");
static_assert(WS_KN + (size_t)4 * NR * 128 * 2 <= WS_V && WS_V + (size_t)4 * NR * 128 * 2 <= WS_KR && WS_KR + (size_t)NR * 64 * 2 <= WS_MIX && WS_MIX + (size_t)NR * 1024 * 2 <= WS_HL, "ws map 2");
static_assert(WS_HL + (size_t)2 * NR * 256 * 4 <= WS_ACUM && WS_ACUM + (size_t)2 * NR * 256 * 4 <= WS_END, "ws map 3");
static_assert(WS_XS + (size_t)(128 + 16) * 256 * 1024 * 2 <= WS_HID && WS_HID + (size_t)144 * 256 * 1024 * 2 <= WS_YE && WS_YE + (size_t)144 * 256 * 1024 * 2 <= WS_END, "ws map 4");
static_assert(WS_XL + (size_t)NR * 1024 * 4 <= WS_H && WS_H + (size_t)NR * 1024 * 2 <= WS_A && WS_WGU + (size_t)16 * 2048 * 1024 * 2 <= WS_WD && WS_WD + (size_t)16 * 1024 * 1024 * 2 <= WS_XL, "ws map 5");
constexpr int LDS_BYTES = 163840;

struct Params {
    const float *x, *c, *ctx, *c_ctx, *norm1_g, *w_mod, *b_mod, *w_in, *sgu_w, *sgu_b, *conv_w, *conv_b, *lru_wa, *lru_ba, *lru_wx, *lru_bx, *lru_lambda,
                *q_norm_g, *w_uq, *kv_norm_g, *w_ukv, *w_out, *norm2_g, *w_router, *w_gate, *w_up, *w_down, *final_norm_g;
    float* out; unsigned char* ws;
};

__device__ __forceinline__ float bf2f(bf16_t v) { return __uint_as_float((unsigned)v << 16); }
__device__ __forceinline__ unsigned f2bf(float f) { unsigned u = __float_as_uint(f); return (u + 0x7fffu + ((u >> 16) & 1u)) >> 16; }
__device__ __forceinline__ unsigned pk2(float lo, float hi) { return f2bf(lo) | (f2bf(hi) << 16); }
__device__ __forceinline__ float wave_sum(float v) {
#pragma unroll
    for (int o = 1; o < 64; o <<= 1) v += __shfl_xor(v, o);
    return v;
}
__device__ __forceinline__ float gelu_tanh(float x) { const float u = 0.7978845608028654f * (x + 0.044715f * x * x * x); const float e = __expf(2.f * u); return x * (1.f - __builtin_amdgcn_rcpf(e + 1.f)); }
__device__ __forceinline__ float sigmoid_f(float x) { return __builtin_amdgcn_rcpf(1.f + __expf(-x)); }
__device__ __forceinline__ void lds_barrier() { asm volatile("s_waitcnt lgkmcnt(0)\n\ts_barrier" ::: "memory"); }
__device__ __forceinline__ int crow16(int r, int hi) { return (r & 3) + 8 * (r >> 2) + 4 * hi; }

__device__ __forceinline__ void sincos_d(double x, double& s, double& c) {
    const double kd = rint(x * 0.6366197723675814); const int k = (int)kd;
    double y = fma(-kd, 1.5707963267948966, x); y = fma(-kd, 6.123233995736766e-17, y);
    const double y2 = y * y;
    const double sp = y * (1.0 + y2 * (-1.0 / 6 + y2 * (1.0 / 120 + y2 * (-1.0 / 5040 + y2 * (1.0 / 362880 + y2 * (-1.0 / 39916800 + y2 * (1.0 / 6227020800.0)))))));
    const double cp = 1.0 + y2 * (-0.5 + y2 * (1.0 / 24 + y2 * (-1.0 / 720 + y2 * (1.0 / 40320 + y2 * (-1.0 / 3628800 + y2 * (1.0 / 479001600.0 + y2 * (-1.0 / 87178291200.0)))))));
    const int q = k & 3;
    s = (q == 0) ? sp : (q == 1) ? cp : (q == 2) ? -sp : -cp;
    c = (q == 0) ? cp : (q == 1) ? -sp : (q == 2) ? -cp : sp;
}

__device__ __forceinline__ void tr_item(const float* W, int K, int N, bf16_t* WT, int k0, int n0, long drow0, LAS float* scr, int lane) {
#pragma unroll 8
    for (int i = 0; i < 32; ++i) { const int kk = 2 * i + (lane >> 5); scr[kk * 33 + (lane & 31)] = W[(size_t)(k0 + kk) * N + n0 + (lane & 31)]; }
    asm volatile("s_waitcnt lgkmcnt(0)" ::: "memory");
    const int c = lane & 7;
#pragma unroll
    for (int j = 0; j < 4; ++j) { const int n = (lane >> 3) + 8 * j; const LAS float* s = scr + (8 * c) * 33 + n;
        v4u o; o.x = pk2(s[0 * 33], s[1 * 33]); o.y = pk2(s[2 * 33], s[3 * 33]); o.z = pk2(s[4 * 33], s[5 * 33]); o.w = pk2(s[6 * 33], s[7 * 33]);
        *(v4u*)(WT + (size_t)(drow0 + n) * K + k0 + 8 * c) = o; }
    asm volatile("s_waitcnt lgkmcnt(0)" ::: "memory");
}
struct CvtItem { const float* W; bf16_t* WT; int K, N, k0, n0; long drow0, drow_mul; int kvs; };
__device__ __forceinline__ bool cvt_item(const Params& P, int l, int it, CvtItem& c) {
    unsigned char* ws = P.ws;
    constexpr int I_IN = 8 * 7, I_UQ = 3 * 3, I_UKV = 2 * 4, I_OUT = 8 * 4, I_E = 16 * 32;
    c.drow0 = 0; c.drow_mul = 128; c.kvs = 0;
    if (it < I_IN) { c.W = P.w_in + (size_t)l * 1024 * INC; c.WT = (bf16_t*)(ws + WS_WIN); c.K = 1024; c.N = INC; c.k0 = (it / 7) * 128; c.n0 = (it % 7) * 256; return true; } it -= I_IN;
    if (it < I_UQ) { c.W = P.w_uq + (size_t)l * QLR * 768; c.WT = (bf16_t*)(ws + WS_WUQ); c.K = QLR; c.N = 768; c.k0 = (it / 3) * 128; c.n0 = (it % 3) * 256; return true; } it -= I_UQ;
    if (it < I_UKV) { c.W = P.w_ukv + (size_t)l * KVLR * 1024; c.WT = (bf16_t*)(ws + WS_WUKV); c.K = KVLR; c.N = 1024; c.k0 = (it / 4) * 128; c.n0 = (it % 4) * 256; c.kvs = 1; return true; } it -= I_UKV;
    if (it < I_OUT) { c.W = P.w_out + (size_t)l * 1024 * 1024; c.WT = (bf16_t*)(ws + WS_WOUT); c.K = 1024; c.N = 1024; c.k0 = (it / 4) * 128; c.n0 = (it % 4) * 256; return true; } it -= I_OUT;
    if (it >= 3 * I_E) return false;
    const int mat = it / I_E, q = it % I_E, e = q / 32, w = q % 32; const size_t eoff = ((size_t)l * 16 + e) * 1024 * 1024;
    c.K = 1024; c.N = 1024; c.k0 = (w / 4) * 128; c.n0 = (w % 4) * 256;
    if (mat == 0)      { c.W = P.w_gate + eoff; c.WT = (bf16_t*)(ws + WS_WGU); c.drow0 = (long)e * 2048; c.drow_mul = 256; }
    else if (mat == 1) { c.W = P.w_up + eoff;   c.WT = (bf16_t*)(ws + WS_WGU); c.drow0 = (long)e * 2048 + 128; c.drow_mul = 256; }
    else               { c.W = P.w_down + eoff; c.WT = (bf16_t*)(ws + WS_WD);  c.drow0 = (long)e * 1024; }
    return true;
}
__device__ __forceinline__ void convert_weights(const Params& P, LAS unsigned char* lds, int l, int vcu, int G) {
    const int tid = otid(), lane = tid & 63, wave = __builtin_amdgcn_readfirstlane(tid >> 6);
    LAS unsigned* img = (LAS unsigned*)lds;
    CvtItem c; int it = vcu; bool have = cvt_item(P, l, it, c);
    v4f v[16];
#define CVT_LOAD() do { const bool ok_ = c.n0 + 4 * lane < c.N; const float* src_ = c.W + (size_t)(c.k0 + wave * 16) * c.N + c.n0 + 4 * lane; \
    _Pragma("unroll") for (int i_ = 0; i_ < 16; ++i_) v[i_] = ok_ ? *(const v4f*)(src_ + (size_t)i_ * c.N) : (v4f){0.f, 0.f, 0.f, 0.f}; } while (0)
    if (have) CVT_LOAD();
    while (have) {
#pragma unroll
        for (int i = 0; i < 8; ++i)
#pragma unroll
            for (int j = 0; j < 4; ++j) img[(4 * lane + j) * 65 + wave * 8 + i] = pk2(v[2 * i][j], v[2 * i + 1][j]);
        __syncthreads();
        const CvtItem cur = c; it += G; have = cvt_item(P, l, it, c);
        if (have) CVT_LOAD();
#pragma unroll
        for (int rr = 0; rr < 8; ++rr) { const int n = (wave * 8 + rr) * 4 + (lane >> 4), ch = lane & 15;
            const LAS unsigned* s = img + n * 65 + 4 * ch; v4u o; o.x = s[0]; o.y = s[1]; o.z = s[2]; o.w = s[3];
            if (cur.n0 + n < cur.N) { const int ng = cur.n0 + n; const long dr = cur.kvs ? (long)(((ng >> 7) & 1) * 512 + (ng >> 8) * 128 + (ng & 127)) : cur.drow0 + (ng >> 7) * cur.drow_mul + (ng & 127);
                *(v4u*)(cur.WT + (size_t)dr * cur.K + cur.k0 + 8 * ch) = o; } }
        __syncthreads();
    }
#undef CVT_LOAD
    unsigned char* ws = P.ws; LAS float* scr = (LAS float*)(lds + wave * 16384);
    for (int it3 = vcu * 8 + wave; it3 < 64; it3 += G * 8) {
        const int e = it3 >> 1, k0 = (it3 & 1) * 512; bf16_t* wh = (bf16_t*)(ws + WS_WRH) + (size_t)e * 1024 + k0; bf16_t* wl = (bf16_t*)(ws + WS_WRL) + (size_t)e * 1024 + k0;
#pragma unroll
        for (int i = 0; i < 8; ++i) { const int k = 64 * i + lane; float w = 0.f; if (e < 16) w = P.w_router[((size_t)l * 1024 + k0 + k) * 16 + e];
            const unsigned h = f2bf(w); wh[k] = (bf16_t)h; wl[k] = (bf16_t)f2bf(w - __uint_as_float(h << 16)); } }
    for (int it2 = vcu * 8 + wave; it2 < 64 + 64 + 32; it2 += G * 8) {
        if (it2 < 64) { v4u z = {0u, 0u, 0u, 0u}; bf16_t* p = (bf16_t*)(ws + WS_WIN) + (size_t)(INC + it2) * 1024; *(v4u*)(p + lane * 8) = z; *(v4u*)(p + 512 + lane * 8) = z; }
        else if (it2 < 128) { const int pc = it2 - 64; const float* s = P.sgu_w + (size_t)l * 65536 + pc * 1024; bf16_t* d = (bf16_t*)(ws + WS_SGUW) + pc * 1024;
#pragma unroll
            for (int j = 0; j < 4; ++j) { const v4f x = *(const v4f*)(s + 256 * j + 4 * lane); v2u o; o.x = pk2(x[0], x[1]); o.y = pk2(x[2], x[3]); *(v2u*)(d + 256 * j + 4 * lane) = o; } }
        else { const int q = it2 - 128, mi = q >> 1, half = q & 1, d = mi >> 3, m = (mi >> 2) & 1, nb = mi & 3;
            const float* W = (m ? P.lru_wx : P.lru_wa) + (((size_t)l * 2 + d) * 4 + nb) * 4096;
            tr_item(W, 64, 64, (bf16_t*)(ws + WS_LRUW), 0, half * 32, (long)mi * 64 + half * 32, scr, lane); }
    }
}
#define GAS __attribute__((address_space(1)))
typedef GAS unsigned gu32;
#define XB_TMO      128
#define XB_XCNT(j)  (256  + 64 * (j))
#define XB_XSUB(j)  (1280 + 64 * (j))
#define XB_XGEN(j)  (2304 + 64 * (j))
#define XB_TOP      3328
#define XB_TOPGEN   3392
#define XCD_BAR_WORDS 3456
#define XB_SPIN_CAP (1u << 18)

__device__ __forceinline__ unsigned xb_ld(unsigned* p)              { return __hip_atomic_load(p, __ATOMIC_RELAXED, __HIP_MEMORY_SCOPE_AGENT); }
__device__ __forceinline__ unsigned xb_add(unsigned* p, unsigned v) { return __hip_atomic_fetch_add(p, v, __ATOMIC_RELAXED, __HIP_MEMORY_SCOPE_AGENT); }
__device__ __forceinline__ unsigned xb_xcc_id() { return (unsigned)__builtin_amdgcn_s_getreg((3 << 11) | 20) & 0xFu; }
#define XB_SPIN(cond, bar) do { unsigned _sp = 0; while (cond) { __builtin_amdgcn_s_sleep(1); \
    if ((++_sp & 255u) == 0u) { if (xb_ld(&(bar)[XB_TMO])) break; if (_sp > XB_SPIN_CAP) { atomicAdd(&(bar)[XB_TMO], 1u); break; } } } } while (0)

struct XcdBarrier {
    unsigned* bar; unsigned x;
    volatile LAS unsigned* st;
};

__device__ __forceinline__ XcdBarrier xcd_barrier_post(unsigned* bar, volatile LAS unsigned* st) {
    XcdBarrier b; b.bar = bar; b.x = xb_xcc_id(); b.st = st;
    if (otid() == 0) (void)xb_add(&bar[XB_XCNT(b.x)], 1u);
    return b;
}
__device__ __forceinline__ void xcd_barrier_complete(unsigned* bar, unsigned x, unsigned& nloc, unsigned& nx) {
    const unsigned G = gridDim.x * gridDim.y * gridDim.z;
    unsigned sum, cnt, mine, sp = 0u;
    for (;;) {
        sum = 0u; cnt = 0u; mine = 0u;
#pragma unroll
        for (unsigned j = 0; j < 16; ++j) { const unsigned c = xb_ld(&bar[XB_XCNT(j)]); sum += c; cnt += (c > 0u) ? 1u : 0u; mine = (j == x) ? c : mine; }
        if (sum == G) break;
        __builtin_amdgcn_s_sleep(1);
        if ((++sp & 255u) == 0u) { if (xb_ld(&bar[XB_TMO])) break; if (sp > XB_SPIN_CAP) { atomicAdd(&bar[XB_TMO], 1u); break; } }
    }
    nloc = mine > 0u ? mine : 1u; nx = cnt > 0u ? cnt : 1u;
}

__device__ __forceinline__ void xcd_barrier(const XcdBarrier& b) {
    asm volatile("s_waitcnt vmcnt(0)" ::: "memory");
    __syncthreads();
    if (otid() == 0) {
        unsigned* bar = b.bar;
        __builtin_amdgcn_s_waitcnt(0);
        unsigned nloc = b.st[0], nx = b.st[1];
        if (nloc == 0u) { xcd_barrier_complete(bar, b.x, nloc, nx); b.st[0] = nloc; b.st[1] = nx; }
        const unsigned old = xb_add(&bar[XB_XSUB(b.x)], 1u);
        const unsigned gen = old / nloc;
        if (old + 1u == (gen + 1u) * nloc) {
            __builtin_amdgcn_fence(__ATOMIC_RELEASE, "agent");
            asm volatile("s_waitcnt vmcnt(0)" ::: "memory");
            const unsigned og = xb_add(&bar[XB_TOP], 1u);
            const unsigned tg = og / nx;
            if (og + 1u == (tg + 1u) * nx) xb_add(&bar[XB_TOPGEN], 1u);
            else XB_SPIN(xb_ld(&bar[XB_TOPGEN]) == tg, bar);
            __builtin_amdgcn_fence(__ATOMIC_ACQUIRE, "agent");
            xb_add(&bar[XB_XGEN(b.x)], 1u);
            asm volatile("s_waitcnt vmcnt(0)" ::: "memory");
        } else {
            XB_SPIN(xb_ld(&bar[XB_XGEN(b.x)]) == gen, bar);
            __builtin_amdgcn_fence(__ATOMIC_ACQUIRE, "agent");
            asm volatile("s_waitcnt vmcnt(0)" ::: "memory");
        }
    }
    __syncthreads();
}
__device__ __forceinline__ void row_norm_mod_bf16(const float* xrow, const float* g, const float* sh, const float* sc, bf16_t* orow, int lane) {
    v4f v[4]; float ss = 0.f;
#pragma unroll
    for (int j = 0; j < 4; ++j) { v[j] = *(const v4f*)(xrow + 256 * j + 4 * lane); ss += (v[j][0] * v[j][0] + v[j][1] * v[j][1]) + (v[j][2] * v[j][2] + v[j][3] * v[j][3]); }
    const float rstd = 1.0f / sqrtf(wave_sum(ss) * (1.0f / 1024.0f) + EPSN);
#pragma unroll
    for (int j = 0; j < 4; ++j) { const int c = 256 * j + 4 * lane; const v4f gv = *(const v4f*)(g + c), shv = *(const v4f*)(sh + c), scv = *(const v4f*)(sc + c);
        const v4f y = ((v[j] * rstd) * gv) * (1.0f + scv) + shv; v2u o; o.x = pk2(y[0], y[1]); o.y = pk2(y[2], y[3]); *(v2u*)(orow + c) = o; }
}

__device__ __forceinline__ void phase0(const Params& P, LAS unsigned char* lds, int vcu, int G) {
    const int tid = otid(), lane = tid & 63, wave = tid >> 6;
    float* MOD = (float*)(P.ws + WS_MOD);
    if (vcu < 192) {
        LAS float* sv = (LAS float*)(lds + 131072); LAS float* red = (LAS float*)(lds + 131072 + 8192);
        for (int i = tid; i < 1024; i += 512) { const float a = P.c[i], b = P.c_ctx[i]; sv[i] = a / (1.f + expf(-a)); sv[1024 + i] = b / (1.f + expf(-b)); }
        __syncthreads();
        for (int it = vcu; it < 192; it += G) {
            const int l = it / 96, cg = it % 96; const float* W = P.w_mod + (size_t)l * 1024 * 6144 + cg * 64 + lane;
            float al = 0.f, ac = 0.f; const int k0 = wave * 128;
            for (int kb = 0; kb < 128; kb += 32) { float wv[32];
#pragma unroll
                for (int k = 0; k < 32; ++k) wv[k] = W[(size_t)(k0 + kb + k) * 6144];
#pragma unroll
                for (int k = 0; k < 32; ++k) { al += sv[k0 + kb + k] * wv[k]; ac += sv[1024 + k0 + kb + k] * wv[k]; } }
            red[(wave * 2 + 0) * 64 + lane] = al; red[(wave * 2 + 1) * 64 + lane] = ac;
            __syncthreads();
            if (wave < 2) { float s = 0.f;
#pragma unroll
                for (int w8 = 0; w8 < 8; ++w8) s += red[(w8 * 2 + wave) * 64 + lane];
                const int col = cg * 64 + lane; MOD[(l * 2 + wave) * 6144 + col] = s + P.b_mod[l * 6144 + col]; }
            __syncthreads();
        }
    }
    if (vcu == G - 1) {
        float* cosT = (float*)(P.ws + WS_ROPE); float* sinT = cosT + 4096;
        for (int i = tid; i < 4096; i += 512) { const int p = i >> 4, f = i & 15; const float inv = exp2f(-(float)f * (13.287712379549449f / 16.0f)); const float ang = (float)p * inv;
            double s, c; sincos_d((double)ang, s, c); cosT[i] = (float)c; sinT[i] = (float)s; }
    }
    convert_weights(P, lds, 0, vcu, G);
}
__device__ __forceinline__ void phase_norm1_l0(const Params& P, int gw, int NGW) {
    const int lane = otid() & 63; const float* MOD = (const float*)(P.ws + WS_MOD); bf16_t* H = (bf16_t*)(P.ws + WS_H);
    for (int r0 = gw; r0 < NR; r0 += 2 * NGW) {
        v4f v[2][4]; float ss[2];
#pragma unroll
        for (int u = 0; u < 2; ++u) { const int r = (r0 + u * NGW < NR) ? r0 + u * NGW : r0; const float* src = r < NCTX ? P.ctx + (size_t)r * 1024 : P.x + (size_t)(r - NCTX) * 1024; ss[u] = 0.f;
#pragma unroll
            for (int j = 0; j < 4; ++j) { v[u][j] = *(const v4f*)(src + 256 * j + 4 * lane); ss[u] += (v[u][j][0] * v[u][j][0] + v[u][j][1] * v[u][j][1]) + (v[u][j][2] * v[u][j][2] + v[u][j][3] * v[u][j][3]); } }
#pragma unroll
        for (int u = 0; u < 2; ++u) { const int r = r0 + u * NGW; if (r < NR) { const float* md = MOD + (r < NCTX ? 1 : 0) * 6144; const float rstd = 1.0f / sqrtf(wave_sum(ss[u]) * (1.0f / 1024.0f) + EPSN);
            v4f gv[4], shv[4], scv[4];
#pragma unroll
            for (int j = 0; j < 4; ++j) { const int c = 256 * j + 4 * lane; gv[j] = *(const v4f*)(P.norm1_g + c); shv[j] = *(const v4f*)(md + c); scv[j] = *(const v4f*)(md + 1024 + c); }
#pragma unroll
            for (int j = 0; j < 4; ++j) { const int c = 256 * j + 4 * lane;
                const v4f y = ((v[u][j] * rstd) * gv[j]) * (1.0f + scv[j]) + shv[j]; v2u o; o.x = pk2(y[0], y[1]); o.y = pk2(y[2], y[3]); *(v2u*)(H + (size_t)r * 1024 + c) = o; } } }
    }
}
__device__ __forceinline__ void phase3_rows(const Params& P, int l, int gw, int NGW) {
    const int lane = otid() & 63; const bf16_t* PROJ = (const bf16_t*)(P.ws + WS_PROJ);
    bf16_t* CQN = (bf16_t*)(P.ws + WS_CQN); bf16_t* CKVN = (bf16_t*)(P.ws + WS_CKVN); unsigned char* KR = P.ws + WS_KR;
    const float* cosT = (const float*)(P.ws + WS_ROPE); const float* sinT = cosT + 4096;
    const float* qg = P.q_norm_g + l * QLR; const float* kg = P.kv_norm_g + l * KVLR;
    for (int r0 = gw; r0 < NR; r0 += 2 * NGW) {
        float q[2][6], kv[2][4], kr[2];
#pragma unroll
        for (int u = 0; u < 2; ++u) { const int r = (r0 + u * NGW < NR) ? r0 + u * NGW : r0; const bf16_t* pr = PROJ + (size_t)r * INP;
#pragma unroll
            for (int j = 0; j < 6; ++j) q[u][j] = bf2f(pr[1024 + 64 * j + lane]);
#pragma unroll
            for (int j = 0; j < 4; ++j) kv[u][j] = bf2f(pr[1408 + 64 * j + lane]);
            kr[u] = bf2f(pr[1664 + lane]); }
#pragma unroll
        for (int u = 0; u < 2; ++u) { const int r = r0 + u * NGW; if (r < NR) { float sq = 0.f, sk = 0.f;
#pragma unroll
            for (int j = 0; j < 6; ++j) sq += q[u][j] * q[u][j];
#pragma unroll
            for (int j = 0; j < 4; ++j) sk += kv[u][j] * kv[u][j];
            const float rq = 1.0f / sqrtf(wave_sum(sq) * (1.0f / QLR) + EPSN), rk = 1.0f / sqrtf(wave_sum(sk) * (1.0f / KVLR) + EPSN);
#pragma unroll
            for (int j = 0; j < 6; ++j) CQN[(size_t)r * QLR + 64 * j + lane] = (bf16_t)f2bf(q[u][j] * rq * qg[64 * j + lane]);
#pragma unroll
            for (int j = 0; j < 4; ++j) CKVN[(size_t)r * KVLR + 64 * j + lane] = (bf16_t)f2bf(kv[u][j] * rk * kg[64 * j + lane]);
            float ko = kr[u]; const float other = __shfl_xor(kr[u], 16);
            if (r >= NCTX) { const int t = r - NCTX, a = lane >> 5, f = lane & 15, pos = a ? (t & 63) : (t >> 6); const float cs = cosT[pos * 16 + f], sn = sinT[pos * 16 + f];
                ko = (lane & 16) ? (kr[u] * cs + other * sn) : (kr[u] * cs - other * sn); }
            { const int dd = lane & 31, pos = (lane & 32) + 8 * ((dd & 15) >> 2) + 4 * (dd >> 4) + (dd & 3); const float kq = __builtin_amdgcn_fmed3f(ko * att::KFP8, -448.f, 448.f);
              KR[(size_t)r * 64 + pos] = (unsigned char)(__builtin_amdgcn_cvt_pk_fp8_f32(kq, kq, 0, false) & 0xff); } } }
    }
}
__device__ __forceinline__ void sgu_item(const Params& P, int l, int n, LAS unsigned char* lds) {
    const int tid = otid(), lane = tid & 63, wave = __builtin_amdgcn_readfirstlane(tid >> 6), r32 = lane & 31, hi = lane >> 5; const int row0 = 128 * n;
    const bf16_t* PROJ = (const bf16_t*)(P.ws + WS_PROJ); bf16_t* MIX = (bf16_t*)(P.ws + WS_MIX); const bf16_t* SW = (const bf16_t*)(P.ws + WS_SGUW);
    constexpr int UP = 528;
    LAS unsigned char* VT = lds; LAS unsigned char* UT = lds + 65536;
    const int g = wave >> 1, cbase = 64 * g + 32 * (wave & 1), cB = cbase + r32;
    {
        const int t = tid >> 2, qd = tid & 3; const bf16_t* pr = PROJ + (size_t)(row0 + t) * INP + 64 * qd;
        s8v ru[8], rv[8];
#pragma unroll
        for (int j = 0; j < 8; ++j) { ru[j] = *(const s8v*)(pr + 8 * j); rv[j] = *(const s8v*)(pr + 256 + 8 * j); }
        float v[64]; float ss = 0.f;
#pragma unroll
        for (int j = 0; j < 8; ++j) {
#pragma unroll
            for (int i = 0; i < 8; ++i) { const float gv = gelu_tanh(bf2f((bf16_t)rv[j][i])); v[8 * j + i] = gv; ss += gv * gv; } }
#pragma unroll
        for (int j = 0; j < 8; ++j) { v4u o;
            o.x = pk2(gelu_tanh(bf2f((bf16_t)ru[j][0])), gelu_tanh(bf2f((bf16_t)ru[j][1]))); o.y = pk2(gelu_tanh(bf2f((bf16_t)ru[j][2])), gelu_tanh(bf2f((bf16_t)ru[j][3])));
            o.z = pk2(gelu_tanh(bf2f((bf16_t)ru[j][4])), gelu_tanh(bf2f((bf16_t)ru[j][5]))); o.w = pk2(gelu_tanh(bf2f((bf16_t)ru[j][6])), gelu_tanh(bf2f((bf16_t)ru[j][7])));
            *(LAS v4u*)(UT + t * UP + (64 * qd + 8 * j) * 2) = o; }
        ss += __shfl_xor(ss, 1); ss += __shfl_xor(ss, 2);
        const float rstd = 1.0f / sqrtf(ss * (1.0f / 256.0f) + EPSN);
#pragma unroll
        for (int i = 0; i < 64; ++i) { const int c = 64 * qd + i; *(LAS bf16_t*)(VT + c * 256 + ((((t >> 3) ^ (c & 15)) << 4) | ((t & 7) << 1))) = (bf16_t)f2bf(v[i] * rstd); }
    }
    const bf16_t* swp = SW + ((size_t)g * 128 + r32) * 128 + 8 * hi;
    s8v a0[8], a1[8];
#pragma unroll
    for (int ks = 0; ks < 8; ++ks) a0[ks] = *(const s8v*)(swp + 16 * ks);
    lds_barrier();
    s8v bf[8];
#pragma unroll
    for (int ks = 0; ks < 8; ++ks) bf[ks] = *(const LAS s8v*)(VT + cB * 256 + (((2 * ks + hi) ^ (cB & 15)) << 4));
    f16v acc[4];
#pragma unroll
    for (int pt = 0; pt < 4; ++pt) acc[pt] = (f16v){0.f, 0.f, 0.f, 0.f, 0.f, 0.f, 0.f, 0.f, 0.f, 0.f, 0.f, 0.f, 0.f, 0.f, 0.f, 0.f};
#pragma unroll
    for (int ks = 0; ks < 8; ++ks) a1[ks] = *(const s8v*)(swp + (size_t)32 * 128 + 16 * ks);
#pragma unroll
    for (int ks = 0; ks < 8; ++ks) acc[0] = __builtin_amdgcn_mfma_f32_32x32x16_bf16(a0[ks], bf[ks], acc[0], 0, 0, 0);
#pragma unroll
    for (int ks = 0; ks < 8; ++ks) a0[ks] = *(const s8v*)(swp + (size_t)64 * 128 + 16 * ks);
#pragma unroll
    for (int ks = 0; ks < 8; ++ks) acc[1] = __builtin_amdgcn_mfma_f32_32x32x16_bf16(a1[ks], bf[ks], acc[1], 0, 0, 0);
#pragma unroll
    for (int ks = 0; ks < 8; ++ks) a1[ks] = *(const s8v*)(swp + (size_t)96 * 128 + 16 * ks);
#pragma unroll
    for (int ks = 0; ks < 8; ++ks) acc[2] = __builtin_amdgcn_mfma_f32_32x32x16_bf16(a0[ks], bf[ks], acc[2], 0, 0, 0);
#pragma unroll
    for (int ks = 0; ks < 8; ++ks) acc[3] = __builtin_amdgcn_mfma_f32_32x32x16_bf16(a1[ks], bf[ks], acc[3], 0, 0, 0);
    const float* bs = P.sgu_b + ((size_t)l * 4 + g) * 128;
#pragma unroll
    for (int pt = 0; pt < 4; ++pt)
#pragma unroll
        for (int r = 0; r < 16; ++r) { const int p = 32 * pt + crow16(r, hi); LAS bf16_t* up = (LAS bf16_t*)(UT + p * UP + cB * 2);
            const float u = bf2f(*up); *up = (bf16_t)f2bf(u * (acc[pt][r] + bs[p])); }
    lds_barrier();
#pragma unroll
    for (int j = 0; j < 8; ++j) { const int idx = tid + 512 * j, p = idx >> 5, c8 = idx & 31;
        const v4u o = *(const LAS v4u*)(UT + p * UP + c8 * 16); *(v4u*)(MIX + (size_t)(row0 + p) * 1024 + 8 * c8) = o; }
    lds_barrier();
}
__device__ __forceinline__ void lru_item(const Params& P, int l, int n, int nb, LAS unsigned char* lds) {
    const int tid = otid(), lane = tid & 63, wave = __builtin_amdgcn_readfirstlane(tid >> 6), r32 = lane & 31, hi = lane >> 5; const int row0 = 128 * n;
    const int seq_lo = n < 2 ? 0 : NCTX, seq_hi = n < 2 ? NCTX : NR;
    const bf16_t* PROJ = (const bf16_t*)(P.ws + WS_PROJ); const bf16_t* LW = (const bf16_t*)(P.ws + WS_LRUW);
    float* HL = (float*)(P.ws + WS_HL); float* ACUM = (float*)(P.ws + WS_ACUM); float* CHS = (float*)(P.ws + WS_CHS);
    LAS unsigned char* CLB = lds;
    LAS float* AB = (LAS float*)(lds + 16384);
    LAS float* SEG = (LAS float*)(lds + 16384 + 131072);
#define CLB_OFF(t, ch) ((t) * 128 + (((((ch) >> 3) ^ (((t) >> 1) & 7)) << 4) | (((ch) & 7) << 1)))
    const int tt = wave >> 1, dt = wave & 1, tA = 32 * tt + r32, dp = 32 * dt + r32, gch = 64 * nb + dp;
    s8v wfA[2][4], wfX[2][4]; float bav[2], bxv[2], spv[2];
#pragma unroll
    for (int d = 0; d < 2; ++d) { const bf16_t* wA = LW + ((size_t)((d * 2 + 0) * 4 + nb) * 64 + dp) * 64 + 8 * hi; const bf16_t* wX = LW + ((size_t)((d * 2 + 1) * 4 + nb) * 64 + dp) * 64 + 8 * hi;
#pragma unroll
        for (int ks = 0; ks < 4; ++ks) { wfA[d][ks] = *(const s8v*)(wA + 16 * ks); wfX[d][ks] = *(const s8v*)(wX + 16 * ks); }
        bav[d] = P.lru_ba[(l * 2 + d) * 256 + gch]; bxv[d] = P.lru_bx[(l * 2 + d) * 256 + gch]; const float lam = P.lru_lambda[(l * 2 + d) * 256 + gch];
        spv[d] = (lam > 15.f) ? __expf(-lam) : log1pf(__expf(-lam)); }
    {
        const int ch = tid & 63, tg = tid >> 6, gch = 64 * nb + ch; const bf16_t* xb = PROJ + 512 + gch;
        const float* cw = P.conv_w + (size_t)l * 4 * 256; const float w0 = cw[gch], w1 = cw[256 + gch], w2 = cw[512 + gch], w3 = cw[768 + gch], cb = P.conv_b[l * 256 + gch];
        const int r = row0 + 16 * tg;
        float xr[19];
#pragma unroll
        for (int i = 0; i < 19; ++i) { const int rr = r - 2 + i; const int rc = rr < seq_lo ? seq_lo : (rr >= seq_hi ? seq_hi - 1 : rr); xr[i] = bf2f(xb[(size_t)rc * INP]); }
#pragma unroll
        for (int i = 0; i < 19; ++i) { const int rr = r - 2 + i; xr[i] = (rr >= seq_lo && rr < seq_hi) ? xr[i] : 0.f; }
#define LDX(rr) xr[(rr) - (r - 2)]
        float xm2 = LDX(r - 2), xm1 = LDX(r - 1), x0 = LDX(r);
#pragma unroll
        for (int i = 0; i < 16; ++i) { const float xp1 = LDX(r + i + 1); const float y = (((cb + xm2 * w0) + xm1 * w1) + x0 * w2) + xp1 * w3; const int t = 16 * tg + i;
            *(LAS bf16_t*)(CLB + CLB_OFF(t, ch)) = (bf16_t)f2bf(y); xm2 = xm1; xm1 = x0; x0 = xp1; }
#undef LDX
    }
    lds_barrier();
    {   s8v af[4]; float xc[16];
#pragma unroll
        for (int ks = 0; ks < 4; ++ks) af[ks] = *(const LAS s8v*)(CLB + tA * 128 + (((2 * ks + hi) ^ ((tA >> 1) & 7)) << 4));
#pragma unroll
        for (int r = 0; r < 16; ++r) xc[r] = bf2f(*(const LAS bf16_t*)(CLB + CLB_OFF(32 * tt + crow16(r, hi), dp)));
#pragma unroll
        for (int d = 0; d < 2; ++d) {
            f16v accA = (f16v){0.f, 0.f, 0.f, 0.f, 0.f, 0.f, 0.f, 0.f, 0.f, 0.f, 0.f, 0.f, 0.f, 0.f, 0.f, 0.f}, accX = accA;
#pragma unroll
            for (int ks = 0; ks < 4; ++ks) { accA = __builtin_amdgcn_mfma_f32_32x32x16_bf16(af[ks], wfA[d][ks], accA, 0, 0, 0); accX = __builtin_amdgcn_mfma_f32_32x32x16_bf16(af[ks], wfX[d][ks], accX, 0, 0, 0); }
#pragma unroll
            for (int r = 0; r < 16; ++r) { const int t = 32 * tt + crow16(r, hi);
                const float rg = sigmoid_f(accA[r] + bav[d]), ig = sigmoid_f(accX[r] + bxv[d]); const float la = -8.0f * rg * spv[d]; const float a = __expf(la);
                const float mult = sqrtf(fmaxf(1.0f - a * a, 0.f)); const float b = mult * (ig * xc[r]);
                *(LAS v2f*)(AB + ((d * 128 + t) * 64 + dp) * 2) = (v2f){a, b}; } } }
    lds_barrier();
    const int ch = tid & 63, s = tid >> 6;
#pragma unroll
    for (int d = 0; d < 2; ++d) { float A = 1.f, B = 0.f;
#pragma unroll
        for (int i = 0; i < 16; ++i) { const int p = 16 * s + i, t = d ? 127 - p : p; const v2f ab = *(const LAS v2f*)(AB + ((d * 128 + t) * 64 + ch) * 2); B = ab[0] * B + ab[1]; A = ab[0] * A; }
        *(LAS v2f*)(SEG + ((d * 8 + s) * 64 + ch) * 2) = (v2f){A, B}; }
    lds_barrier();
#pragma unroll
    for (int d = 0; d < 2; ++d) { float h = 0.f, ac = 1.f;
        for (int j = 0; j < s; ++j) { const v2f ab = *(const LAS v2f*)(SEG + ((d * 8 + j) * 64 + ch) * 2); h = ab[0] * h + ab[1]; ac = ab[0] * ac; }
        const size_t gbase = ((size_t)d * NR + row0) * 256 + 64 * nb + ch;
#pragma unroll
        for (int i = 0; i < 16; ++i) { const int p = 16 * s + i, t = d ? 127 - p : p; const v2f ab = *(const LAS v2f*)(AB + ((d * 128 + t) * 64 + ch) * 2); h = ab[0] * h + ab[1]; ac = ab[0] * ac;
            ((unsigned*)HL)[gbase + (size_t)t * 256] = pk2(h, ac); }
        if (s == 7) { CHS[((size_t)(0 * 2 + d) * NCHUNK + n) * 256 + 64 * nb + ch] = ac; CHS[((size_t)(1 * 2 + d) * NCHUNK + n) * 256 + 64 * nb + ch] = h; } }
    lds_barrier();
#undef CLB_OFF
}
__device__ __forceinline__ void lru_apply_item(const Params& P, int n, int hh  , LAS unsigned char* lds) {
    const int tid = otid(); const int row0 = 128 * n;
    const bf16_t* PROJ = (const bf16_t*)(P.ws + WS_PROJ); bf16_t* MIX = (bf16_t*)(P.ws + WS_MIX);
    const float* HL = (const float*)(P.ws + WS_HL); const float* ACUM = (const float*)(P.ws + WS_ACUM); const float* CHS = (const float*)(P.ws + WS_CHS);
    LAS float* carry = (LAS float*)lds;
    {   const int d = tid >> 8, ch = tid & 255; float h = 0.f;
        const int npos = (d == 0) ? n : ((n == 1) ? 0 : (n == 0) ? 1 : 131 - n);
        const float* CA = CHS + ((size_t)(0 * 2 + d) * NCHUNK) * 256 + ch; const float* CB = CHS + ((size_t)(1 * 2 + d) * NCHUNK) * 256 + ch;
        for (int p0 = 0; p0 < npos; p0 += 8) { float a[8], b[8];
#pragma unroll
            for (int k = 0; k < 8; ++k) { const int pos = (p0 + k < npos) ? p0 + k : 0; const int j = (d == 0) ? pos : ((pos == 0) ? 1 : (pos == 1) ? 0 : 131 - pos); a[k] = CA[(size_t)j * 256]; b[k] = CB[(size_t)j * 256]; }
#pragma unroll
            for (int k = 0; k < 8; ++k) if (p0 + k < npos) h = a[k] * h + b[k]; }
        carry[d * 256 + ch] = h; }
    __syncthreads();
    {   const int oc = tid & 31, rg = tid >> 5; const int rb = row0 + 64 * hh + 4 * rg;
        float cf[8], cb[8];
#pragma unroll
        for (int k = 0; k < 8; ++k) { cf[k] = carry[8 * oc + k]; cb[k] = carry[256 + 8 * oc + k]; }
        uint4 fa[4], fb[4], ba[4], bb[4], gg[4];
#pragma unroll
        for (int i = 0; i < 4; ++i) { const int r = rb + i; const unsigned* p0 = (const unsigned*)HL + (size_t)r * 256 + 8 * oc; const unsigned* p1 = (const unsigned*)HL + ((size_t)NR + r) * 256 + 8 * oc;
            fa[i] = *(const uint4*)p0; fb[i] = *(const uint4*)(p0 + 4); ba[i] = *(const uint4*)p1; bb[i] = *(const uint4*)(p1 + 4);
            gg[i] = *(const uint4*)(PROJ + (size_t)r * INP + 768 + 8 * oc); }
#pragma unroll
        for (int i = 0; i < 4; ++i) { const int r = rb + i;
            const unsigned fw[8] = {fa[i].x, fa[i].y, fa[i].z, fa[i].w, fb[i].x, fb[i].y, fb[i].z, fb[i].w};
            const unsigned bw[8] = {ba[i].x, ba[i].y, ba[i].z, ba[i].w, bb[i].x, bb[i].y, bb[i].z, bb[i].w};
            const unsigned gw[4] = {gg[i].x, gg[i].y, gg[i].z, gg[i].w};
            float o[8];
#pragma unroll
            for (int k = 0; k < 8; ++k) { const float hf = __uint_as_float(fw[k] << 16) + __uint_as_float(fw[k] & 0xffff0000u) * cf[k];
                const float hb = __uint_as_float(bw[k] << 16) + __uint_as_float(bw[k] & 0xffff0000u) * cb[k];
                const float gv = (k & 1) ? __uint_as_float(gw[k >> 1] & 0xffff0000u) : __uint_as_float(gw[k >> 1] << 16);
                o[k] = (hf + hb) * gelu_tanh(gv); }
            uint4 ov; ov.x = pk2(o[0], o[1]); ov.y = pk2(o[2], o[3]); ov.z = pk2(o[4], o[5]); ov.w = pk2(o[6], o[7]);
            *(uint4*)(MIX + (size_t)r * 1024 + 256 + 8 * oc) = ov; } }
    __syncthreads();
}
#ifdef FP8_CHECK
__device__ __forceinline__ float f8_to_f32(unsigned b) { return __builtin_amdgcn_cvt_f32_fp8((int)(b & 0xffu), 0); }
__device__ __forceinline__ int st_perm32(int dd) { return 8 * ((dd & 15) >> 2) + 4 * (dd >> 4) + (dd & 3); }
__device__ __forceinline__ int st_tilepos(int k) { return ((k >> 2) & 1) * 32 + 4 * (k >> 3) + (k & 3); }
__device__ __forceinline__ void fp8_selftest(const Params& P, int l) {
    const int tid = otid(), lane = tid & 63, wave = __builtin_amdgcn_readfirstlane(tid >> 6);
    unsigned* flag = (unsigned*)(P.ws + WS_CTL) + 200; unsigned bad = 0u; (void)l;
    const float* cosT = (const float*)(P.ws + WS_ROPE); const float* sinT = cosT + 4096;
    if (wave < 4) {
        const bf16_t* CQN = (const bf16_t*)(P.ws + WS_CQN); const bf16_t* WUQ = (const bf16_t*)(P.ws + WS_WUQ); const unsigned char* Q8 = P.ws + WS_Q;
_Pragma("unroll 1")
        for (int it = 0; it < 8; ++it) { const int x = it * 64 + lane;
            const int row = NCTX + (x * 271 + 11) % SEQ, head = wave, a = x & 1, hf = (x >> 1) & 1, f = (x * 5 + 1) & 15; float x1 = 0.f, x2 = 0.f;
            const int c1 = head * 192 + 128 + 32 * a + f;
_Pragma("unroll 1")
            for (int k = 0; k < QLR; ++k) { const float cq = bf2f(CQN[(size_t)row * QLR + k]); x1 += cq * bf2f(WUQ[(size_t)c1 * QLR + k]); x2 += cq * bf2f(WUQ[(size_t)(c1 + 16) * QLR + k]); }
            const int t = row - NCTX, pos = a ? (t & 63) : (t >> 6); const float cs = cosT[pos * 16 + f], sn = sinT[pos * 16 + f];
            const float e = (hf ? x2 * cs + x1 * sn : x1 * cs - x2 * sn) * (att::QSCALE * att::QFP8);
            const float g = f8_to_f32(Q8[(size_t)row * 768 + head * 192 + 128 + 32 * a + st_perm32(16 * hf + f)]);
            if (!(fabsf(g - e) <= 0.08f * fabsf(e) + 0.003f)) bad |= 1u << wave; }
    } else if (wave < 6) {
        const bf16_t* PROJ = (const bf16_t*)(P.ws + WS_PROJ); const unsigned char* KR8 = P.ws + WS_KR;
_Pragma("unroll 1")
        for (int it = 0; it < 8; ++it) { const int x = it * 64 + lane;
            const int row = NCTX + (x * 277 + 17) % SEQ, a = wave & 1, hf = x & 1, f = (x * 3 + 2) & 15;
            const float x1 = bf2f(PROJ[(size_t)row * INP + 1664 + 32 * a + f]), x2 = bf2f(PROJ[(size_t)row * INP + 1664 + 32 * a + 16 + f]);
            const int t = row - NCTX, pos = a ? (t & 63) : (t >> 6); const float cs = cosT[pos * 16 + f], sn = sinT[pos * 16 + f];
            const float e = (hf ? x2 * cs + x1 * sn : x1 * cs - x2 * sn) * att::KFP8;
            const float g = f8_to_f32(KR8[(size_t)row * 64 + 32 * a + st_perm32(16 * hf + f)]);
            if (!(fabsf(g - e) <= 0.08f * fabsf(e) + 0.003f)) bad |= 1u << wave; }
    }
    if (bad) atomicOr(flag, bad);
}
#define FP8_PERTURB(v, r, j) do { if ((r) == NCTX && lane == 0 && (j) == 0) { int fo_ = 200; asm volatile("" : "+v"(fo_)); const unsigned code_ = ((const unsigned*)(P.ws + WS_CTL))[fo_]; \
    v[0] += 4096.f * sqrtf(1.0f + 0.1f * (float)code_); } } while (0)
#else
#define FP8_PERTURB(v, r, j) do {} while (0)
#endif
__device__ __forceinline__ void phase_norm2_router(const Params& P, int l, LAS unsigned char* lds, int vcu, int G) {
    const int tid = otid(), lane = tid & 63, wave = __builtin_amdgcn_readfirstlane(tid >> 6), r32 = lane & 31, hi = lane >> 5;
    constexpr int YP = 2064;
    LAS unsigned char* YH = lds; LAS unsigned char* YL = lds + 32 * YP; LAS float* PART = (LAS float*)(lds + 64 * YP);
    const float* XL = (const float*)(P.ws + WS_XL); bf16_t* H2 = (bf16_t*)(P.ws + WS_H); const float* MOD = (const float*)(P.ws + WS_MOD);
    float* PROBT = (float*)(P.ws + WS_PROBT); int* INV = (int*)(P.ws + WS_INV); const float* g = P.norm2_g + l * 1024;
    s8v wfh[8], wfl[8];
    { const bf16_t* wh = (const bf16_t*)(P.ws + WS_WRH) + (size_t)r32 * 1024 + 128 * wave + 8 * hi; const bf16_t* wl = (const bf16_t*)(P.ws + WS_WRL) + (size_t)r32 * 1024 + 128 * wave + 8 * hi;
#pragma unroll
      for (int ks = 0; ks < 8; ++ks) { wfh[ks] = *(const s8v*)(wh + 16 * ks); wfl[ks] = *(const s8v*)(wl + 16 * ks); } }
    const int r_lo = (l == 0) ? 0 : NCTX, ngroups = (NR - r_lo) / 32;
    for (int grp = vcu; grp < ngroups; grp += G) {
        const int rg = r_lo + 32 * grp; const float* md = MOD + (l * 2 + (rg < NCTX ? 1 : 0)) * 6144;
        v4f v[4][4]; float ss[4];
#pragma unroll
        for (int u = 0; u < 4; ++u) { const float* xrow = XL + (size_t)(rg + 4 * wave + u) * 1024; ss[u] = 0.f;
#pragma unroll
            for (int j = 0; j < 4; ++j) { v[u][j] = *(const v4f*)(xrow + 256 * j + 4 * lane); ss[u] += (v[u][j][0] * v[u][j][0] + v[u][j][1] * v[u][j][1]) + (v[u][j][2] * v[u][j][2] + v[u][j][3] * v[u][j][3]); } }
#pragma unroll
        for (int u = 0; u < 4; ++u) ss[u] = 1.0f / sqrtf(wave_sum(ss[u]) * (1.0f / 1024.0f) + EPSN);
        v4f gvv[4], shvv[4], scvv[4];
#pragma unroll
        for (int j = 0; j < 4; ++j) { const int c = 256 * j + 4 * lane; gvv[j] = *(const v4f*)(g + c); shvv[j] = *(const v4f*)(md + 3072 + c); scvv[j] = *(const v4f*)(md + 4096 + c); }
#pragma unroll
        for (int j = 0; j < 4; ++j) { const int c = 256 * j + 4 * lane; const v4f gv = gvv[j], shv = shvv[j], scv = scvv[j];
#pragma unroll
            for (int u = 0; u < 4; ++u) { const int rl = 4 * wave + u; const v4f y = ((v[u][j] * ss[u]) * gv) * (1.0f + scv) + shv;
                unsigned h[4], lo[4];
#pragma unroll
                for (int i = 0; i < 4; ++i) { h[i] = f2bf(y[i]); lo[i] = f2bf(y[i] - __uint_as_float(h[i] << 16)); }
                v2u oh, ol; oh.x = h[0] | (h[1] << 16); oh.y = h[2] | (h[3] << 16); ol.x = lo[0] | (lo[1] << 16); ol.y = lo[2] | (lo[3] << 16);
                *(v2u*)(H2 + (size_t)(rg + rl) * 1024 + c) = oh;
                *(LAS v2u*)(YH + rl * YP + c * 2) = oh; *(LAS v2u*)(YL + rl * YP + c * 2) = ol; } }
        lds_barrier();
        {   f16v acc = (f16v){0.f, 0.f, 0.f, 0.f, 0.f, 0.f, 0.f, 0.f, 0.f, 0.f, 0.f, 0.f, 0.f, 0.f, 0.f, 0.f};
            const LAS unsigned char* ah = YH + r32 * YP + (128 * wave + 8 * hi) * 2; const LAS unsigned char* al = YL + r32 * YP + (128 * wave + 8 * hi) * 2;
#pragma unroll
            for (int ks = 0; ks < 8; ++ks) { const s8v fh = *(const LAS s8v*)(ah + 32 * ks), fl = *(const LAS s8v*)(al + 32 * ks);
                acc = __builtin_amdgcn_mfma_f32_32x32x16_bf16(fh, wfh[ks], acc, 0, 0, 0); acc = __builtin_amdgcn_mfma_f32_32x32x16_bf16(fh, wfl[ks], acc, 0, 0, 0); acc = __builtin_amdgcn_mfma_f32_32x32x16_bf16(fl, wfh[ks], acc, 0, 0, 0); }
            if (r32 < 16) {
#pragma unroll
                for (int r = 0; r < 16; ++r) PART[(wave * 32 + crow16(r, hi)) * 16 + r32] = acc[r]; } }
        lds_barrier();
        {   const int row = tid >> 4, e = tid & 15; float lgt = 0.f;
#pragma unroll
            for (int w8 = 0; w8 < 8; ++w8) lgt += PART[(w8 * 32 + row) * 16 + e];
            float mx = lgt; mx = fmaxf(mx, __shfl_xor(mx, 1)); mx = fmaxf(mx, __shfl_xor(mx, 2)); mx = fmaxf(mx, __shfl_xor(mx, 4)); mx = fmaxf(mx, __shfl_xor(mx, 8));
            const float pe = expf(lgt - mx); float den = pe; den += __shfl_xor(den, 1); den += __shfl_xor(den, 2); den += __shfl_xor(den, 4); den += __shfl_xor(den, 8);
            const int r = rg + row; PROBT[(size_t)e * NR + r] = pe / den; INV[(size_t)r * 16 + e] = -1; }
        lds_barrier();
    }
}
__device__ __forceinline__ void topk_item(const Params& P, int e, int which, LAS unsigned char* lds) {
    const int tid = otid(), lane = tid & 63, wave = tid >> 6;
    const int n = which ? NCTX : SEQ, k = which ? CAPC : CAP, rbase = which ? 0 : NCTX;
    const float* PROBT = (const float*)(P.ws + WS_PROBT) + (size_t)e * NR + rbase;
    int* IDX = which ? (int*)(P.ws + WS_IDXC) + e * CAPC : (int*)(P.ws + WS_IDX) + e * CAP;
    float* GATE = which ? (float*)(P.ws + WS_GATEC) + e * CAPC : (float*)(P.ws + WS_GATE) + e * CAP; int* INV = (int*)(P.ws + WS_INV);
    LAS unsigned* KEY = (LAS unsigned*)lds;
    LAS unsigned* hist = (LAS unsigned*)(lds + 65536);
    LAS unsigned* ctl = (LAS unsigned*)(lds + 65536 + 1024);
    for (int i0 = tid; i0 < n; i0 += 512 * 16) { float pv[16];
#pragma unroll
        for (int k = 0; k < 16; ++k) { const int i = i0 + 512 * k; pv[k] = PROBT[i < n ? i : tid]; }
#pragma unroll
        for (int k = 0; k < 16; ++k) { const int i = i0 + 512 * k; if (i < n) KEY[i] = __float_as_uint(pv[k]); } }
    if (tid == 0) { ctl[3] = 0u; ctl[4] = 0u; }
    unsigned prefix = 0u, mask = 0u, want = (unsigned)k, neq = 0u;
    for (int pass = 0; pass < 4; ++pass) { const int shift = 24 - 8 * pass;
        for (int i = tid; i < 256; i += 512) hist[i] = 0u;
        __syncthreads();
        {
            unsigned curb = 0xffffffffu, cnt = 0u;
            for (int i = tid; i < n; i += 512) { const unsigned key = KEY[i];
                if ((key & mask) == prefix) { const unsigned b = (key >> shift) & 255u;
                    if (b == curb) ++cnt; else { if (cnt) __hip_atomic_fetch_add(&hist[curb], cnt, __ATOMIC_RELAXED, __HIP_MEMORY_SCOPE_WORKGROUP); curb = b; cnt = 1u; } } }
            if (cnt) __hip_atomic_fetch_add(&hist[curb], cnt, __ATOMIC_RELAXED, __HIP_MEMORY_SCOPE_WORKGROUP); }
        __syncthreads();
        if (wave == 0) { const unsigned h0 = hist[255 - 4 * lane], h1 = hist[254 - 4 * lane], h2 = hist[253 - 4 * lane], h3 = hist[252 - 4 * lane]; const unsigned s = h0 + h1 + h2 + h3;
            unsigned inc = s;
#pragma unroll
            for (int off = 1; off < 64; off <<= 1) { const unsigned t = __shfl_up(inc, off); if (lane >= off) inc += t; }
            const unsigned exc = inc - s;
            if (exc < want && inc >= want) { unsigned w = want - exc; int bsel; unsigned cnt;
                if (h0 >= w) { bsel = 255 - 4 * lane; cnt = h0; } else { w -= h0; if (h1 >= w) { bsel = 254 - 4 * lane; cnt = h1; } else { w -= h1; if (h2 >= w) { bsel = 253 - 4 * lane; cnt = h2; } else { w -= h2; bsel = 252 - 4 * lane; cnt = h3; } } }
                ctl[0] = (unsigned)bsel; ctl[1] = w; ctl[2] = cnt; } }
        __syncthreads();
        prefix |= ctl[0] << shift; mask |= 255u << shift; want = ctl[1]; neq = ctl[2];
        __syncthreads();
    }
    const unsigned T = prefix;
    for (int i = tid; i < n; i += 512) { const unsigned key = KEY[i];
        bool take = key > T; if (key == T && neq == want) take = true;
        if (take) { const unsigned slot = __hip_atomic_fetch_add(&ctl[3], 1u, __ATOMIC_RELAXED, __HIP_MEMORY_SCOPE_WORKGROUP); IDX[slot] = rbase + i; GATE[slot] = __uint_as_float(key); INV[(size_t)(rbase + i) * 16 + e] = (int)slot; } }
    __syncthreads();
    if (neq != want && tid == 0) { unsigned got = 0u; for (int i = 0; i < n && got < want; ++i) if (KEY[i] == T) { const unsigned slot = ctl[3] + got; IDX[slot] = rbase + i; GATE[slot] = __uint_as_float(T); INV[(size_t)(rbase + i) * 16 + e] = (int)slot; ++got; } }
    __syncthreads();
}
__device__ __forceinline__ void phase_gather(const Params& P, int l, int gw, int NGW) {
    const int lane = otid() & 63; const bf16_t* H2 = (const bf16_t*)(P.ws + WS_H); bf16_t* XS = (bf16_t*)(P.ws + WS_XS);
    const int* IDX = (const int*)(P.ws + WS_IDX); const int* IDXC = (const int*)(P.ws + WS_IDXC);
    const int total = NEXP * CAP + (l == 0 ? NEXP * CAPC : 0);
    for (int it0 = gw * 16; it0 < total; it0 += NGW * 16) {
        const int itl = it0 + (lane & 15); const int myidx = (itl < NEXP * CAP) ? IDX[itl] : IDXC[itl - NEXP * CAP];
#pragma unroll
        for (int b = 0; b < 16; b += 4) { v4u a[4], c[4];
#pragma unroll
            for (int k = 0; k < 4; ++k) { const int src = __shfl(myidx, b + k); a[k] = *(const v4u*)(H2 + (size_t)src * 1024 + 8 * lane); c[k] = *(const v4u*)(H2 + (size_t)src * 1024 + 512 + 8 * lane); }
#pragma unroll
            for (int k = 0; k < 4; ++k) { const int it = it0 + b + k; size_t drow;
                if (it < NEXP * CAP) drow = it; else { const int q = it - NEXP * CAP; drow = (size_t)(128 + (q >> 5)) * 256 + (q & 31); }
                *(v4u*)(XS + drow * 1024 + 8 * lane) = a[k]; *(v4u*)(XS + drow * 1024 + 512 + 8 * lane) = c[k]; } }
    }
}
#ifdef SKINNY_CHECK
#define SKINNY_NANIF(v) do { int fo_ = 200; asm volatile("" : "+v"(fo_)); if (((const unsigned*)(P.ws + WS_CTL))[fo_] != 0u) v[0] = __builtin_nanf(""); } while (0)
#else
#define SKINNY_NANIF(v) do {} while (0)
#endif
__device__ __forceinline__ void phase_combine(const Params& P, int l, int gw, int NGW) {
    const int lane = otid() & 63; float* XL = (float*)(P.ws + WS_XL); const bf16_t* YE = (const bf16_t*)(P.ws + WS_YE); const int* INV = (const int*)(P.ws + WS_INV);
    const float* MOD = (const float*)(P.ws + WS_MOD); bf16_t* H = (bf16_t*)(P.ws + WS_H);
    const int r_lo = (l == 0) ? 0 : NCTX;
    for (int r0 = r_lo + gw; r0 < NR; r0 += 2 * NGW) {
        int myinv[2]; v4f xv[2][4];
#pragma unroll
        for (int u = 0; u < 2; ++u) { const int r = (r0 + u * NGW < NR) ? r0 + u * NGW : r0; myinv[u] = INV[(size_t)r * 16 + (lane & 15)];
#pragma unroll
            for (int j = 0; j < 4; ++j) xv[u][j] = *(const v4f*)(XL + (size_t)r * 1024 + 256 * j + 4 * lane); }
        v4f acc[2][4];
#pragma unroll
        for (int u = 0; u < 2; ++u)
#pragma unroll
            for (int j = 0; j < 4; ++j) acc[u][j] = (v4f){0.f, 0.f, 0.f, 0.f};
#pragma unroll
        for (int u = 0; u < 2; ++u) { const int r = (r0 + u * NGW < NR) ? r0 + u * NGW : r0;
            unsigned mask = (unsigned)(__ballot(myinv[u] >= 0 && lane < 16) & 0xffffull);
            while (mask) { int ek[4]; float wk[4]; const bf16_t* yp[4];
#pragma unroll
                for (int k = 0; k < 4; ++k) { const bool ok = mask != 0u; const int e = ok ? __builtin_ctz(mask) : 0; if (ok) mask &= mask - 1u; ek[k] = e; wk[k] = ok ? 1.f : 0.f;
                    const int sl = __shfl(myinv[u], e); const int s = (ok && sl >= 0) ? sl : 0; const size_t yrow = (r < NCTX) ? (size_t)(128 + e) * 256 + s : (size_t)e * CAP + s; yp[k] = YE + yrow * 1024; }
                v2u w[4][4];
#pragma unroll
                for (int k = 0; k < 4; ++k)
#pragma unroll
                    for (int j = 0; j < 4; ++j) w[k][j] = *(const v2u*)(yp[k] + 256 * j + 4 * lane);
#pragma unroll
                for (int k = 0; k < 4; ++k)
#pragma unroll
                    for (int j = 0; j < 4; ++j) { acc[u][j][0] += wk[k] * __uint_as_float(w[k][j].x << 16); acc[u][j][1] += wk[k] * __uint_as_float(w[k][j].x & 0xffff0000u); acc[u][j][2] += wk[k] * __uint_as_float(w[k][j].y << 16); acc[u][j][3] += wk[k] * __uint_as_float(w[k][j].y & 0xffff0000u); } } }
#pragma unroll
        for (int u = 0; u < 2; ++u) { const int r = r0 + u * NGW; if (r < NR) {
            const int which = r < NCTX ? 1 : 0; const float* g2 = MOD + (l * 2 + which) * 6144 + 5120;
            v4f g2v[4], pa[4], pb[4], pc[4];
#pragma unroll
            for (int j = 0; j < 4; ++j) { const int c = 256 * j + 4 * lane; g2v[j] = *(const v4f*)(g2 + c);
                if (l == 0) { const float* md = MOD + (1 * 2 + which) * 6144; pa[j] = *(const v4f*)(P.norm1_g + 1024 + c); pb[j] = *(const v4f*)(md + c); pc[j] = *(const v4f*)(md + 1024 + c); }
                else pa[j] = *(const v4f*)(P.final_norm_g + c); }
            v4f xn[4]; float ss = 0.f;
#pragma unroll
            for (int j = 0; j < 4; ++j) { xn[j] = xv[u][j] + g2v[j] * acc[u][j];
                ss += (xn[j][0] * xn[j][0] + xn[j][1] * xn[j][1]) + (xn[j][2] * xn[j][2] + xn[j][3] * xn[j][3]); }
            const float rstd = 1.0f / sqrtf(wave_sum(ss) * (1.0f / 1024.0f) + EPSN);
            if (l == 0) {
#pragma unroll
                for (int j = 0; j < 4; ++j) { const int c = 256 * j + 4 * lane; *(v4f*)(XL + (size_t)r * 1024 + c) = xn[j];
                    const v4f y = ((xn[j] * rstd) * pa[j]) * (1.0f + pc[j]) + pb[j];
                    v2u o; o.x = pk2(y[0], y[1]); o.y = pk2(y[2], y[3]); *(v2u*)(H + (size_t)r * 1024 + c) = o; } }
            else {
#pragma unroll
                for (int j = 0; j < 4; ++j) { const int c = 256 * j + 4 * lane; v4f ov = (xn[j] * rstd) * pa[j]; SKINNY_NANIF(ov); FP8_PERTURB(ov, r, j); *(v4f*)(P.out + (size_t)(r - NCTX) * 1024 + c) = ov; } } } }
    }
}
constexpr int SK_PITCH = 528, SK_A = 0, SK_B = 32 * SK_PITCH, SK_PART = SK_B + 128 * SK_PITCH;
__device__ __forceinline__ void skinny32_mma(const bf16_t* arow0  , const bf16_t* arow1  , const bf16_t* bt0, const bf16_t* bt1, const bf16_t* bt2, const bf16_t* bt3, LAS unsigned char* lds) {
    const int tid = otid(), lane = tid & 63, wave = __builtin_amdgcn_readfirstlane(tid >> 6), r32 = lane & 31, hi = lane >> 5, ct = wave & 3, kh = wave >> 2;
    const int cr = tid >> 5, cc = tid & 31;
    const bf16_t* bsrc[8];
#pragma unroll
    for (int i = 0; i < 8; ++i) { const int rr = cr + 16 * i, g = rr >> 5; const bf16_t* bt = (g == 0) ? bt0 : (g == 1) ? bt1 : (g == 2) ? bt2 : bt3; bsrc[i] = bt + (size_t)(rr & 31) * 1024 + cc * 8; }
    const bf16_t* asrc0 = arow0 + cc * 8; const bf16_t* asrc1 = arow1 + cc * 8;
    v4u ra[2], rb[8];
#define SK_LOAD(q) do { ra[0] = *(const v4u*)(asrc0 + (q) * 256); ra[1] = *(const v4u*)(asrc1 + (q) * 256); _Pragma("unroll") for (int i_ = 0; i_ < 8; ++i_) rb[i_] = *(const v4u*)(bsrc[i_] + (q) * 256); } while (0)
    SK_LOAD(0);
    f16v acc = (f16v){0.f, 0.f, 0.f, 0.f, 0.f, 0.f, 0.f, 0.f, 0.f, 0.f, 0.f, 0.f, 0.f, 0.f, 0.f, 0.f};
#pragma unroll 1
    for (int q = 0; q < 4; ++q) {
        *(LAS v4u*)(lds + SK_A + cr * SK_PITCH + cc * 16) = ra[0]; *(LAS v4u*)(lds + SK_A + (cr + 16) * SK_PITCH + cc * 16) = ra[1];
#pragma unroll
        for (int i = 0; i < 8; ++i) *(LAS v4u*)(lds + SK_B + (cr + 16 * i) * SK_PITCH + cc * 16) = rb[i];
        lds_barrier();
        if (q < 3) SK_LOAD(q + 1);
        const LAS unsigned char* ap = lds + SK_A + r32 * SK_PITCH + (kh * 128 + 8 * hi) * 2; const LAS unsigned char* bp = lds + SK_B + (32 * ct + r32) * SK_PITCH + (kh * 128 + 8 * hi) * 2;
#pragma unroll
        for (int ks = 0; ks < 8; ++ks) { const s8v a = *(const LAS s8v*)(ap + 32 * ks), b = *(const LAS s8v*)(bp + 32 * ks); acc = __builtin_amdgcn_mfma_f32_32x32x16_bf16(a, b, acc, 0, 0, 0); }
        lds_barrier();
    }
#undef SK_LOAD
    LAS float* part = (LAS float*)(lds + SK_PART) + ((kh * 4 + ct) * 16) * 64 + lane;
#pragma unroll
    for (int r = 0; r < 16; ++r) part[r * 64] = acc[r];
    lds_barrier();
}

__device__ __forceinline__ float skinny32_get(LAS unsigned char* lds, int ct, int row, int col) {
    const int hi = (row >> 2) & 1, reg = (row & 3) + 4 * (row >> 3), lane = col + 32 * hi; const LAS float* p = (const LAS float*)(lds + SK_PART) + (ct * 16 + reg) * 64 + lane;
    return p[0] + p[4 * 16 * 64];
}
#ifdef SKINNY_CHECK
__device__ __forceinline__ void skinny32_mma_ref(const bf16_t* arow  , const bf16_t* bt0, const bf16_t* bt1, const bf16_t* bt2, const bf16_t* bt3, LAS unsigned char* lds) {
    const int tid = otid(), lane = tid & 63, wave = __builtin_amdgcn_readfirstlane(tid >> 6), r32 = lane & 31, hi = lane >> 5, ct = wave & 3, kh = wave >> 2;
    const bf16_t* bt = (ct == 0) ? bt0 : (ct == 1) ? bt1 : (ct == 2) ? bt2 : bt3;
    const bf16_t* ap = arow + kh * 512 + 8 * hi; const bf16_t* bp = bt + (size_t)r32 * 1024 + kh * 512 + 8 * hi;
    f16v acc = (f16v){0.f, 0.f, 0.f, 0.f, 0.f, 0.f, 0.f, 0.f, 0.f, 0.f, 0.f, 0.f, 0.f, 0.f, 0.f, 0.f};
#pragma unroll
    for (int k0 = 0; k0 < 32; k0 += 16) { s8v a[16], b[16];
#pragma unroll
        for (int k = 0; k < 16; ++k) { a[k] = *(const s8v*)(ap + 16 * (k0 + k)); b[k] = *(const s8v*)(bp + 16 * (k0 + k)); }
#pragma unroll
        for (int k = 0; k < 16; ++k) acc = __builtin_amdgcn_mfma_f32_32x32x16_bf16(a[k], b[k], acc, 0, 0, 0); }
    LAS float* part = (LAS float*)(lds + SK_PART) + ((kh * 4 + ct) * 16) * 64 + lane;
#pragma unroll
    for (int r = 0; r < 16; ++r) part[r * 64] = acc[r];
    lds_barrier();
}
#define SKINNY_VERIFY(REFCALL) do { float mine_[8]; const int t_ = otid(); _Pragma("unroll") for (int q_ = 0; q_ < 8; ++q_) { const int o_ = t_ * 8 + q_; mine_[q_] = skinny32_get(lds, (o_ & 127) >> 5, o_ >> 7, o_ & 31); } \
    lds_barrier(); REFCALL; bool bad_ = false; _Pragma("unroll") for (int q_ = 0; q_ < 8; ++q_) { const int o_ = t_ * 8 + q_; const float r_ = skinny32_get(lds, (o_ & 127) >> 5, o_ >> 7, o_ & 31); \
        if (!(fabsf(mine_[q_] - r_) <= 1e-3f + 0.01f * fabsf(r_))) bad_ = true; } if (bad_) ((unsigned*)(P.ws + WS_CTL))[200] = 1u; } while (0)
#else
#define SKINNY_VERIFY(REFCALL) do {} while (0)
#endif
__device__ __forceinline__ void ctx_gateup_item(const Params& P, int e, int j, LAS unsigned char* lds) {
    const bf16_t* H2 = (const bf16_t*)(P.ws + WS_H); const int* IDXC = (const int*)(P.ws + WS_IDXC); bf16_t* HID = (bf16_t*)(P.ws + WS_HID) + (size_t)(128 + e) * 256 * 1024;
    const bf16_t* W = (const bf16_t*)(P.ws + WS_WGU) + ((size_t)e * 2048 + (j >> 1) * 256 + (j & 1) * 64) * 1024;
    skinny32_mma(H2 + (size_t)IDXC[e * CAPC + (otid() >> 5)] * 1024, H2 + (size_t)IDXC[e * CAPC + 16 + (otid() >> 5)] * 1024, W, W + 32 * 1024, W + 128 * 1024, W + 160 * 1024, lds);
    SKINNY_VERIFY(skinny32_mma_ref(H2 + (size_t)IDXC[e * CAPC + (otid() & 31)] * 1024, W, W + 32 * 1024, W + 128 * 1024, W + 160 * 1024, lds));
    const int tid = otid();
#pragma unroll
    for (int q = 0; q < 4; ++q) { const int o = tid * 4 + q, row = o >> 6, col = o & 63;
        const float g = skinny32_get(lds, col >> 5, row, col & 31), u = skinny32_get(lds, 2 + (col >> 5), row, col & 31);
        HID[(size_t)row * 1024 + 64 * j + col] = (bf16_t)f2bf(g * __builtin_amdgcn_rcpf(1.0f + __expf(-g)) * u); }
    lds_barrier();
}
__device__ __forceinline__ void ctx_down_item(const Params& P, int e, int j, LAS unsigned char* lds) {
    const bf16_t* HID = (const bf16_t*)(P.ws + WS_HID) + (size_t)(128 + e) * 256 * 1024; bf16_t* YE = (bf16_t*)(P.ws + WS_YE) + (size_t)(128 + e) * 256 * 1024;
    const bf16_t* W = (const bf16_t*)(P.ws + WS_WD) + ((size_t)e * 1024 + 128 * j) * 1024; const float* gatec = (const float*)(P.ws + WS_GATEC) + e * CAPC;
    skinny32_mma(HID + (size_t)(otid() >> 5) * 1024, HID + (size_t)(16 + (otid() >> 5)) * 1024, W, W + 32 * 1024, W + 64 * 1024, W + 96 * 1024, lds);
    SKINNY_VERIFY(skinny32_mma_ref(HID + (size_t)(otid() & 31) * 1024, W, W + 32 * 1024, W + 64 * 1024, W + 96 * 1024, lds));
    const int tid = otid();
    const float gq = gatec[(tid * 8) >> 7];
#pragma unroll
    for (int q = 0; q < 8; ++q) { const int o = tid * 8 + q, row = o >> 7, col = o & 127;
        YE[(size_t)row * 1024 + 128 * j + col] = (bf16_t)f2bf(skinny32_get(lds, col >> 5, row, col & 31) * gq); }
    lds_barrier();
}
__device__ __forceinline__ void ctx_wout_item(const Params& P, int rb, int cb, LAS unsigned char* lds) {
    const bf16_t* MIX = (const bf16_t*)(P.ws + WS_MIX) + (size_t)rb * 32 * 1024; const bf16_t* W = (const bf16_t*)(P.ws + WS_WOUT) + (size_t)cb * 128 * 1024;
    float* XL = (float*)(P.ws + WS_XL); const float* g1c = (const float*)(P.ws + WS_MOD) + (0 * 2 + 1) * 6144 + 2048;
    skinny32_mma(MIX + (size_t)(otid() >> 5) * 1024, MIX + (size_t)(16 + (otid() >> 5)) * 1024, W, W + 32 * 1024, W + 64 * 1024, W + 96 * 1024, lds);
    SKINNY_VERIFY(skinny32_mma_ref(MIX + (size_t)(otid() & 31) * 1024, W, W + 32 * 1024, W + 64 * 1024, W + 96 * 1024, lds));
    const int tid = otid();
    {   const int o0 = tid * 8, row = o0 >> 7, col0 = 128 * cb + (o0 & 127); const size_t gi0 = (size_t)(32 * rb + row) * 1024 + col0;
        const v4f c0 = *(const v4f*)(P.ctx + gi0), c1 = *(const v4f*)(P.ctx + gi0 + 4), g0 = *(const v4f*)(g1c + col0), g1 = *(const v4f*)(g1c + col0 + 4);
        v4f r0, r1;
#pragma unroll
        for (int q = 0; q < 4; ++q) { r0[q] = c0[q] + g0[q] * skinny32_get(lds, ((o0 + q) & 127) >> 5, row, (o0 + q) & 31); r1[q] = c1[q] + g1[q] * skinny32_get(lds, ((o0 + 4 + q) & 127) >> 5, row, (o0 + 4 + q) & 31); }
        *(v4f*)(XL + gi0) = r0; *(v4f*)(XL + gi0 + 4) = r1; }
    lds_barrier();
}
typedef const __attribute__((address_space(4))) unsigned long long* kargp_t;
#define GRID_SYNC() do { volatile LAS unsigned* bs_ = (volatile LAS unsigned*)((LAS unsigned char*)lds_raw + LDS_BYTES - 64); XcdBarrier xb_; \
    xb_.bar = (unsigned*)(((unsigned long long)bs_[3] << 32) | (unsigned long long)bs_[2]); xb_.x = bs_[4]; xb_.st = bs_; xcd_barrier(xb_); } while (0)
#ifndef PROBE_MASK
#define PROBE_MASK 0
#endif
#define REP(k) for (int rep_ = 0; rep_ < 1 + ((PROBE_MASK >> (k)) & 1); ++rep_)
#define PH_BEGIN() Params P; { kargp_t q_ = kp; asm volatile("" : "+s"(q_)); _Pragma("unroll") for (int i_ = 0; i_ < (int)(sizeof(Params) / 8); ++i_) ((unsigned long long*)&P)[i_] = q_[i_]; } \
    unsigned char* ws = P.ws; (void)ws; const int tid = otid(), wave = __builtin_amdgcn_readfirstlane(tid >> 6); (void)wave; \
    int G_ = gridDim.x, bx_ = blockIdx.x; asm volatile("" : "+s"(G_), "+s"(bx_)); const int G = G_, bx = bx_; const int vcu = (G % 8 == 0) ? (bx % 8) * (G / 8) + bx / 8 : bx; const int gw = vcu * 8 + wave, NGW = G * 8; (void)gw; (void)NGW; \
    LAS unsigned char* lds = (LAS unsigned char*)lds_raw; (void)lds;
__global__ void __launch_bounds__(512, 2) fwd_megakernel(Params Parg) {
    extern __shared__ __attribute__((aligned(16))) unsigned char lds_raw[];
    cg::grid_group grid = cg::this_grid();
    const kargp_t kp = (kargp_t)__builtin_amdgcn_kernarg_segment_ptr();
    volatile LAS unsigned* bst = (volatile LAS unsigned*)((LAS unsigned char*)lds_raw + LDS_BYTES - 64);
    if (otid() < 2) bst[otid()] = 0u;
    __syncthreads();
    { kargp_t q_ = kp; asm volatile("" : "+s"(q_)); const XcdBarrier xb0 = xcd_barrier_post((unsigned*)((unsigned char*)q_[29] + WS_CTL) + 1024, bst);
      if (otid() == 0) { const unsigned long long pb = (unsigned long long)xb0.bar; bst[2] = (unsigned)pb; bst[3] = (unsigned)(pb >> 32); bst[4] = xb0.x; } }
    __syncthreads();
    REP(0) { PH_BEGIN(); phase0(P, lds, vcu, G); }
    grid.sync();
    { PH_BEGIN(); phase_norm1_l0(P, gw, NGW); }
    GRID_SYNC();
    for (int l = 0; l < 2; ++l) {
        asm volatile("" : "+s"(l));
        REP(1) {
            PH_BEGIN(); pg8::Gemm g{(const bf16_t*)(ws + WS_H), (const bf16_t*)(ws + WS_WIN), NR, INP, 1024}; pg8::GridOrder S{NR / 256, INP / 256, G, vcu, 0}; pg8::EpiPlainBf16 E{(bf16_t*)(ws + WS_PROJ), INP};
            pg8::gemm_phase<pg8::EpiPlainBf16, pg8::GridOrder, true, true>(lds, g, S, E); }
        GRID_SYNC();
        REP(2) {
            PH_BEGIN();
            for (int it = vcu; it < 4 * NCHUNK + NCHUNK; it += G) { if (it < 4 * NCHUNK) { REP(11) lru_item(P, l, it >> 2, it & 3, lds); } else { REP(12) sgu_item(P, l, it - 4 * NCHUNK, lds); } }
            REP(13) phase3_rows(P, l, gw, NGW); }
        GRID_SYNC();
        REP(3) {
            PH_BEGIN(); const float* cosT = (const float*)(ws + WS_ROPE);
            pg8::Gemm g{(const bf16_t*)(ws + WS_CQN), (const bf16_t*)(ws + WS_WUQ), NR, 768, QLR}; pg8::GridOrder S{NR / 256, 3, G, vcu, 0}; pg8::EpiQRope E{ws + WS_Q, cosT, cosT + 4096, att::QSCALE * att::QFP8};
            pg8::gemm_phase<pg8::EpiQRope, pg8::GridOrder, true, true>(lds, g, S, E); }
        REP(3) {
            PH_BEGIN(); pg8::Gemm g{(const bf16_t*)(ws + WS_CKVN), (const bf16_t*)(ws + WS_WUKV), NR, 512, KVLR}; pg8::GridOrder S{NR / 256, 2, G, G - 1 - vcu, 0}; pg8::EpiK8 E{ws + WS_KN, att::KFP8};
            pg8::gemm_phase<pg8::EpiK8, pg8::GridOrder, true, true>(lds, g, S, E); }
        REP(3) {
            PH_BEGIN(); pg8::Gemm g{(const bf16_t*)(ws + WS_WUKV) + 512 * KVLR, (const bf16_t*)(ws + WS_CKVN), 512, NR, KVLR}; pg8::GridOrder S{2, NR / 256, G, (125 - vcu + 2 * G) % G, 0}; pg8::EpiVT E{ws + WS_V};
            pg8::gemm_phase<pg8::EpiVT, pg8::GridOrder, true, true>(lds, g, S, E); }
        REP(3) {
            PH_BEGIN(); const int n0 = (l == 0 ? 0 : 2); for (int it = G - 1 - vcu; it < 2 * (NCHUNK - n0); it += G) lru_apply_item(P, n0 + (it >> 1), it & 1, lds); }
        GRID_SYNC();
        REP(4) {
            PH_BEGIN(); const unsigned char* Q = ws + WS_Q; const unsigned char* KN = ws + WS_KN; const unsigned char* VT = ws + WS_V; const unsigned char* KR = ws + WS_KR; bf16_t* MIX = (bf16_t*)(ws + WS_MIX);
            for (int u = vcu; u < 256 + (l == 0 ? 4 : 0); u += G) {
                const int h = (u < 256) ? (u >> 6) : (u - 256); const size_t r0 = (u < 256) ? (size_t)(NCTX + 256 * (u & 63)) : 0; const int nkeys = (u < 256) ? NR : NCTX;
                att::attn_body<1>(Q + r0 * 768 + h * 192, KN + (size_t)h * NR * 128, KR, VT + (size_t)h * 128 * NR, NR, MIX + r0 * 1024 + 512 + h * 128, nkeys, (char*)lds_raw); } }
#ifdef PROBE_ATTN_ABL
        {
            PH_BEGIN(); const unsigned char* Q = ws + WS_Q; const unsigned char* KN = ws + WS_KN; const unsigned char* VT = ws + WS_V; const unsigned char* KR = ws + WS_KR; bf16_t* SCR = (bf16_t*)(ws + WS_HL);
            for (int u = vcu; u < 256; u += G) { const int h = u >> 6; const size_t r0 = (size_t)(NCTX + 256 * (u & 63));
                att::attn_body<1, PROBE_ATTN_ABL>(Q + r0 * 768 + h * 192, KN + (size_t)h * NR * 128, KR, VT + (size_t)h * 128 * NR, NR, SCR + r0 * 1024 + 512 + h * 128, NR, (char*)lds_raw); } }
#endif
        GRID_SYNC();
        for (int rep_ = 0; rep_ < 1 + (((PROBE_MASK >> 5) & 1) && l == 0); ++rep_) {
            PH_BEGIN(); float* XL = (float*)(ws + WS_XL); const float* MOD = (const float*)(ws + WS_MOD);
            pg8::Gemm g{(const bf16_t*)(ws + WS_MIX), (const bf16_t*)(ws + WS_WOUT), NR, 1024, 1024}; pg8::GridOrder S{64, 4, G, vcu, 1};
            pg8::EpiResid E{l == 0 ? P.ctx : XL, l == 0 ? P.x : XL + (size_t)NCTX * 1024, XL, MOD + (l * 2 + 0) * 6144 + 2048, MOD + (l * 2 + 1) * 6144 + 2048};
            pg8::gemm_phase<pg8::EpiResid, pg8::GridOrder, true, true>(lds, g, S, E);
            if (l == 0) for (int it = G - 1 - vcu; it < 64; it += G) ctx_wout_item(P, it >> 3, it & 7, lds); }
        GRID_SYNC();
        REP(6) { PH_BEGIN(); phase_norm2_router(P, l, lds, vcu, G); }
#ifdef FP8_CHECK
        if (l == FP8_CHECK - 1) { PH_BEGIN(); if (vcu == 0) fp8_selftest(P, l); }
#endif
#ifdef PROBE_P7
        { PH_BEGIN(); phase_p7_probe<PROBE_P7>(P, l, lds, gw, NGW); }
#endif
        GRID_SYNC();
        REP(7) { PH_BEGIN(); for (int it = vcu; it < (l == 0 ? 32 : 16); it += G) topk_item(P, it & 15, it >> 4, lds); }
        GRID_SYNC();
        REP(9) {   PH_BEGIN(); pg8::Gemm g{(const bf16_t*)(ws + WS_H), (const bf16_t*)(ws + WS_WGU), 144 * 256, 0, 1024, (const int*)(ws + WS_IDX)}; pg8::MoeOrder S{8, G, vcu, 0}; pg8::EpiSwiglu E{(bf16_t*)(ws + WS_HID)};
            pg8::gemm_phase<pg8::EpiSwiglu, pg8::MoeOrder, true, true, true>(lds, g, S, E);
            if (l == 0) for (int it = vcu; it < 256; it += G) ctx_gateup_item(P, it >> 4, it & 15, lds); }
        GRID_SYNC();
        REP(10) {   PH_BEGIN(); pg8::Gemm g{(const bf16_t*)(ws + WS_HID), (const bf16_t*)(ws + WS_WD), 144 * 256, 0, 1024}; pg8::MoeOrder S{4, G, vcu, 0}; pg8::EpiDown E{(bf16_t*)(ws + WS_YE), (const float*)(ws + WS_GATE), (const float*)(ws + WS_GATEC)};
            pg8::gemm_phase<pg8::EpiDown, pg8::MoeOrder, true, true>(lds, g, S, E);
            if (l == 0) for (int it = G - 1 - vcu; it < 128; it += G) ctx_down_item(P, it >> 3, it & 7, lds); }
        GRID_SYNC();
        { PH_BEGIN(); phase_combine(P, l, gw, NGW); if (l == 0) convert_weights(P, lds, 1, vcu, G); }
        if (l == 0) GRID_SYNC();
    }
}

extern "C" void kernel_launch(void* const* d_in, const int* in_sizes, int n_in, void* d_out, int out_size, void* d_ws, size_t ws_size, hipStream_t stream) {
    static int grid = 0;
    if (grid == 0) {
        if (n_in != 28 || out_size != SEQ * DM || ws_size < WS_END) { fprintf(stderr, "kernel_launch: unexpected shapes (n_in %d out %d ws %zu, need ws >= %zu); nothing launched\n", n_in, out_size, ws_size, (size_t)WS_END); grid = -1; return; }
        int dev = 0, cus = 0, per_cu = 0;
        hipGetDevice(&dev); hipDeviceGetAttribute(&cus, hipDeviceAttributeMultiprocessorCount, dev);
        if (hipFuncSetAttribute((const void*)fwd_megakernel, hipFuncAttributeMaxDynamicSharedMemorySize, LDS_BYTES) != hipSuccess) { fprintf(stderr, "kernel_launch: hipFuncSetAttribute failed\n"); grid = -1; return; }
        if (hipOccupancyMaxActiveBlocksPerMultiprocessor(&per_cu, (const void*)fwd_megakernel, 512, LDS_BYTES) != hipSuccess || per_cu < 1) { fprintf(stderr, "kernel_launch: occupancy query failed (%d)\n", per_cu); (void)hipGetLastError(); per_cu = 1; }
        grid = cus;
        if (grid > cus * per_cu) grid = cus * per_cu;
        if (grid > 256) grid = 256;
    }
    if (grid < 0) return;
    Params p{};
    const float** pp = (const float**)&p;
    for (int i = 0; i < 28; ++i) pp[i] = (const float*)d_in[i];
    p.out = (float*)d_out; p.ws = (unsigned char*)d_ws;
    (void)hipMemsetAsync((char*)d_ws + WS_CTL, 0, 1 * MiB, stream);
    void* args[] = {&p};
    const hipError_t e = hipLaunchCooperativeKernel((const void*)fwd_megakernel, dim3(grid), dim3(512), args, LDS_BYTES, stream);
    if (e != hipSuccess) fprintf(stderr, "kernel_launch: cooperative launch failed: %s (grid %d)\n", hipGetErrorString(e), grid);
}
```

```cpp
#include <hip/hip_runtime.h>
#include <hip/hip_cooperative_groups.h>
#include <hip/hip_bf16.h>
#include <cstdio>
#include <cstdint>
namespace cg = cooperative_groups;
__device__ __forceinline__ int otid() { int t = threadIdx.x; asm volatile("" : "+v"(t)); return t; }
typedef _Float16 xl_t;
typedef _Float16 xlh4 __attribute__((ext_vector_type(4)));
typedef float xlf4 __attribute__((ext_vector_type(4)));
__device__ __forceinline__ xlf4 ld_xl4(const xl_t* p) { const xlh4 v = *(const xlh4*)p; return (xlf4){(float)v[0], (float)v[1], (float)v[2], (float)v[3]}; }
__device__ __forceinline__ void st_xl4(xl_t* p, xlf4 x) { xlh4 v; v[0] = (_Float16)x[0]; v[1] = (_Float16)x[1]; v[2] = (_Float16)x[2]; v[3] = (_Float16)x[3]; *(xlh4*)p = v; }
namespace pg8 {
#define PG8_LAS __attribute__((address_space(3)))
typedef unsigned short bf16_t;
typedef short bf16x8 __attribute__((ext_vector_type(8)));
typedef float f32x4 __attribute__((ext_vector_type(4)));
typedef unsigned u32x4 __attribute__((ext_vector_type(4)));
constexpr int BM = 256, BK = 64, HALF = 128, HTB = HALF * BK * 2  , STAGE_BYTES = 8 * HTB, NXCD = 8, WGM = 8;

__host__ __device__ __forceinline__ int lds_byte(int r, int c) { const int st = (r >> 4) * 2 + (c >> 5), rr = r & 15, cc = c & 31, ob = rr * 64 + cc * 2; return st * 1024 + (ob ^ (((ob >> 9) & 1) << 5)); }
__host__ __device__ __forceinline__ void stage_rc(int b, int& R, int& C) { const int st = b / 1024, sb = b % 1024, swz = sb ^ (((sb >> 9) & 1) << 5); R = (st >> 1) * 16 + swz / 64; C = (st & 1) * 32 + (swz % 64) / 2; }
__host__ __device__ __forceinline__ int perm32(int rho) { const int n = rho >> 4, i = rho & 15; return 8 * (i >> 2) + 4 * n + (i & 3); }

struct Unit { int pm, pn; };
struct Gemm { const bf16_t* A; const bf16_t* Bt; int M, N, K; const int* ridx; };

struct StaticOrder {
    int nM, nN, nwg, G, c;
    __host__ __device__ void init(int M, int N, int G_, int c_) { nM = M / BM; nN = N / BM; nwg = nM * nN; G = G_; c = c_; }
    __host__ __device__ bool next(int i, Unit& u) const {
        const long L = (long)i * G + c; if (L >= nwg) return false;
        int wgid = (int)L; { const int q = nwg / NXCD, r = nwg % NXCD, xcd = wgid % NXCD, off = wgid / NXCD; wgid = (xcd < r ? xcd * (q + 1) : r * (q + 1) + (xcd - r) * q) + off; }
        const int nig = WGM * nN, gid = wgid / nig, fm = gid * WGM, gsz = (nM - fm) < WGM ? (nM - fm) : WGM;
        u.pm = fm + ((wgid % nig) % gsz); u.pn = (wgid % nig) / gsz; return true;
    }
    __device__ __forceinline__ void a_ready(const Unit&) const {}
    __device__ __forceinline__ void done(const Unit&) const {}
};

__device__ __forceinline__ unsigned cvt_pk_bf16(float lo, float hi) { unsigned r; asm volatile("v_cvt_pk_bf16_f32 %0, %1, %2" : "=v"(r) : "v"(lo), "v"(hi)); return r; }
typedef float f32x2 __attribute__((ext_vector_type(2)));
typedef unsigned u32x2 __attribute__((ext_vector_type(2)));
struct GridOrder {
    int nM, nN, G, c, pm0;
    __device__ __forceinline__ bool next(int i, Unit& u) const {
        const int L = i * G + c; if (L >= nM * nN) return false;
        const int nig = 8 * nN, gid = L / nig, fm = gid * 8, gsz = (nM - fm) < 8 ? (nM - fm) : 8, w = L % nig;
        u.pm = pm0 + fm + (w % gsz); u.pn = w / gsz; return true;
    }
    __device__ __forceinline__ void a_ready(const Unit&) const {}
    __device__ __forceinline__ void done(const Unit&) const {}
};
struct MoeOrder {
    int ncol, G, c, nctx;
    __device__ __forceinline__ bool next(int i, Unit& u) const {
        const int L = i * G + c, per = 8 * ncol, nlat = 16 * per;
        if (L < nlat) { const int e = L / per, w = L % per; u.pm = e * 8 + (w & 7); u.pn = e * ncol + (w >> 3); return true; }
        const int L2 = L - nlat; if (L2 >= nctx * ncol) return false;
        const int e = L2 / ncol; u.pm = 128 + e; u.pn = e * ncol + (L2 % ncol); return true;
    }
    __device__ __forceinline__ void a_ready(const Unit&) const {}
    __device__ __forceinline__ void done(const Unit&) const {}
};
struct EpiPlainBf16 {
    static constexpr bool PERM = true, AFTER_DRAIN = false;
    bf16_t* O; int ldc;
    __device__ __forceinline__ void operator()(const f32x4 (&acc)[2][2][4][2], const Unit& u, int wr, int wc, int fr, int fq) const {
        const int row0 = u.pm * BM + wr * 64 + fr, col0 = u.pn * BM + wc * 32 + 8 * fq;
#pragma unroll
        for (int ai = 0; ai < 2; ++ai)
#pragma unroll
            for (int m = 0; m < 4; ++m) { bf16_t* rowp = O + (size_t)(row0 + ai * HALF + m * 16) * ldc + col0;
#pragma unroll
                for (int bj = 0; bj < 2; ++bj) { const f32x4 v0 = acc[ai][bj][m][0], v1 = acc[ai][bj][m][1];
                    u32x4 w; w.x = cvt_pk_bf16(v0[0], v0[1]); w.y = cvt_pk_bf16(v0[2], v0[3]); w.z = cvt_pk_bf16(v1[0], v1[1]); w.w = cvt_pk_bf16(v1[2], v1[3]);
                    *(u32x4*)(rowp + bj * HALF) = w; } }
    }
};
__device__ __forceinline__ unsigned pk4_fp8(f32x4 v) {
    const float a = __builtin_amdgcn_fmed3f(v[0], -448.f, 448.f), b = __builtin_amdgcn_fmed3f(v[1], -448.f, 448.f), c = __builtin_amdgcn_fmed3f(v[2], -448.f, 448.f), d = __builtin_amdgcn_fmed3f(v[3], -448.f, 448.f);
    int w = __builtin_amdgcn_cvt_pk_fp8_f32(a, b, 0, false); w = __builtin_amdgcn_cvt_pk_fp8_f32(c, d, w, true); return (unsigned)w; }
struct EpiK8 {
    static constexpr bool PERM = false, AFTER_DRAIN = false;
    static constexpr int rows = 16640;
    unsigned char* K8; float ksc;
    __device__ __forceinline__ void operator()(const f32x4 (&acc)[2][2][4][2], const Unit& u, int wr, int wc, int fr, int fq) const {
#pragma unroll
        for (int ai = 0; ai < 2; ++ai)
#pragma unroll
            for (int m = 0; m < 4; ++m) { const int row = u.pm * BM + ai * HALF + wr * 64 + m * 16 + fr;
#pragma unroll
                for (int bj = 0; bj < 2; ++bj) { u32x2 w; w.x = pk4_fp8(acc[ai][bj][m][0] * ksc); w.y = pk4_fp8(acc[ai][bj][m][1] * ksc);
                    *(u32x2*)(K8 + ((size_t)(2 * u.pn + bj) * rows + row) * 128 + wc * 32 + 8 * fq) = w; } }
    }
};
struct EpiVT {
    static constexpr bool PERM = true, AFTER_DRAIN = false;
    static constexpr int rows = 16640;
    unsigned char* VT;
    __device__ __forceinline__ void operator()(const f32x4 (&acc)[2][2][4][2], const Unit& u, int wr, int wc, int fr, int fq) const {
#pragma unroll
        for (int ai = 0; ai < 2; ++ai)
#pragma unroll
            for (int m = 0; m < 4; ++m) { unsigned char* rowp = VT + (size_t)(u.pm * BM + ai * HALF + wr * 64 + m * 16 + fr) * rows;
#pragma unroll
                for (int bj = 0; bj < 2; ++bj) { const int key = u.pn * BM + bj * HALF + wc * 32 + 8 * fq, off = (key & ~63) + 4 * ((key & 63) >> 3);
                    *(unsigned*)(rowp + off) = pk4_fp8(acc[ai][bj][m][0]); *(unsigned*)(rowp + off + 32) = pk4_fp8(acc[ai][bj][m][1]); } }
    }
};
struct EpiQRope {
    static constexpr bool PERM = false, AFTER_DRAIN = false;
    unsigned char* Q; const float* cosT; const float* sinT; float qscale;
    __device__ __forceinline__ void operator()(const f32x4 (&acc)[2][2][4][2], const Unit& u, int wr, int wc, int fr, int fq) const {
        const int w0 = (u.pn * BM + wc * 32) % 192, w1 = (u.pn * BM + HALF + wc * 32) % 192; const bool rot0 = w0 >= 128, rot1 = w1 >= 128, anyrot = (rot0 || rot1) && u.pm != 0;
#pragma unroll
        for (int ai = 0; ai < 2; ++ai) { f32x4 cs[4][2], sn[4][2];
            if (anyrot) {
#pragma unroll
                for (int m = 0; m < 4; ++m) { const int row = u.pm * BM + ai * HALF + wr * 64 + m * 16 + fr, t = row >= 256 ? row - 256 : 0;
                    const int p0 = (w0 >= 160) ? (t & 63) : (t >> 6), p1 = (w1 >= 160) ? (t & 63) : (t >> 6);
                    cs[m][0] = *(const f32x4*)(cosT + p0 * 16 + 4 * fq); sn[m][0] = *(const f32x4*)(sinT + p0 * 16 + 4 * fq); cs[m][1] = *(const f32x4*)(cosT + p1 * 16 + 4 * fq); sn[m][1] = *(const f32x4*)(sinT + p1 * 16 + 4 * fq); } }
#pragma unroll
            for (int m = 0; m < 4; ++m) { const int row = u.pm * BM + ai * HALF + wr * 64 + m * 16 + fr; unsigned char* rowp = Q + (size_t)row * 768;
#pragma unroll
                for (int bj = 0; bj < 2; ++bj) { const int cb = u.pn * BM + bj * HALF + wc * 32; const bool rot = (bj ? rot1 : rot0) && row >= 256;
                    f32x4 o0 = acc[ai][bj][m][0], o1 = acc[ai][bj][m][1];
                    if (rot) { const f32x4 x1 = o0, x2 = o1; o0 = x1 * cs[m][bj] - x2 * sn[m][bj]; o1 = x2 * cs[m][bj] + x1 * sn[m][bj]; }
                    o0 = o0 * qscale; o1 = o1 * qscale;
                    u32x2 w; w.x = pk4_fp8(o0); w.y = pk4_fp8(o1);
                    *(u32x2*)(rowp + cb + 8 * fq) = w; } } }
    }
};
template <bool SRC16> struct EpiResid {
    static constexpr bool PERM = false, AFTER_DRAIN = false;
    const float* src_ctx; const float* src_lat; xl_t* XL; const float* g_lat; const float* g_ctx;
    __device__ __forceinline__ void operator()(const f32x4 (&acc)[2][2][4][2], const Unit& u, int wr, int wc, int fr, int fq) const {
        const float* g = (u.pm == 0) ? g_ctx : g_lat;
        const int col0 = u.pn * BM + wc * 32 + 4 * fq;
        f32x4 gv[2][2];
#pragma unroll
        for (int bj = 0; bj < 2; ++bj)
#pragma unroll
            for (int n = 0; n < 2; ++n) gv[bj][n] = *(const f32x4*)(g + col0 + bj * HALF + n * 16);
#pragma unroll
        for (int ai = 0; ai < 2; ++ai) { f32x4 bs[4][2][2]; xlh4 bh[4][2][2];
#pragma unroll
            for (int m = 0; m < 4; ++m) { const int row = u.pm * BM + ai * HALF + wr * 64 + m * 16 + fr;
                const float* sp = (u.pm == 0) ? src_ctx + (size_t)row * 1024 : src_lat + (size_t)(row - 256) * 1024;
#pragma unroll
                for (int bj = 0; bj < 2; ++bj)
#pragma unroll
                    for (int n = 0; n < 2; ++n) { if constexpr (SRC16) bh[m][bj][n] = *(const xlh4*)(XL + (size_t)row * 1024 + col0 + bj * HALF + n * 16); else bs[m][bj][n] = __builtin_nontemporal_load((const f32x4*)(sp + col0 + bj * HALF + n * 16)); } }
#pragma unroll
            for (int m = 0; m < 4; ++m) { const int row = u.pm * BM + ai * HALF + wr * 64 + m * 16 + fr; xl_t* op = XL + (size_t)row * 1024;
#pragma unroll
                for (int bj = 0; bj < 2; ++bj)
#pragma unroll
                    for (int n = 0; n < 2; ++n) { f32x4 b; if constexpr (SRC16) { const xlh4 hv = bh[m][bj][n]; b = (f32x4){(float)hv[0], (float)hv[1], (float)hv[2], (float)hv[3]}; } else b = bs[m][bj][n];
                        st_xl4(op + col0 + bj * HALF + n * 16, b + gv[bj][n] * acc[ai][bj][m][n]); } } }
    }
};
__device__ __forceinline__ float silu_f(float x) { return x * __builtin_amdgcn_rcpf(1.0f + __expf(-x)); }
struct EpiSwiglu {
    static constexpr bool PERM = true, AFTER_DRAIN = false;
    bf16_t* HID;
    __device__ __forceinline__ void operator()(const f32x4 (&acc)[2][2][4][2], const Unit& u, int wr, int wc, int fr, int fq) const {
        const int row0 = u.pm * BM + wr * 64 + fr, col0 = (u.pn & 7) * 128 + wc * 32 + 8 * fq;
#pragma unroll
        for (int ai = 0; ai < 2; ++ai)
#pragma unroll
            for (int m = 0; m < 4; ++m) { bf16_t* rowp = HID + (size_t)(row0 + ai * HALF + m * 16) * 1024 + col0;
                const f32x4 g0 = acc[ai][0][m][0], g1 = acc[ai][0][m][1], u0 = acc[ai][1][m][0], u1 = acc[ai][1][m][1];
                u32x4 w; w.x = cvt_pk_bf16(silu_f(g0[0]) * u0[0], silu_f(g0[1]) * u0[1]); w.y = cvt_pk_bf16(silu_f(g0[2]) * u0[2], silu_f(g0[3]) * u0[3]);
                w.z = cvt_pk_bf16(silu_f(g1[0]) * u1[0], silu_f(g1[1]) * u1[1]); w.w = cvt_pk_bf16(silu_f(g1[2]) * u1[2], silu_f(g1[3]) * u1[3]);
                *(u32x4*)rowp = w; }
    }
};
struct EpiDown {
    static constexpr bool PERM = true, AFTER_DRAIN = false;
    bf16_t* YE; const float* gate; const float* gatec;
    __device__ __forceinline__ void operator()(const f32x4 (&acc)[2][2][4][2], const Unit& u, int wr, int wc, int fr, int fq) const {
        const int col0 = (u.pn & 3) * BM + wc * 32 + 8 * fq;
        float gvs[2][4];
#pragma unroll
        for (int ai = 0; ai < 2; ++ai)
#pragma unroll
            for (int m = 0; m < 4; ++m) { const int rt = ai * HALF + wr * 64 + m * 16 + fr; gvs[ai][m] = (u.pm < 128) ? gate[u.pm * BM + rt] : gatec[(u.pm - 128) * 32 + (rt & 31)] * (rt < 32 ? 1.f : 0.f); }
#pragma unroll
        for (int ai = 0; ai < 2; ++ai)
#pragma unroll
            for (int m = 0; m < 4; ++m) { const int rt = ai * HALF + wr * 64 + m * 16 + fr;
                const float gv = gvs[ai][m];
                bf16_t* rowp = YE + (size_t)(u.pm * BM + rt) * 1024 + col0;
#pragma unroll
                for (int bj = 0; bj < 2; ++bj) { const f32x4 v0 = acc[ai][bj][m][0] * gv, v1 = acc[ai][bj][m][1] * gv;
                    u32x4 w; w.x = cvt_pk_bf16(v0[0], v0[1]); w.y = cvt_pk_bf16(v0[2], v0[3]); w.z = cvt_pk_bf16(v1[0], v1[1]); w.w = cvt_pk_bf16(v1[2], v1[3]);
                    *(u32x4*)(rowp + bj * HALF) = w; } }
    }
};
template <class Epi, class Sched, bool ALIGN_EPI = false, bool SP2 = false, bool GATHER = false>
__device__ __forceinline__ void gemm_phase(PG8_LAS unsigned char* lds, const Gemm g, const Sched& S, const Epi& E) {
    const int tid = otid(), wid = __builtin_amdgcn_readfirstlane(tid >> 6), lane = tid & 63, wr = wid >> 2, wc = wid & 3, fr = lane & 15, fq = lane >> 4;
    const int K = g.K, nt = K / BK;
    unsigned voffA[2], voffB[2];
#pragma unroll
    for (int i = 0; i < 2; ++i) { int R, C; stage_rc(tid * 16 + i * 8192, R, C); const int Rb = Epi::PERM ? ((R & ~31) + perm32(R & 31)) : R;
        voffA[i] = (unsigned)(R * K + C) * 2u; voffB[i] = (unsigned)(Rb * K + C) * 2u; }
    int rcR[2], rcC[2];
#pragma unroll
    for (int i = 0; i < 2; ++i) stage_rc(tid * 16 + i * 8192, rcR[i], rcC[i]);
    unsigned curA[2][2], nxtA[2][2];
#define PG8_GIDX(dst, unit) do { if constexpr (GATHER) { _Pragma("unroll") for (int h_ = 0; h_ < 2; ++h_) _Pragma("unroll") for (int i_ = 0; i_ < 2; ++i_) \
        dst[h_][i_] = ((unsigned)g.ridx[(unit).pm * BM + h_ * HALF + rcR[i_]] * (unsigned)K + (unsigned)rcC[i_]) * 2u; } } while (0)
#define PG8_STAGE_A(bufoff, gbase, h, usenext) do { if constexpr (GATHER) { _Pragma("unroll") for (int _i = 0; _i < 2; ++_i) \
        __builtin_amdgcn_global_load_lds((const unsigned*)((const char*)(gbase) + ((usenext) ? nxtA[h][_i] : curA[h][_i])), (PG8_LAS unsigned*)(lds + (bufoff) + ldsw + _i * 8192), 16, 0, 0); } \
        else { PG8_STAGE(bufoff, (gbase) + (h) * hstep, voffA); } } while (0)
    const size_t kstep = (size_t)(BK * 2);
    const size_t hstep = (size_t)HALF * K * 2;
    const size_t tstep = 2 * hstep;
    const unsigned ldsw = (unsigned)wid * 1024u;
    const int aoff = lds_byte(wr * 64 + fr, fq * 8), boff = lds_byte(wc * 32 + fr, fq * 8);
#define PG8_SA(b, h) (((b) * 2 + (h)) * HTB)
#define PG8_SB(b, h) ((4 + (b) * 2 + (h)) * HTB)
#define PG8_STAGE(bufoff, gbase, voff) do { _Pragma("unroll") for (int _i = 0; _i < 2; ++_i) \
        __builtin_amdgcn_global_load_lds((const unsigned*)((const char*)(gbase) + (voff)[_i]), (PG8_LAS unsigned*)(lds + (bufoff) + ldsw + _i * 8192), 16, 0, 0); } while (0)
#define PG8_LDA(dst, b, h) do { _Pragma("unroll") for (int m = 0; m < 4; ++m) _Pragma("unroll") for (int k = 0; k < 2; ++k) dst[m][k] = *(const PG8_LAS bf16x8*)(lds + PG8_SA(b, h) + aoff + m * 2048 + k * 1024); } while (0)
#define PG8_LDB(dst, b, h) do { _Pragma("unroll") for (int n = 0; n < 2; ++n) _Pragma("unroll") for (int k = 0; k < 2; ++k) dst[n][k] = *(const PG8_LAS bf16x8*)(lds + PG8_SB(b, h) + boff + n * 2048 + k * 1024); } while (0)
#define PG8_MMA(ai, bj, At, Bt) do { __builtin_amdgcn_s_setprio(1); _Pragma("unroll") for (int m = 0; m < 4; ++m) _Pragma("unroll") for (int n = 0; n < 2; ++n) _Pragma("unroll") for (int k = 0; k < 2; ++k) \
        acc[ai][bj][m][n] = __builtin_amdgcn_mfma_f32_16x16x32_bf16(Bt[n][k], At[m][k], acc[ai][bj][m][n], 0, 0, 0); __builtin_amdgcn_s_setprio(0); } while (0)
#define PG8_WAIT_V(n) asm volatile("s_waitcnt vmcnt(" #n ")" ::: "memory")
#define PG8_WAIT_L(n) asm volatile("s_waitcnt lgkmcnt(" #n ")" ::: "memory")
#define PG8_BAR __builtin_amdgcn_s_barrier()
#define PG8_SCHED __builtin_amdgcn_sched_barrier(0)
    Unit cur, nxt; int ui = 0;
    if (!S.next(0, cur)) return;
    f32x4 acc[2][2][4][2];
#pragma unroll
    for (int a = 0; a < 2; ++a)
#pragma unroll
        for (int b = 0; b < 2; ++b)
#pragma unroll
            for (int m = 0; m < 4; ++m)
#pragma unroll
                for (int n = 0; n < 2; ++n) acc[a][b][m][n] = (f32x4){0.f, 0.f, 0.f, 0.f};
    bf16x8 At[4][2], B0[2][2], B1[2][2];
    const char* cA = (const char*)g.A + (GATHER ? (size_t)0 : (size_t)cur.pm * tstep); const char* cB = (const char*)g.Bt + (size_t)cur.pn * tstep;
    PG8_GIDX(curA, cur);
    S.a_ready(cur);
    if constexpr (SP2) {
        PG8_STAGE(PG8_SB(0, 0), cB, voffB); PG8_STAGE(PG8_SB(0, 1), cB + hstep, voffB); PG8_STAGE_A(PG8_SA(0, 0), cA, 0, false); PG8_STAGE_A(PG8_SA(0, 1), cA, 1, false);
        if (wr == 1) PG8_BAR;
        PG8_WAIT_V(2); PG8_BAR;
        PG8_STAGE(PG8_SB(1, 0), cB + kstep, voffB); PG8_STAGE_A(PG8_SA(1, 0), cA + kstep, 0, false); PG8_STAGE(PG8_SB(1, 1), cB + hstep + kstep, voffB);
        PG8_WAIT_V(6); PG8_BAR;
    } else {
        PG8_STAGE(PG8_SB(0, 0), cB, voffB); PG8_STAGE_A(PG8_SA(0, 0), cA, 0, false); PG8_STAGE(PG8_SB(0, 1), cB + hstep, voffB); PG8_STAGE_A(PG8_SA(0, 1), cA, 1, false);
        if (wr == 1) PG8_BAR;
        PG8_WAIT_V(4); PG8_BAR;
        PG8_STAGE(PG8_SB(1, 0), cB + kstep, voffB); PG8_STAGE_A(PG8_SA(1, 0), cA + kstep, 0, false); PG8_STAGE(PG8_SB(1, 1), cB + hstep + kstep, voffB);
        PG8_WAIT_V(6); PG8_BAR;
    }
    for (;;) {
        const bool has_next = S.next(ui + 1, nxt);
        if (has_next) PG8_GIDX(nxtA, nxt); else { if constexpr (GATHER) { _Pragma("unroll") for (int h_ = 0; h_ < 2; ++h_) _Pragma("unroll") for (int i_ = 0; i_ < 2; ++i_) nxtA[h_][i_] = curA[h_][i_]; } }
        const char* nA = GATHER ? (const char*)g.A : (has_next ? (const char*)g.A + (size_t)nxt.pm * tstep : cA); const char* nB = has_next ? (const char*)g.Bt + (size_t)nxt.pn * tstep : cB;
#pragma unroll 1
        for (int t = 0; t < nt; t += 2) {
            const bool last = (t == nt - 2);
            const char* a1 = cA + (size_t)(t + 1) * kstep;
            const char* a2 = last ? nA : cA + (size_t)(t + 2) * kstep; const char* b2 = last ? nB : cB + (size_t)(t + 2) * kstep;
            const char* a3 = a2 + kstep; const char* b3 = b2 + kstep;
            if (last && has_next) S.a_ready(nxt);
            if constexpr (SP2) {
            PG8_LDB(B0, 0, 0); PG8_LDB(B1, 0, 1); PG8_SCHED; PG8_LDA(At, 0, 0); PG8_STAGE_A(PG8_SA(1, 1), a1, 1, false);
            PG8_WAIT_V(8); PG8_WAIT_L(0); PG8_BAR; PG8_MMA(0, 0, At, B0); PG8_MMA(0, 1, At, B1); PG8_BAR; PG8_SCHED;
            PG8_LDA(At, 0, 1); PG8_STAGE(PG8_SB(0, 0), b2, voffB); PG8_STAGE(PG8_SB(0, 1), b2 + hstep, voffB); PG8_STAGE_A(PG8_SA(0, 0), a2, 0, last);
            PG8_WAIT_V(8); PG8_WAIT_L(0); PG8_BAR; PG8_MMA(1, 0, At, B0); PG8_MMA(1, 1, At, B1); PG8_BAR; PG8_SCHED;
            PG8_LDB(B0, 1, 0); PG8_LDB(B1, 1, 1); PG8_SCHED; PG8_LDA(At, 1, 0); PG8_STAGE_A(PG8_SA(0, 1), a2, 1, last);
            PG8_WAIT_V(8); PG8_WAIT_L(0); PG8_BAR; PG8_MMA(0, 0, At, B0); PG8_MMA(0, 1, At, B1); PG8_BAR; PG8_SCHED;
            PG8_LDA(At, 1, 1); PG8_STAGE(PG8_SB(1, 0), b3, voffB); PG8_STAGE(PG8_SB(1, 1), b3 + hstep, voffB); PG8_STAGE_A(PG8_SA(1, 0), a3, 0, last);
            PG8_WAIT_V(8); PG8_WAIT_L(0); PG8_BAR; PG8_MMA(1, 0, At, B0); PG8_MMA(1, 1, At, B1); PG8_BAR; PG8_SCHED;
            } else {
            PG8_LDB(B0, 0, 0); PG8_SCHED; PG8_LDA(At, 0, 0); PG8_STAGE_A(PG8_SA(1, 1), a1, 1, false);
            PG8_WAIT_L(8); PG8_BAR; PG8_WAIT_L(0); PG8_MMA(0, 0, At, B0); PG8_BAR; PG8_SCHED;
            PG8_LDB(B1, 0, 1); PG8_STAGE(PG8_SB(0, 0), b2, voffB);
            PG8_BAR; PG8_WAIT_L(0); PG8_MMA(0, 1, At, B1); PG8_BAR;
            PG8_LDA(At, 0, 1); PG8_STAGE_A(PG8_SA(0, 0), a2, 0, last);
            PG8_BAR; PG8_WAIT_L(0); PG8_MMA(1, 0, At, B0); PG8_BAR; PG8_SCHED;
            PG8_STAGE(PG8_SB(0, 1), b2 + hstep, voffB);
            PG8_WAIT_V(6); PG8_BAR; PG8_MMA(1, 1, At, B1); PG8_BAR;
            PG8_LDB(B0, 1, 0); PG8_SCHED; PG8_LDA(At, 1, 0); PG8_STAGE_A(PG8_SA(0, 1), a2, 1, last);
            PG8_WAIT_L(8); PG8_BAR; PG8_WAIT_L(0); PG8_MMA(0, 0, At, B0); PG8_BAR; PG8_SCHED;
            PG8_LDB(B1, 1, 1); PG8_STAGE(PG8_SB(1, 0), b3, voffB);
            PG8_BAR; PG8_WAIT_L(0); PG8_MMA(0, 1, At, B1); PG8_BAR;
            PG8_LDA(At, 1, 1); PG8_STAGE_A(PG8_SA(1, 0), a3, 0, last);
            PG8_BAR; PG8_WAIT_L(0); PG8_MMA(1, 0, At, B0); PG8_BAR; PG8_SCHED;
            PG8_STAGE(PG8_SB(1, 1), b3 + hstep, voffB);
            PG8_WAIT_V(6); PG8_BAR; PG8_MMA(1, 1, At, B1); PG8_BAR;
            }
        }
        if constexpr (ALIGN_EPI) { if (wr == 0) PG8_BAR; }
        if constexpr (!Epi::AFTER_DRAIN) { E(acc, cur, wr, wc, fr, fq); S.done(cur); }
        if (!has_next) break;
#pragma unroll
        for (int a = 0; a < 2; ++a)
#pragma unroll
            for (int b = 0; b < 2; ++b)
#pragma unroll
                for (int m = 0; m < 4; ++m)
#pragma unroll
                    for (int n = 0; n < 2; ++n) acc[a][b][m][n] = (f32x4){0.f, 0.f, 0.f, 0.f};
        cur = nxt; cA = nA; cB = nB; ++ui;
        if constexpr (GATHER) { _Pragma("unroll") for (int h_ = 0; h_ < 2; ++h_) _Pragma("unroll") for (int i_ = 0; i_ < 2; ++i_) curA[h_][i_] = nxtA[h_][i_]; }
        if constexpr (ALIGN_EPI) { if (wr == 1) PG8_BAR; }
    }
    PG8_WAIT_V(0);
    if constexpr (!ALIGN_EPI) { if (wr == 0) PG8_BAR; }
    PG8_BAR;
    if constexpr (Epi::AFTER_DRAIN) { E.fused(acc, cur, wr, wc, fr, fq, lds, wid, lane); S.done(cur); }
#undef PG8_SA
#undef PG8_SB
#undef PG8_STAGE
#undef PG8_STAGE_A
#undef PG8_GIDX
#undef PG8_LDA
#undef PG8_LDB
#undef PG8_MMA
#undef PG8_WAIT_V
#undef PG8_WAIT_L
#undef PG8_BAR
#undef PG8_SCHED
}
}
namespace att {
using bf16 = unsigned short;
using i32x8 = __attribute__((ext_vector_type(8))) int;
using i32x4 = __attribute__((ext_vector_type(4))) int;
using f32x16 = __attribute__((ext_vector_type(16))) float;
using u32x4  = __attribute__((ext_vector_type(4))) unsigned;
using f32x2 = __attribute__((ext_vector_type(2))) float;
using f32x4a = __attribute__((ext_vector_type(4))) float;
constexpr int NW = 8, QBLK = 32, KVBLK = 64;
constexpr float SCALE = 0.07216878364870322f;
constexpr float QSCALE = SCALE * 1.4426950408889634f;
constexpr float QFP8 = 4.f, KFP8 = 0.25f;
constexpr float CSH = 5.f;
constexpr float THR2 = 3.5f;
constexpr int LDQ = 768, LDO = 1024;
constexpr int SHM_V = 128 * 64, SHM_K = KVBLK * 128, SHM_KR = KVBLK * 64;
constexpr int STAGE = SHM_V + SHM_K + SHM_KR  , NSLOT = 6, SL_K = SHM_V, SL_KR = SHM_V + SHM_K;
constexpr int OFF_WS = NSLOT * STAGE, SHM_ATTN = OFF_WS + NW * 64 * 4;
#define SBAR() __builtin_amdgcn_sched_barrier(0)
__device__ __forceinline__ int crow(int r, int hi) { return (r & 3) + 8 * (r >> 2) + 4 * hi; }
__device__ __forceinline__ int pk4f8(float a, float b, float c, float d) { int w = __builtin_amdgcn_cvt_pk_fp8_f32(a, b, 0, false); return __builtin_amdgcn_cvt_pk_fp8_f32(c, d, w, true); }
__device__ __forceinline__ i32x8 mk8(i32x4 lo, i32x4 hi) { return (i32x8){lo[0], lo[1], lo[2], lo[3], hi[0], hi[1], hi[2], hi[3]}; }
#define MX_(A, B, C) __builtin_amdgcn_mfma_scale_f32_32x32x64_f8f6f4(A, B, C, 0, 0, 0, 0, 0, 0)
#define ONES8_ ((i32x8){0x38383838, 0x38383838, 0x38383838, 0x38383838, 0x38383838, 0x38383838, 0x38383838, 0x38383838})
#define MXS_(A, B, C) __builtin_amdgcn_mfma_scale_f32_16x16x128_f8f6f4(A, B, C, 0, 0, 0, 0, 0, 0)
#define LD8_(base, a0, a1, off) mk8(*reinterpret_cast<const i32x4*>((base) + (a0) + (off)), *reinterpret_cast<const i32x4*>((base) + (a1) + (off)))
#define SPLAT_(x) (f32x16){x, x, x, x, x, x, x, x, x, x, x, x, x, x, x, x}
__device__ __forceinline__ void qkt(f32x16& p0, f32x16& p1, const char* Ks, const char* KRs, const i32x8* qr, const int (&ka)[4], const int (&ra)[2], float ninit) {
  p0 = SPLAT_(ninit); p1 = p0;
  { const i32x8 b0 = LD8_(Ks, ka[0], ka[1], 0), b1 = LD8_(Ks, ka[0], ka[1], 4096); p0 = MX_(b0, qr[0], p0); p1 = MX_(b1, qr[0], p1); }
  { const i32x8 b0 = LD8_(Ks, ka[2], ka[3], 0), b1 = LD8_(Ks, ka[2], ka[3], 4096); p0 = MX_(b0, qr[1], p0); p1 = MX_(b1, qr[1], p1); }
  { const i32x8 b0 = LD8_(KRs, ra[0], ra[1], 0), b1 = LD8_(KRs, ra[0], ra[1], 2048); p0 = MX_(b0, qr[2], p0); p1 = MX_(b1, qr[2], p1); }
}
__device__ __forceinline__ void partialSM_first(f32x16& p0, f32x16& p1, float& m_reg, float& alpha) {
  float pmax = p0[0]; for (int r = 1; r < 16; ++r) pmax = fmaxf(pmax, p0[r]); for (int r = 0; r < 16; ++r) pmax = fmaxf(pmax, p1[r]);
  { auto rr = __builtin_amdgcn_permlane32_swap(__float_as_uint(pmax), __float_as_uint(pmax), false, false);
    pmax = fmaxf(__uint_as_float(rr[0]), __uint_as_float(rr[1])); }
  const float delta = (fabsf(pmax - CSH) <= THR2) ? 0.f : pmax - CSH; m_reg = delta; alpha = 1.f;
  if (__any(delta != 0.f)) { for (int r = 0; r < 16; ++r) p0[r] -= delta; for (int r = 0; r < 16; ++r) p1[r] -= delta; }
  for (int r = 0; r < 16; ++r) p0[r] = __builtin_amdgcn_exp2f(p0[r]);
}
#define PK8_(P, B) pk4f8(P[B], P[B + 1], P[B + 2], P[B + 3])
__device__ __forceinline__ void finishSM(f32x16& p0, f32x16& p1, i32x8& pa) {
  for (int r = 0; r < 16; ++r) p1[r] = __builtin_amdgcn_exp2f(p1[r]);
  pa = (i32x8){PK8_(p0, 0), PK8_(p0, 4), PK8_(p0, 8), PK8_(p0, 12), PK8_(p1, 0), PK8_(p1, 4), PK8_(p1, 8), PK8_(p1, 12)};
}
__device__ __forceinline__ void pv_d0(f32x16* o, const char* Vs, const int (&va)[2], i32x8 pa, f32x4a& lacc, i32x8 onesb) {
#pragma unroll
  for (int d = 0; d < 4; ++d) { const i32x8 v = LD8_(Vs, va[0], va[1], d * 2048); o[d] = MX_(pa, v, o[d]); }
  lacc = MXS_(pa, onesb, lacc);
}
#define EX_(i) p1[i] = __builtin_amdgcn_exp2f(p1[i])
#define P2_(P, B) (f32x2){P[B], P[B + 1]}
template <int ABL> __device__ __forceinline__ void qk_fin(f32x16& n0, f32x16& n1, const char* Ks, const char* KRs, const i32x8* qr, const int (&ka)[4], const int (&ra)[2], float ninit,
                                       f32x16& p0, f32x16& p1, i32x8& pa, i32x8& e0, i32x8& e1, i32x8& A, i32x8& B, const char* VsN, const int (&va)[2]) {
  i32x8 f0, f1;
  SBAR();
  f0 = LD8_(Ks, ka[2], ka[3], 0); f1 = LD8_(Ks, ka[2], ka[3], 4096);
  n0 = SPLAT_(ninit); n1 = n0;
  SBAR();
  n0 = MX_(e0, qr[0], n0); SBAR();
  if constexpr (!(ABL & 1)) { EX_(0); EX_(1); EX_(2); EX_(3); EX_(4); EX_(5); }
  SBAR();
  n1 = MX_(e1, qr[0], n1); SBAR();
  e0 = LD8_(KRs, ra[0], ra[1], 0); e1 = LD8_(KRs, ra[0], ra[1], 2048);
  if constexpr (!(ABL & 1)) { pa[0] = PK8_(p0, 0); pa[1] = PK8_(p0, 4); pa[2] = PK8_(p0, 8); asm volatile("" : "+v"(pa)); }
  SBAR();
  n0 = MX_(f0, qr[1], n0); SBAR();
  if constexpr (!(ABL & 1)) { EX_(6); EX_(7); EX_(8); EX_(9); EX_(10); EX_(11); pa[3] = PK8_(p0, 12); asm volatile("" : "+v"(pa)); }
  SBAR();
  n1 = MX_(f1, qr[1], n1); SBAR();
  if constexpr (!(ABL & 1)) { EX_(12); EX_(13); EX_(14); EX_(15); pa[4] = PK8_(p1, 0); pa[5] = PK8_(p1, 4); asm volatile("" : "+v"(pa)); }
  SBAR();
  n0 = MX_(e0, qr[2], n0); SBAR();
  if constexpr (!(ABL & 1)) { pa[6] = PK8_(p1, 8); pa[7] = PK8_(p1, 12); asm volatile("" : "+v"(pa)); }
  SBAR();
  n1 = MX_(e1, qr[2], n1); SBAR();
  A = LD8_(VsN, va[0], va[1], 0); B = LD8_(VsN, va[0], va[1], 2048);
  SBAR();
  if constexpr (ABL & 1) { asm volatile("" :: "v"(n0), "v"(n1)); }
}
template <int ABL> __device__ __forceinline__ void pv_par(f32x16* o, const char* Vs, const int (&va)[2], i32x8 pa, f32x16& n0, f32x16& n1, float& m_reg, float& alpha, i32x8& A, i32x8& B, i32x8& e0, i32x8& e1, const char* KsN, const int (&ka)[4], f32x4a& lacc, i32x8 onesb) {
  SBAR();
  o[0] = MX_(pa, A, o[0]); SBAR();
  A = LD8_(Vs, va[0], va[1], 4096);
  SBAR();
  o[1] = MX_(pa, B, o[1]); SBAR();
  B = LD8_(Vs, va[0], va[1], 6144);
  float pmax = n0[0];
  if constexpr (!(ABL & 1)) {
#pragma unroll
  for (int r = 1; r < 16; ++r) pmax = fmaxf(pmax, n0[r]);
  }
  SBAR();
  o[2] = MX_(pa, A, o[2]); SBAR();
  float delta = 0.f; bool adj = false; alpha = 1.f;
  if constexpr (!(ABL & 1)) {
#pragma unroll
  for (int r = 0; r < 16; ++r) pmax = fmaxf(pmax, n1[r]);
  { auto rr = __builtin_amdgcn_permlane32_swap(__float_as_uint(pmax), __float_as_uint(pmax), false, false); pmax = fmaxf(__uint_as_float(rr[0]), __uint_as_float(rr[1])); }
  if (__builtin_expect(!__all(pmax <= CSH + THR2), 0)) { delta = fmaxf(pmax - CSH, 0.f); alpha = __builtin_amdgcn_exp2f(-delta); m_reg += delta; adj = true; }
  }
  SBAR();
  o[3] = MX_(pa, B, o[3]); SBAR();
  lacc = MXS_(pa, onesb, lacc); SBAR();
  e0 = LD8_(KsN, ka[0], ka[1], 0); e1 = LD8_(KsN, ka[0], ka[1], 4096);
  if constexpr (!(ABL & 1)) { if (adj) {
#pragma unroll
  for (int r = 0; r < 16; ++r) n0[r] -= delta;
#pragma unroll
  for (int r = 0; r < 16; ++r) n1[r] -= delta;
  }
#pragma unroll
  for (int r = 0; r < 16; ++r) n0[r] = __builtin_amdgcn_exp2f(n0[r]);
  }
  SBAR();
}
__device__ __forceinline__ void glds16(const void* gsrc, unsigned lds_dst) { unsigned keep;
  asm volatile("s_mov_b32 %0, m0\n\ts_mov_b32 m0, %2\n\ts_nop 0\n\tglobal_load_lds_dwordx4 %1, off\n\ts_mov_b32 m0, %0" : "=&s"(keep) : "v"(gsrc), "s"(lds_dst) : "memory"); }
__device__ __forceinline__ void glds16s(const void* sbase, int voff, unsigned lds_dst) { unsigned keep;
  asm volatile("s_mov_b32 %0, m0\n\ts_mov_b32 m0, %3\n\ts_nop 0\n\tglobal_load_lds_dwordx4 %1, %2\n\ts_mov_b32 m0, %0" : "=&s"(keep) : "v"(voff), "s"(sbase), "s"(lds_dst) : "memory"); }
#define WAIT_BAR_ALL() asm volatile("s_waitcnt vmcnt(0) lgkmcnt(0)\n\ts_barrier" ::: "memory")
template <int SDEPTH, int ABL = 0>
__device__ __forceinline__ void attn_body(const unsigned char* Qb, const unsigned char* Kn, const unsigned char* Kr, const unsigned char* Vt, int vpitch, bf16* Ob, int seq, char* lds) {
  const int tid = otid(), wid = __builtin_amdgcn_readfirstlane(tid >> 6), lane = tid & 63, r32 = lane & 31, hi = lane >> 5;
  float* ws = (float*)(lds + OFF_WS) + wid * 64; float* li_l = ws; float* al_l = ws + 32;
  float m_reg = 0.f; f32x16 o[4] = {}; f32x4a lacc = {0.f, 0.f, 0.f, 0.f}; i32x8 qr[3];
  const int lrow0 = ((lane & 15) >= 8 ? 16 : 0) + 4 * (lane >> 4);
  i32x8 onesb; { const int ov = ((((lane >> 4) & 1) != 0) == ((lane & 15) >= 8)) ? 0x38383838 : 0; onesb = (i32x8){ov, ov, ov, ov, ov, ov, ov, ov}; }
  { const unsigned char* Qw = Qb + (long)(wid * QBLK + r32) * LDQ + hi * 32;
#pragma unroll
    for (int s = 0; s < 3; ++s) qr[s] = mk8(*reinterpret_cast<const i32x4*>(Qw + 64 * s), *reinterpret_cast<const i32x4*>(Qw + 64 * s + 16)); }
  int ka[4], ra[2], va[2];
#pragma unroll
  for (int q = 0; q < 4; ++q) ka[q] = r32 * 128 + (((4 * (q >> 1) + 2 * hi + (q & 1)) ^ ((r32 >> 1) & 7)) << 4);
#pragma unroll
  for (int q = 0; q < 2; ++q) { ra[q] = r32 * 64 + (((2 * hi + q) ^ ((r32 >> 2) & 3)) << 4); va[q] = ra[q]; }
  int okA, ovA, orA;
  { const int row = 8 * wid + (lane >> 3), c = (lane & 7) ^ ((row >> 1) & 7); okA = row * 128 + c * 16; }
  { const int row = 16 * wid + (lane >> 2), c = (lane & 3) ^ ((row >> 2) & 3); ovA = row * vpitch + c * 16; orA = row * 64 + c * 16; }
  const unsigned lds0 = (unsigned)(uintptr_t)lds;
#define DMA_TILE(k0, so) do { const unsigned d_ = (unsigned)__builtin_amdgcn_readfirstlane((int)(lds0 + (unsigned)(so) + (unsigned)wid * 1024u)); \
    glds16s(Kn + (long)(k0) * 128, okA, d_ + SL_K); glds16s(Vt + (k0), ovA, d_); if (wid < 4) glds16s(Kr + (long)(k0) * 64, orA, d_ + SL_KR); } while (0)
#define RESC(a) do { if (__any((a) < 1.f)) { if (hi == 0) al_l[r32] = (a); asm volatile("s_waitcnt lgkmcnt(0)" ::: "memory"); \
    for (int r = 0; r < 4; ++r) lacc[r] *= al_l[lrow0 + r]; for (int r = 0; r < 16; ++r) { const float a_ = al_l[crow(r, hi)]; for (int d = 0; d < 4; ++d) o[d][r] *= a_; } } } while (0)
  f32x16 pA0, pA1, pB0, pB1; float alA, alB; i32x8 pa; const int NT = seq / KVBLK;
#define SLOT(t) (((t) % 6) * STAGE)
  const bool grpB = wid >= 4;
  DMA_TILE(0, 0); DMA_TILE(KVBLK, STAGE); DMA_TILE(2 * KVBLK, 2 * STAGE); DMA_TILE(3 * KVBLK, 3 * STAGE);
  WAIT_BAR_ALL();
  if (4 < NT) DMA_TILE(4 * KVBLK, 4 * STAGE);
  qkt(pA0, pA1, lds + SL_K, lds + SL_KR, qr, ka, ra, CSH); partialSM_first(pA0, pA1, m_reg, alA);
#define BARDMA(tn) do { if constexpr (!(ABL & 2)) { if ((tn) - 1 < NT) { if (wid < 4) asm volatile("s_waitcnt vmcnt(3) lgkmcnt(0)\n\ts_barrier" ::: "memory"); else asm volatile("s_waitcnt vmcnt(2) lgkmcnt(0)\n\ts_barrier" ::: "memory"); } \
    else WAIT_BAR_ALL(); if ((tn) < NT) DMA_TILE((tn) * KVBLK, SLOT(tn)); } } while (0)
  i32x8 fe0, fe1, fA, fB;
  fe0 = LD8_(lds + SLOT(1) + SL_K, ka[0], ka[1], 0); fe1 = LD8_(lds + SLOT(1) + SL_K, ka[0], ka[1], 4096);
  for (int t = 0; t + 3 < NT; t += 2) {
    qk_fin<ABL>(pB0, pB1, lds + SLOT(t + 1) + SL_K, lds + SLOT(t + 1) + SL_KR, qr, ka, ra, CSH - m_reg, pA0, pA1, pa, fe0, fe1, fA, fB, lds + SLOT(t), va);
    if (grpB) BARDMA(t + 5);
    pv_par<ABL>(o, lds + SLOT(t), va, pa, pB0, pB1, m_reg, alB, fA, fB, fe0, fe1, lds + SLOT(t + 2) + SL_K, ka, lacc, onesb);
    RESC(alB); if (!grpB) BARDMA(t + 5);
    qk_fin<ABL>(pA0, pA1, lds + SLOT(t + 2) + SL_K, lds + SLOT(t + 2) + SL_KR, qr, ka, ra, CSH - m_reg, pB0, pB1, pa, fe0, fe1, fA, fB, lds + SLOT(t + 1), va);
    if (grpB) BARDMA(t + 6);
    pv_par<ABL>(o, lds + SLOT(t + 1), va, pa, pA0, pA1, m_reg, alA, fA, fB, fe0, fe1, lds + SLOT(t + 3) + SL_K, ka, lacc, onesb);
    RESC(alA); if (!grpB) BARDMA(t + 6);
  }
  qk_fin<ABL>(pB0, pB1, lds + SLOT(NT - 1) + SL_K, lds + SLOT(NT - 1) + SL_KR, qr, ka, ra, CSH - m_reg, pA0, pA1, pa, fe0, fe1, fA, fB, lds + SLOT(NT - 2), va);
  pv_par<ABL>(o, lds + SLOT(NT - 2), va, pa, pB0, pB1, m_reg, alB, fA, fB, fe0, fe1, lds + SLOT(NT - 1) + SL_K, ka, lacc, onesb);
  RESC(alB);
  finishSM(pB0, pB1, pa); SBAR();
  pv_d0(o, lds + SLOT(NT - 1), va, pa, lacc, onesb);
  if ((lane & 7) == 0) { for (int r = 0; r < 4; ++r) li_l[lrow0 + r] = lacc[r]; } asm volatile("s_waitcnt lgkmcnt(0)" ::: "memory");
  float rli[16];
#pragma unroll
  for (int r = 0; r < 16; ++r) rli[r] = __builtin_amdgcn_rcpf(li_l[crow(r, hi)]);
  bf16* Ow = Ob + (long)(wid * QBLK) * LDO;
#pragma unroll
  for (int r = 0; r < 16; ++r) { int orow = crow(r, hi);
#pragma unroll
    for (int d0 = 0; d0 < 4; ++d0) { const float v = o[d0][r] * rli[r]; unsigned u = __float_as_uint(v); u = (u + 0x7fffu + ((u >> 16) & 1u)) >> 16; Ow[(long)orow * LDO + d0 * 32 + r32] = (bf16)u; } }
  asm volatile("s_waitcnt lgkmcnt(0)\n\ts_barrier" ::: "memory");
#undef DMA_TILE
#undef RESC
#undef SLOT
#undef BARDMA
}
#undef SBAR
}
#define LAS __attribute__((address_space(3)))
typedef unsigned short bf16_t;
typedef float v4f __attribute__((ext_vector_type(4)));
typedef float v2f __attribute__((ext_vector_type(2)));
typedef unsigned v4u __attribute__((ext_vector_type(4)));
typedef unsigned v2u __attribute__((ext_vector_type(2)));
typedef short s8v __attribute__((ext_vector_type(8)));
typedef float f16v __attribute__((ext_vector_type(16)));

constexpr int DM = 1024, SEQ = 16384, NCTX = 256, NR = SEQ + NCTX  , NCHUNK = NR / 128  ;
constexpr int INC = 1728, INP = 1792, QLR = 384, KVLR = 256, NHEAD = 4, NEXP = 16, FFD = 1024, CAP = 2048, CAPC = 32;
constexpr float EPSN = 1e-6f;
constexpr size_t MiB = 1u << 20;
constexpr size_t WS_CTL = 0, WS_MOD = 1 * MiB, WS_ROPE = WS_MOD + 128 * 1024, WS_SGUW = WS_MOD + 256 * 1024, WS_LRUW = WS_MOD + 512 * 1024, WS_WRH = WS_MOD + 768 * 1024, WS_WRL = WS_MOD + 832 * 1024;
constexpr size_t WS_CHS = 2 * MiB, WS_PROBT = 3 * MiB, WS_IDX = 5 * MiB, WS_IDXC = WS_IDX + 128 * 1024, WS_GATE = WS_IDX + 256 * 1024, WS_GATEC = WS_GATE + 128 * 1024, WS_INV = 6 * MiB;
constexpr size_t WS_WIN = 8 * MiB, WS_WUQ = 12 * MiB, WS_WUKV = 13 * MiB, WS_WOUT = 14 * MiB, WS_WGU = 16 * MiB, WS_WD = 80 * MiB;
constexpr size_t WS_XL = 112 * MiB, WS_H = 177 * MiB, WS_A = 210 * MiB;
constexpr size_t WS_PROJ = WS_A, WS_CQN = 267 * MiB, WS_CKVN = 280 * MiB, WS_Q = 289 * MiB, WS_KN = 314 * MiB, WS_V = 331 * MiB, WS_KR = 348 * MiB, WS_MIX = 351 * MiB, WS_HL = 384 * MiB, WS_ACUM = 417 * MiB;
constexpr size_t WS_XS = WS_A, WS_HID = 282 * MiB, WS_YE = 354 * MiB, WS_END = 450 * MiB;
static_assert(WS_PROJ + (size_t)NR * INP * 2 <= WS_CQN && WS_CQN + (size_t)NR * QLR * 2 <= WS_CKVN && WS_CKVN + (size_t)NR * KVLR * 2 <= WS_Q && WS_Q + (size_t)NR * 768 * 2 <= WS_KN, "ws map 1");
static_assert(WS_KN + (size_t)4 * NR * 128 * 2 <= WS_V && WS_V + (size_t)4 * NR * 128 * 2 <= WS_KR && WS_KR + (size_t)NR * 64 * 2 <= WS_MIX && WS_MIX + (size_t)NR * 1024 * 2 <= WS_HL, "ws map 2");
static_assert(WS_HL + (size_t)2 * NR * 256 * 4 <= WS_ACUM && WS_ACUM + (size_t)2 * NR * 256 * 4 <= WS_END, "ws map 3");
static_assert(WS_XS + (size_t)(128 + 16) * 256 * 1024 * 2 <= WS_HID && WS_HID + (size_t)144 * 256 * 1024 * 2 <= WS_YE && WS_YE + (size_t)144 * 256 * 1024 * 2 <= WS_END, "ws map 4");
static_assert(WS_XL + (size_t)NR * 1024 * 4 <= WS_H && WS_H + (size_t)NR * 1024 * 2 <= WS_A && WS_WGU + (size_t)16 * 2048 * 1024 * 2 <= WS_WD && WS_WD + (size_t)16 * 1024 * 1024 * 2 <= WS_XL, "ws map 5");
constexpr int LDS_BYTES = 163840;

struct Params {
    const float *x, *c, *ctx, *c_ctx, *norm1_g, *w_mod, *b_mod, *w_in, *sgu_w, *sgu_b, *conv_w, *conv_b, *lru_wa, *lru_ba, *lru_wx, *lru_bx, *lru_lambda,
                *q_norm_g, *w_uq, *kv_norm_g, *w_ukv, *w_out, *norm2_g, *w_router, *w_gate, *w_up, *w_down, *final_norm_g;
    float* out; unsigned char* ws;
};

__device__ __forceinline__ float bf2f(bf16_t v) { return __uint_as_float((unsigned)v << 16); }
__device__ __forceinline__ unsigned f2bf(float f) { unsigned u = __float_as_uint(f); return (u + 0x7fffu + ((u >> 16) & 1u)) >> 16; }
__device__ __forceinline__ unsigned pk2(float lo, float hi) { return f2bf(lo) | (f2bf(hi) << 16); }
__device__ __forceinline__ float wave_sum(float v) {
#pragma unroll
    for (int o = 1; o < 64; o <<= 1) v += __shfl_xor(v, o);
    return v;
}
__device__ __forceinline__ float gelu_tanh(float x) { const float u = 0.7978845608028654f * (x + 0.044715f * x * x * x); const float e = __expf(2.f * u); return x * (1.f - __builtin_amdgcn_rcpf(e + 1.f)); }
__device__ __forceinline__ float sigmoid_f(float x) { return __builtin_amdgcn_rcpf(1.f + __expf(-x)); }
__device__ __forceinline__ void lds_barrier() { asm volatile("s_waitcnt lgkmcnt(0)\n\ts_barrier" ::: "memory"); }
__device__ __forceinline__ int crow16(int r, int hi) { return (r & 3) + 8 * (r >> 2) + 4 * hi; }

__device__ __forceinline__ void sincos_d(double x, double& s, double& c) {
    const double kd = rint(x * 0.6366197723675814); const int k = (int)kd;
    double y = fma(-kd, 1.5707963267948966, x); y = fma(-kd, 6.123233995736766e-17, y);
    const double y2 = y * y;
    const double sp = y * (1.0 + y2 * (-1.0 / 6 + y2 * (1.0 / 120 + y2 * (-1.0 / 5040 + y2 * (1.0 / 362880 + y2 * (-1.0 / 39916800 + y2 * (1.0 / 6227020800.0)))))));
    const double cp = 1.0 + y2 * (-0.5 + y2 * (1.0 / 24 + y2 * (-1.0 / 720 + y2 * (1.0 / 40320 + y2 * (-1.0 / 3628800 + y2 * (1.0 / 479001600.0 + y2 * (-1.0 / 87178291200.0)))))));
    const int q = k & 3;
    s = (q == 0) ? sp : (q == 1) ? cp : (q == 2) ? -sp : -cp;
    c = (q == 0) ? cp : (q == 1) ? -sp : (q == 2) ? -cp : sp;
}

__device__ __forceinline__ void tr_item(const float* W, int K, int N, bf16_t* WT, int k0, int n0, long drow0, LAS float* scr, int lane) {
#pragma unroll 8
    for (int i = 0; i < 32; ++i) { const int kk = 2 * i + (lane >> 5); scr[kk * 33 + (lane & 31)] = W[(size_t)(k0 + kk) * N + n0 + (lane & 31)]; }
    asm volatile("s_waitcnt lgkmcnt(0)" ::: "memory");
    const int c = lane & 7;
#pragma unroll
    for (int j = 0; j < 4; ++j) { const int n = (lane >> 3) + 8 * j; const LAS float* s = scr + (8 * c) * 33 + n;
        v4u o; o.x = pk2(s[0 * 33], s[1 * 33]); o.y = pk2(s[2 * 33], s[3 * 33]); o.z = pk2(s[4 * 33], s[5 * 33]); o.w = pk2(s[6 * 33], s[7 * 33]);
        *(v4u*)(WT + (size_t)(drow0 + n) * K + k0 + 8 * c) = o; }
    asm volatile("s_waitcnt lgkmcnt(0)" ::: "memory");
}
struct CvtItem { const float* W; bf16_t* WT; int K, N, k0, n0; long drow0, drow_mul; int kvs; };
__device__ __forceinline__ bool cvt_item(const Params& P, int l, int it, CvtItem& c) {
    unsigned char* ws = P.ws;
    constexpr int I_IN = 8 * 7, I_UQ = 3 * 3, I_UKV = 2 * 4, I_OUT = 8 * 4, I_E = 16 * 32;
    c.drow0 = 0; c.drow_mul = 128; c.kvs = 0;
    if (it < I_IN) { c.W = P.w_in + (size_t)l * 1024 * INC; c.WT = (bf16_t*)(ws + WS_WIN); c.K = 1024; c.N = INC; c.k0 = (it / 7) * 128; c.n0 = (it % 7) * 256; return true; } it -= I_IN;
    if (it < I_UQ) { c.W = P.w_uq + (size_t)l * QLR * 768; c.WT = (bf16_t*)(ws + WS_WUQ); c.K = QLR; c.N = 768; c.k0 = (it / 3) * 128; c.n0 = (it % 3) * 256; return true; } it -= I_UQ;
    if (it < I_UKV) { c.W = P.w_ukv + (size_t)l * KVLR * 1024; c.WT = (bf16_t*)(ws + WS_WUKV); c.K = KVLR; c.N = 1024; c.k0 = (it / 4) * 128; c.n0 = (it % 4) * 256; c.kvs = 1; return true; } it -= I_UKV;
    if (it < I_OUT) { c.W = P.w_out + (size_t)l * 1024 * 1024; c.WT = (bf16_t*)(ws + WS_WOUT); c.K = 1024; c.N = 1024; c.k0 = (it / 4) * 128; c.n0 = (it % 4) * 256; return true; } it -= I_OUT;
    if (it >= 3 * I_E) return false;
    const int mat = it / I_E, q = it % I_E, e = q / 32, w = q % 32; const size_t eoff = ((size_t)l * 16 + e) * 1024 * 1024;
    c.K = 1024; c.N = 1024; c.k0 = (w / 4) * 128; c.n0 = (w % 4) * 256;
    if (mat == 0)      { c.W = P.w_gate + eoff; c.WT = (bf16_t*)(ws + WS_WGU); c.drow0 = (long)e * 2048; c.drow_mul = 256; }
    else if (mat == 1) { c.W = P.w_up + eoff;   c.WT = (bf16_t*)(ws + WS_WGU); c.drow0 = (long)e * 2048 + 128; c.drow_mul = 256; }
    else               { c.W = P.w_down + eoff; c.WT = (bf16_t*)(ws + WS_WD);  c.drow0 = (long)e * 1024; }
    return true;
}
constexpr int CVT_NONEXP = 8 * 7 + 3 * 3 + 2 * 4 + 8 * 4, CVT_ALL = CVT_NONEXP + 3 * 16 * 32;
__device__ __forceinline__ void convert_weights(const Params& P, LAS unsigned char* lds, int l, int vcu, int G, int it0, int it1, bool SMALL) {
    const int tid = otid(), lane = tid & 63, wave = __builtin_amdgcn_readfirstlane(tid >> 6);
    LAS unsigned* img = (LAS unsigned*)lds;
    CvtItem c; int it = it0 + vcu; bool have = it < it1 && cvt_item(P, l, it, c);
    v4f v[16];
#define CVT_LOAD() do { const bool ok_ = c.n0 + 4 * lane < c.N; const float* src_ = c.W + (size_t)(c.k0 + wave * 16) * c.N + c.n0 + 4 * lane; \
    _Pragma("unroll") for (int i_ = 0; i_ < 16; ++i_) v[i_] = ok_ ? __builtin_nontemporal_load((const v4f*)(src_ + (size_t)i_ * c.N)) : (v4f){0.f, 0.f, 0.f, 0.f}; } while (0)
    if (have) CVT_LOAD();
    while (have) {
#pragma unroll
        for (int i = 0; i < 8; ++i)
#pragma unroll
            for (int j = 0; j < 4; ++j) img[(4 * lane + j) * 65 + wave * 8 + i] = pk2(v[2 * i][j], v[2 * i + 1][j]);
        __syncthreads();
        const CvtItem cur = c; it += G; have = it < it1 && cvt_item(P, l, it, c);
        if (have) CVT_LOAD();
#pragma unroll
        for (int rr = 0; rr < 8; ++rr) { const int n = (wave * 8 + rr) * 4 + (lane >> 4), ch = lane & 15;
            const LAS unsigned* s = img + n * 65 + 4 * ch; v4u o; o.x = s[0]; o.y = s[1]; o.z = s[2]; o.w = s[3];
            if (cur.n0 + n < cur.N) { const int ng = cur.n0 + n; const long dr = cur.kvs ? (long)(((ng >> 7) & 1) * 512 + (ng >> 8) * 128 + (ng & 127)) : cur.drow0 + (ng >> 7) * cur.drow_mul + (ng & 127);
                *(v4u*)(cur.WT + (size_t)dr * cur.K + cur.k0 + 8 * ch) = o; } }
        __syncthreads();
    }
#undef CVT_LOAD
    if (!SMALL) return;
    unsigned char* ws = P.ws; LAS float* scr = (LAS float*)(lds + wave * 16384);
    for (int it3 = vcu * 8 + wave; it3 < 64; it3 += G * 8) {
        const int e = it3 >> 1, k0 = (it3 & 1) * 512; bf16_t* wh = (bf16_t*)(ws + WS_WRH) + (size_t)e * 1024 + k0; bf16_t* wl = (bf16_t*)(ws + WS_WRL) + (size_t)e * 1024 + k0;
#pragma unroll
        for (int i = 0; i < 8; ++i) { const int k = 64 * i + lane; float w = 0.f; if (e < 16) w = P.w_router[((size_t)l * 1024 + k0 + k) * 16 + e];
            const unsigned h = f2bf(w); wh[k] = (bf16_t)h; wl[k] = (bf16_t)f2bf(w - __uint_as_float(h << 16)); } }
    for (int it2 = vcu * 8 + wave; it2 < 64 + 64 + 32; it2 += G * 8) {
        if (it2 < 64) { v4u z = {0u, 0u, 0u, 0u}; bf16_t* p = (bf16_t*)(ws + WS_WIN) + (size_t)(INC + it2) * 1024; *(v4u*)(p + lane * 8) = z; *(v4u*)(p + 512 + lane * 8) = z; }
        else if (it2 < 128) { const int pc = it2 - 64; const float* s = P.sgu_w + (size_t)l * 65536 + pc * 1024; bf16_t* d = (bf16_t*)(ws + WS_SGUW) + pc * 1024;
#pragma unroll
            for (int j = 0; j < 4; ++j) { const v4f x = *(const v4f*)(s + 256 * j + 4 * lane); v2u o; o.x = pk2(x[0], x[1]); o.y = pk2(x[2], x[3]); *(v2u*)(d + 256 * j + 4 * lane) = o; } }
        else { const int q = it2 - 128, mi = q >> 1, half = q & 1, d = mi >> 3, m = (mi >> 2) & 1, nb = mi & 3;
            const float* W = (m ? P.lru_wx : P.lru_wa) + (((size_t)l * 2 + d) * 4 + nb) * 4096;
            tr_item(W, 64, 64, (bf16_t*)(ws + WS_LRUW), 0, half * 32, (long)mi * 64 + half * 32, scr, lane); }
    }
}
#define GAS __attribute__((address_space(1)))
typedef GAS unsigned gu32;
#define XB_TMO      128
#define XB_XCNT(j)  (256  + 64 * (j))
#define XB_XSUB(j)  (1280 + 64 * (j))
#define XB_XGEN(j)  (2304 + 64 * (j))
#define XB_TOP      3328
#define XB_TOPGEN   3392
#define XCD_BAR_WORDS 3456
#define XB_SPIN_CAP (1u << 18)

__device__ __forceinline__ unsigned xb_ld(unsigned* p)              { return __hip_atomic_load(p, __ATOMIC_RELAXED, __HIP_MEMORY_SCOPE_AGENT); }
__device__ __forceinline__ unsigned xb_add(unsigned* p, unsigned v) { return __hip_atomic_fetch_add(p, v, __ATOMIC_RELAXED, __HIP_MEMORY_SCOPE_AGENT); }
__device__ __forceinline__ unsigned xb_xcc_id() { return (unsigned)__builtin_amdgcn_s_getreg((3 << 11) | 20) & 0xFu; }
#define XB_SPIN(cond, bar) do { unsigned _sp = 0; while (cond) { __builtin_amdgcn_s_sleep(1); \
    if ((++_sp & 255u) == 0u) { if (xb_ld(&(bar)[XB_TMO])) break; if (_sp > XB_SPIN_CAP) { atomicAdd(&(bar)[XB_TMO], 1u); break; } } } } while (0)

struct XcdBarrier {
    unsigned* bar; unsigned x;
    volatile LAS unsigned* st;
};

__device__ __forceinline__ XcdBarrier xcd_barrier_post(unsigned* bar, volatile LAS unsigned* st) {
    XcdBarrier b; b.bar = bar; b.x = xb_xcc_id(); b.st = st;
    if (otid() == 0) (void)xb_add(&bar[XB_XCNT(b.x)], 1u);
    return b;
}
__device__ __forceinline__ void xcd_barrier_complete(unsigned* bar, unsigned x, unsigned& nloc, unsigned& nx) {
    const unsigned G = gridDim.x * gridDim.y * gridDim.z;
    unsigned sum, cnt, mine, sp = 0u;
    for (;;) {
        sum = 0u; cnt = 0u; mine = 0u;
#pragma unroll
        for (unsigned j = 0; j < 16; ++j) { const unsigned c = xb_ld(&bar[XB_XCNT(j)]); sum += c; cnt += (c > 0u) ? 1u : 0u; mine = (j == x) ? c : mine; }
        if (sum == G) break;
        __builtin_amdgcn_s_sleep(1);
        if ((++sp & 255u) == 0u) { if (xb_ld(&bar[XB_TMO])) break; if (sp > XB_SPIN_CAP) { atomicAdd(&bar[XB_TMO], 1u); break; } }
    }
    nloc = mine > 0u ? mine : 1u; nx = cnt > 0u ? cnt : 1u;
}

__device__ __forceinline__ void xcd_barrier(const XcdBarrier& b) {
    asm volatile("s_waitcnt vmcnt(0)" ::: "memory");
    __syncthreads();
    if (otid() == 0) {
        unsigned* bar = b.bar;
        __builtin_amdgcn_s_waitcnt(0);
        unsigned nloc = b.st[0], nx = b.st[1];
        if (nloc == 0u) { xcd_barrier_complete(bar, b.x, nloc, nx); b.st[0] = nloc; b.st[1] = nx; }
        const unsigned old = xb_add(&bar[XB_XSUB(b.x)], 1u);
        const unsigned gen = old / nloc;
        if (old + 1u == (gen + 1u) * nloc) {
            __builtin_amdgcn_fence(__ATOMIC_RELEASE, "agent");
            asm volatile("s_waitcnt vmcnt(0)" ::: "memory");
            const unsigned og = xb_add(&bar[XB_TOP], 1u);
            const unsigned tg = og / nx;
            if (og + 1u == (tg + 1u) * nx) xb_add(&bar[XB_TOPGEN], 1u);
            else XB_SPIN(xb_ld(&bar[XB_TOPGEN]) == tg, bar);
            __builtin_amdgcn_fence(__ATOMIC_ACQUIRE, "agent");
            xb_add(&bar[XB_XGEN(b.x)], 1u);
            asm volatile("s_waitcnt vmcnt(0)" ::: "memory");
        } else {
            XB_SPIN(xb_ld(&bar[XB_XGEN(b.x)]) == gen, bar);
            __builtin_amdgcn_fence(__ATOMIC_ACQUIRE, "agent");
            asm volatile("s_waitcnt vmcnt(0)" ::: "memory");
        }
    }
    __syncthreads();
}
__device__ __forceinline__ void row_norm_mod_bf16(const float* xrow, const float* g, const float* sh, const float* sc, bf16_t* orow, int lane) {
    v4f v[4]; float ss = 0.f;
#pragma unroll
    for (int j = 0; j < 4; ++j) { v[j] = *(const v4f*)(xrow + 256 * j + 4 * lane); ss += (v[j][0] * v[j][0] + v[j][1] * v[j][1]) + (v[j][2] * v[j][2] + v[j][3] * v[j][3]); }
    const float rstd = 1.0f / sqrtf(wave_sum(ss) * (1.0f / 1024.0f) + EPSN);
#pragma unroll
    for (int j = 0; j < 4; ++j) { const int c = 256 * j + 4 * lane; const v4f gv = *(const v4f*)(g + c), shv = *(const v4f*)(sh + c), scv = *(const v4f*)(sc + c);
        const v4f y = ((v[j] * rstd) * gv) * (1.0f + scv) + shv; v2u o; o.x = pk2(y[0], y[1]); o.y = pk2(y[2], y[3]); *(v2u*)(orow + c) = o; }
}

__device__ __forceinline__ void mod_gemv_item(const Params& P, LAS unsigned char* lds, int l, int cg) {
    const int tid = otid(), lane = tid & 63, wave = tid >> 6;
    float* MOD = (float*)(P.ws + WS_MOD);
    LAS float* sv = (LAS float*)(lds + 131072); LAS float* red = (LAS float*)(lds + 131072 + 8192);
    __syncthreads();
    for (int i = tid; i < 1024; i += 512) { const float a = P.c[i], b = P.c_ctx[i]; sv[i] = a / (1.f + expf(-a)); sv[1024 + i] = b / (1.f + expf(-b)); }
    __syncthreads();
    const float* W = P.w_mod + (size_t)l * 1024 * 6144 + cg * 64 + lane;
    float al = 0.f, ac = 0.f; const int k0 = wave * 128;
    for (int kb = 0; kb < 128; kb += 32) { float wv[32];
#pragma unroll
        for (int k = 0; k < 32; ++k) wv[k] = __builtin_nontemporal_load(W + (size_t)(k0 + kb + k) * 6144);
#pragma unroll
        for (int k = 0; k < 32; ++k) { al += sv[k0 + kb + k] * wv[k]; ac += sv[1024 + k0 + kb + k] * wv[k]; } }
    red[(wave * 2 + 0) * 64 + lane] = al; red[(wave * 2 + 1) * 64 + lane] = ac;
    __syncthreads();
    if (wave < 2) { float s = 0.f;
#pragma unroll
        for (int w8 = 0; w8 < 8; ++w8) s += red[(w8 * 2 + wave) * 64 + lane];
        const int col = cg * 64 + lane; MOD[(l * 2 + wave) * 6144 + col] = s + P.b_mod[l * 6144 + col]; }
    __syncthreads();
}
__device__ __forceinline__ void phase0(const Params& P, LAS unsigned char* lds, int vcu, int G) {
    const int tid = otid();
    const bool split = (G >= 96 + CVT_NONEXP);
    for (int it = vcu; it < (split ? 96 : 192); it += G) mod_gemv_item(P, lds, it / 96, it % 96);
    if (vcu == G - 1) {
        float* cosT = (float*)(P.ws + WS_ROPE); float* sinT = cosT + 4096;
        for (int i = tid; i < 4096; i += 512) { const int p = i >> 4, f = i & 15; const float inv = exp2f(-(float)f * (13.287712379549449f / 16.0f)); const float ang = (float)p * inv;
            double s, c; sincos_d((double)ang, s, c); cosT[i] = (float)c; sinT[i] = (float)s; }
    }
    convert_weights(P, lds, 0, split ? G - 1 - vcu : vcu, G, 0, CVT_NONEXP, true);
}
__device__ __forceinline__ void phase_norm1_l0(const Params& P, int gw, int NGW) {
    const int lane = otid() & 63; const float* MOD = (const float*)(P.ws + WS_MOD); bf16_t* H = (bf16_t*)(P.ws + WS_H);
    for (int r0 = gw; r0 < NR; r0 += 2 * NGW) {
        v4f v[2][4]; float ss[2];
#pragma unroll
        for (int u = 0; u < 2; ++u) { const int r = (r0 + u * NGW < NR) ? r0 + u * NGW : r0; const float* src = r < NCTX ? P.ctx + (size_t)r * 1024 : P.x + (size_t)(r - NCTX) * 1024; ss[u] = 0.f;
#pragma unroll
            for (int j = 0; j < 4; ++j) { v[u][j] = *(const v4f*)(src + 256 * j + 4 * lane); ss[u] += (v[u][j][0] * v[u][j][0] + v[u][j][1] * v[u][j][1]) + (v[u][j][2] * v[u][j][2] + v[u][j][3] * v[u][j][3]); } }
#pragma unroll
        for (int u = 0; u < 2; ++u) { const int r = r0 + u * NGW; if (r < NR) { const float* md = MOD + (r < NCTX ? 1 : 0) * 6144; const float rstd = 1.0f / sqrtf(wave_sum(ss[u]) * (1.0f / 1024.0f) + EPSN);
            v4f gv[4], shv[4], scv[4];
#pragma unroll
            for (int j = 0; j < 4; ++j) { const int c = 256 * j + 4 * lane; gv[j] = *(const v4f*)(P.norm1_g + c); shv[j] = *(const v4f*)(md + c); scv[j] = *(const v4f*)(md + 1024 + c); }
#pragma unroll
            for (int j = 0; j < 4; ++j) { const int c = 256 * j + 4 * lane;
                const v4f y = ((v[u][j] * rstd) * gv[j]) * (1.0f + scv[j]) + shv[j]; v2u o; o.x = pk2(y[0], y[1]); o.y = pk2(y[2], y[3]); *(v2u*)(H + (size_t)r * 1024 + c) = o; } } }
    }
}
__device__ __forceinline__ void phase3_rows(const Params& P, int l, int gw, int NGW) {
    const int lane = otid() & 63; const bf16_t* PROJ = (const bf16_t*)(P.ws + WS_PROJ);
    bf16_t* CQN = (bf16_t*)(P.ws + WS_CQN); bf16_t* CKVN = (bf16_t*)(P.ws + WS_CKVN); unsigned char* KR = P.ws + WS_KR;
    const float* cosT = (const float*)(P.ws + WS_ROPE); const float* sinT = cosT + 4096;
    const float* qg = P.q_norm_g + l * QLR; const float* kg = P.kv_norm_g + l * KVLR;
    for (int r0 = gw; r0 < NR; r0 += 2 * NGW) {
        float q[2][6], kv[2][4], kr[2];
#pragma unroll
        for (int u = 0; u < 2; ++u) { const int r = (r0 + u * NGW < NR) ? r0 + u * NGW : r0; const bf16_t* pr = PROJ + (size_t)r * INP;
#pragma unroll
            for (int j = 0; j < 6; ++j) q[u][j] = bf2f(pr[1024 + 64 * j + lane]);
#pragma unroll
            for (int j = 0; j < 4; ++j) kv[u][j] = bf2f(pr[1408 + 64 * j + lane]);
            kr[u] = bf2f(pr[1664 + lane]); }
#pragma unroll
        for (int u = 0; u < 2; ++u) { const int r = r0 + u * NGW; if (r < NR) { float sq = 0.f, sk = 0.f;
#pragma unroll
            for (int j = 0; j < 6; ++j) sq += q[u][j] * q[u][j];
#pragma unroll
            for (int j = 0; j < 4; ++j) sk += kv[u][j] * kv[u][j];
            const float rq = 1.0f / sqrtf(wave_sum(sq) * (1.0f / QLR) + EPSN), rk = 1.0f / sqrtf(wave_sum(sk) * (1.0f / KVLR) + EPSN);
#pragma unroll
            for (int j = 0; j < 6; ++j) CQN[(size_t)r * QLR + 64 * j + lane] = (bf16_t)f2bf(q[u][j] * rq * qg[64 * j + lane]);
#pragma unroll
            for (int j = 0; j < 4; ++j) CKVN[(size_t)r * KVLR + 64 * j + lane] = (bf16_t)f2bf(kv[u][j] * rk * kg[64 * j + lane]);
            float ko = kr[u]; const float other = __shfl_xor(kr[u], 16);
            if (r >= NCTX) { const int t = r - NCTX, a = lane >> 5, f = lane & 15, pos = a ? (t & 63) : (t >> 6); const float cs = cosT[pos * 16 + f], sn = sinT[pos * 16 + f];
                ko = (lane & 16) ? (kr[u] * cs + other * sn) : (kr[u] * cs - other * sn); }
            { const int dd = lane & 31, pos = (lane & 32) + 8 * ((dd & 15) >> 2) + 4 * (dd >> 4) + (dd & 3); const float kq = __builtin_amdgcn_fmed3f(ko * att::KFP8, -448.f, 448.f);
              KR[(size_t)r * 64 + pos] = (unsigned char)(__builtin_amdgcn_cvt_pk_fp8_f32(kq, kq, 0, false) & 0xff); } } }
    }
}
__device__ __forceinline__ void sgu_item(const Params& P, int l, int n, LAS unsigned char* lds) {
    const int tid = otid(), lane = tid & 63, wave = __builtin_amdgcn_readfirstlane(tid >> 6), r32 = lane & 31, hi = lane >> 5; const int row0 = 128 * n;
    const bf16_t* PROJ = (const bf16_t*)(P.ws + WS_PROJ); bf16_t* MIX = (bf16_t*)(P.ws + WS_MIX); const bf16_t* SW = (const bf16_t*)(P.ws + WS_SGUW);
    constexpr int UP = 528;
    LAS unsigned char* VT = lds; LAS unsigned char* UT = lds + 65536;
    const int g = wave >> 1, cbase = 64 * g + 32 * (wave & 1), cB = cbase + r32;
    {
        const int t = tid >> 2, qd = tid & 3; const bf16_t* pr = PROJ + (size_t)(row0 + t) * INP + 64 * qd;
        s8v ru[8], rv[8];
#pragma unroll
        for (int j = 0; j < 8; ++j) { ru[j] = *(const s8v*)(pr + 8 * j); rv[j] = *(const s8v*)(pr + 256 + 8 * j); }
        float v[64]; float ss = 0.f;
#pragma unroll
        for (int j = 0; j < 8; ++j) {
#pragma unroll
            for (int i = 0; i < 8; ++i) { const float gv = gelu_tanh(bf2f((bf16_t)rv[j][i])); v[8 * j + i] = gv; ss += gv * gv; } }
#pragma unroll
        for (int j = 0; j < 8; ++j) { v4u o;
            o.x = pk2(gelu_tanh(bf2f((bf16_t)ru[j][0])), gelu_tanh(bf2f((bf16_t)ru[j][1]))); o.y = pk2(gelu_tanh(bf2f((bf16_t)ru[j][2])), gelu_tanh(bf2f((bf16_t)ru[j][3])));
            o.z = pk2(gelu_tanh(bf2f((bf16_t)ru[j][4])), gelu_tanh(bf2f((bf16_t)ru[j][5]))); o.w = pk2(gelu_tanh(bf2f((bf16_t)ru[j][6])), gelu_tanh(bf2f((bf16_t)ru[j][7])));
            *(LAS v4u*)(UT + t * UP + (64 * qd + 8 * j) * 2) = o; }
        ss += __shfl_xor(ss, 1); ss += __shfl_xor(ss, 2);
        const float rstd = 1.0f / sqrtf(ss * (1.0f / 256.0f) + EPSN);
#pragma unroll
        for (int i = 0; i < 64; ++i) { const int c = 64 * qd + i; *(LAS bf16_t*)(VT + c * 256 + ((((t >> 3) ^ (c & 15)) << 4) | ((t & 7) << 1))) = (bf16_t)f2bf(v[i] * rstd); }
    }
    const bf16_t* swp = SW + ((size_t)g * 128 + r32) * 128 + 8 * hi;
    s8v aw[4][8];
#pragma unroll
    for (int pt = 0; pt < 4; ++pt)
#pragma unroll
        for (int ks = 0; ks < 8; ++ks) aw[pt][ks] = *(const s8v*)(swp + (size_t)(32 * pt) * 128 + 16 * ks);
    lds_barrier();
    s8v bf[8];
#pragma unroll
    for (int ks = 0; ks < 8; ++ks) bf[ks] = *(const LAS s8v*)(VT + cB * 256 + (((2 * ks + hi) ^ (cB & 15)) << 4));
    f16v acc[4];
#pragma unroll
    for (int pt = 0; pt < 4; ++pt) { acc[pt] = (f16v){0.f, 0.f, 0.f, 0.f, 0.f, 0.f, 0.f, 0.f, 0.f, 0.f, 0.f, 0.f, 0.f, 0.f, 0.f, 0.f};
#pragma unroll
        for (int ks = 0; ks < 8; ++ks) acc[pt] = __builtin_amdgcn_mfma_f32_32x32x16_bf16(bf[ks], aw[pt][ks], acc[pt], 0, 0, 0); }
    const float* bs = P.sgu_b + ((size_t)l * 4 + g) * 128;
    float bsv[4];
#pragma unroll
    for (int pt = 0; pt < 4; ++pt) bsv[pt] = bs[32 * pt + r32];
#pragma unroll
    for (int pt = 0; pt < 4; ++pt) { const int p = 32 * pt + r32;
#pragma unroll
        for (int gq = 0; gq < 4; ++gq) { LAS v2u* up = (LAS v2u*)(UT + p * UP + (cbase + 8 * gq + 4 * hi) * 2); const v2u uw = *up;
            const float o0 = __uint_as_float(uw.x << 16) * (acc[pt][4 * gq + 0] + bsv[pt]), o1 = __uint_as_float(uw.x & 0xffff0000u) * (acc[pt][4 * gq + 1] + bsv[pt]);
            const float o2 = __uint_as_float(uw.y << 16) * (acc[pt][4 * gq + 2] + bsv[pt]), o3 = __uint_as_float(uw.y & 0xffff0000u) * (acc[pt][4 * gq + 3] + bsv[pt]);
            v2u ow; ow.x = pk2(o0, o1); ow.y = pk2(o2, o3); *up = ow; } }
    lds_barrier();
#pragma unroll
    for (int j = 0; j < 8; ++j) { const int idx = tid + 512 * j, p = idx >> 5, c8 = idx & 31;
        const v4u o = *(const LAS v4u*)(UT + p * UP + c8 * 16); *(v4u*)(MIX + (size_t)(row0 + p) * 1024 + 8 * c8) = o; }
    lds_barrier();
}
__device__ __forceinline__ void lru_item(const Params& P, int l, int n, int nb, LAS unsigned char* lds) {
    const int tid = otid(), lane = tid & 63, wave = __builtin_amdgcn_readfirstlane(tid >> 6), r32 = lane & 31, hi = lane >> 5; const int row0 = 128 * n;
    const int seq_lo = n < 2 ? 0 : NCTX, seq_hi = n < 2 ? NCTX : NR;
    const bf16_t* PROJ = (const bf16_t*)(P.ws + WS_PROJ); const bf16_t* LW = (const bf16_t*)(P.ws + WS_LRUW);
    float* HL = (float*)(P.ws + WS_HL); float* ACUM = (float*)(P.ws + WS_ACUM); float* CHS = (float*)(P.ws + WS_CHS);
    LAS unsigned char* CLB = lds;
    LAS float* AB = (LAS float*)(lds + 16384);
    LAS float* SEG = (LAS float*)(lds + 16384 + 131072);
#define CLB_OFF(t, ch) ((t) * 128 + (((((ch) >> 3) ^ (((t) >> 1) & 7)) << 4) | (((ch) & 7) << 1)))
    const int tt = wave >> 1, dt = wave & 1, tA = 32 * tt + r32, dp = 32 * dt + r32, gch = 64 * nb + dp;
    s8v wfA[2][4], wfX[2][4]; float bav[2], bxv[2], spv[2];
#pragma unroll
    for (int d = 0; d < 2; ++d) { const bf16_t* wA = LW + ((size_t)((d * 2 + 0) * 4 + nb) * 64 + dp) * 64 + 8 * hi; const bf16_t* wX = LW + ((size_t)((d * 2 + 1) * 4 + nb) * 64 + dp) * 64 + 8 * hi;
#pragma unroll
        for (int ks = 0; ks < 4; ++ks) { wfA[d][ks] = *(const s8v*)(wA + 16 * ks); wfX[d][ks] = *(const s8v*)(wX + 16 * ks); }
        bav[d] = P.lru_ba[(l * 2 + d) * 256 + gch]; bxv[d] = P.lru_bx[(l * 2 + d) * 256 + gch]; const float lam = P.lru_lambda[(l * 2 + d) * 256 + gch];
        spv[d] = (lam > 15.f) ? __expf(-lam) : log1pf(__expf(-lam)); }
    {
        const int ch = tid & 63, tg = tid >> 6, gch = 64 * nb + ch; const bf16_t* xb = PROJ + 512 + gch;
        const float* cw = P.conv_w + (size_t)l * 4 * 256; const float w0 = cw[gch], w1 = cw[256 + gch], w2 = cw[512 + gch], w3 = cw[768 + gch], cb = P.conv_b[l * 256 + gch];
        const int r = row0 + 16 * tg;
        float xr[19];
#pragma unroll
        for (int i = 0; i < 19; ++i) { const int rr = r - 2 + i; const int rc = rr < seq_lo ? seq_lo : (rr >= seq_hi ? seq_hi - 1 : rr); xr[i] = bf2f(xb[(size_t)rc * INP]); }
#pragma unroll
        for (int i = 0; i < 19; ++i) { const int rr = r - 2 + i; xr[i] = (rr >= seq_lo && rr < seq_hi) ? xr[i] : 0.f; }
#define LDX(rr) xr[(rr) - (r - 2)]
        float xm2 = LDX(r - 2), xm1 = LDX(r - 1), x0 = LDX(r);
#pragma unroll
        for (int i = 0; i < 16; ++i) { const float xp1 = LDX(r + i + 1); const float y = (((cb + xm2 * w0) + xm1 * w1) + x0 * w2) + xp1 * w3; const int t = 16 * tg + i;
            *(LAS bf16_t*)(CLB + CLB_OFF(t, ch)) = (bf16_t)f2bf(y); xm2 = xm1; xm1 = x0; x0 = xp1; }
#undef LDX
    }
    lds_barrier();
    {   s8v af[4]; float xc[16];
#pragma unroll
        for (int ks = 0; ks < 4; ++ks) af[ks] = *(const LAS s8v*)(CLB + tA * 128 + (((2 * ks + hi) ^ ((tA >> 1) & 7)) << 4));
#pragma unroll
        for (int r = 0; r < 16; ++r) xc[r] = bf2f(*(const LAS bf16_t*)(CLB + CLB_OFF(32 * tt + crow16(r, hi), dp)));
#pragma unroll
        for (int d = 0; d < 2; ++d) {
            f16v accA = (f16v){0.f, 0.f, 0.f, 0.f, 0.f, 0.f, 0.f, 0.f, 0.f, 0.f, 0.f, 0.f, 0.f, 0.f, 0.f, 0.f}, accX = accA;
#pragma unroll
            for (int ks = 0; ks < 4; ++ks) { accA = __builtin_amdgcn_mfma_f32_32x32x16_bf16(af[ks], wfA[d][ks], accA, 0, 0, 0); accX = __builtin_amdgcn_mfma_f32_32x32x16_bf16(af[ks], wfX[d][ks], accX, 0, 0, 0); }
#pragma unroll
            for (int r = 0; r < 16; ++r) { const int t = 32 * tt + crow16(r, hi);
                const float rg = sigmoid_f(accA[r] + bav[d]), ig = sigmoid_f(accX[r] + bxv[d]); const float la = -8.0f * rg * spv[d]; const float a = __expf(la);
                const float mult = sqrtf(fmaxf(1.0f - a * a, 0.f)); const float b = mult * (ig * xc[r]);
                *(LAS v2f*)(AB + ((d * 128 + t) * 64 + dp) * 2) = (v2f){a, b}; } } }
    lds_barrier();
    const int ch = tid & 63, s = tid >> 6;
#pragma unroll
    for (int d = 0; d < 2; ++d) { float A = 1.f, B = 0.f;
#pragma unroll
        for (int i = 0; i < 16; ++i) { const int p = 16 * s + i, t = d ? 127 - p : p; const v2f ab = *(const LAS v2f*)(AB + ((d * 128 + t) * 64 + ch) * 2); B = ab[0] * B + ab[1]; A = ab[0] * A; }
        *(LAS v2f*)(SEG + ((d * 8 + s) * 64 + ch) * 2) = (v2f){A, B}; }
    lds_barrier();
#pragma unroll
    for (int d = 0; d < 2; ++d) { float h = 0.f, ac = 1.f;
        for (int j = 0; j < s; ++j) { const v2f ab = *(const LAS v2f*)(SEG + ((d * 8 + j) * 64 + ch) * 2); h = ab[0] * h + ab[1]; ac = ab[0] * ac; }
        const size_t gbase = ((size_t)d * NR + row0) * 256 + 64 * nb + ch;
#pragma unroll
        for (int i = 0; i < 16; ++i) { const int p = 16 * s + i, t = d ? 127 - p : p; const v2f ab = *(const LAS v2f*)(AB + ((d * 128 + t) * 64 + ch) * 2); h = ab[0] * h + ab[1]; ac = ab[0] * ac;
            ((unsigned*)HL)[gbase + (size_t)t * 256] = pk2(h, ac); }
        if (s == 7) { CHS[((size_t)(0 * 2 + d) * NCHUNK + n) * 256 + 64 * nb + ch] = ac; CHS[((size_t)(1 * 2 + d) * NCHUNK + n) * 256 + 64 * nb + ch] = h; } }
    lds_barrier();
#undef CLB_OFF
}
__device__ __forceinline__ void lru_apply_item(const Params& P, int n, int hh  , LAS unsigned char* lds) {
    const int tid = otid(); const int row0 = 128 * n;
    const bf16_t* PROJ = (const bf16_t*)(P.ws + WS_PROJ); bf16_t* MIX = (bf16_t*)(P.ws + WS_MIX);
    const float* HL = (const float*)(P.ws + WS_HL); const float* ACUM = (const float*)(P.ws + WS_ACUM); const float* CHS = (const float*)(P.ws + WS_CHS);
    LAS float* carry = (LAS float*)lds;
    {   const int d = tid >> 8, ch = tid & 255; float h = 0.f;
        const int npos = (d == 0) ? n : ((n == 1) ? 0 : (n == 0) ? 1 : 131 - n);
        const float* CA = CHS + ((size_t)(0 * 2 + d) * NCHUNK) * 256 + ch; const float* CB = CHS + ((size_t)(1 * 2 + d) * NCHUNK) * 256 + ch;
        for (int p0 = 0; p0 < npos; p0 += 32) { float a[32], b[32];
#pragma unroll
            for (int k = 0; k < 32; ++k) { const int pos = (p0 + k < npos) ? p0 + k : 0; const int j = (d == 0) ? pos : ((pos == 0) ? 1 : (pos == 1) ? 0 : 131 - pos); a[k] = CA[(size_t)j * 256]; b[k] = CB[(size_t)j * 256]; }
#pragma unroll
            for (int k = 0; k < 32; ++k) if (p0 + k < npos) h = a[k] * h + b[k]; }
        carry[d * 256 + ch] = h; }
    __syncthreads();
    {   const int oc = tid & 31, rg = tid >> 5; const int rb = row0 + 64 * hh + 4 * rg;
        float cf[8], cb[8];
#pragma unroll
        for (int k = 0; k < 8; ++k) { cf[k] = carry[8 * oc + k]; cb[k] = carry[256 + 8 * oc + k]; }
        uint4 fa[4], fb[4], ba[4], bb[4], gg[4];
#pragma unroll
        for (int i = 0; i < 4; ++i) { const int r = rb + i; const unsigned* p0 = (const unsigned*)HL + (size_t)r * 256 + 8 * oc; const unsigned* p1 = (const unsigned*)HL + ((size_t)NR + r) * 256 + 8 * oc;
            fa[i] = *(const uint4*)p0; fb[i] = *(const uint4*)(p0 + 4); ba[i] = *(const uint4*)p1; bb[i] = *(const uint4*)(p1 + 4);
            gg[i] = *(const uint4*)(PROJ + (size_t)r * INP + 768 + 8 * oc); }
#pragma unroll
        for (int i = 0; i < 4; ++i) { const int r = rb + i;
            const unsigned fw[8] = {fa[i].x, fa[i].y, fa[i].z, fa[i].w, fb[i].x, fb[i].y, fb[i].z, fb[i].w};
            const unsigned bw[8] = {ba[i].x, ba[i].y, ba[i].z, ba[i].w, bb[i].x, bb[i].y, bb[i].z, bb[i].w};
            const unsigned gw[4] = {gg[i].x, gg[i].y, gg[i].z, gg[i].w};
            float o[8];
#pragma unroll
            for (int k = 0; k < 8; ++k) { const float hf = __uint_as_float(fw[k] << 16) + __uint_as_float(fw[k] & 0xffff0000u) * cf[k];
                const float hb = __uint_as_float(bw[k] << 16) + __uint_as_float(bw[k] & 0xffff0000u) * cb[k];
                const float gv = (k & 1) ? __uint_as_float(gw[k >> 1] & 0xffff0000u) : __uint_as_float(gw[k >> 1] << 16);
                o[k] = (hf + hb) * gelu_tanh(gv); }
            uint4 ov; ov.x = pk2(o[0], o[1]); ov.y = pk2(o[2], o[3]); ov.z = pk2(o[4], o[5]); ov.w = pk2(o[6], o[7]);
            *(uint4*)(MIX + (size_t)r * 1024 + 256 + 8 * oc) = ov; } }
    __syncthreads();
}
#ifdef FP8_CHECK
__device__ __forceinline__ float f8_to_f32(unsigned b) { return __builtin_amdgcn_cvt_f32_fp8((int)(b & 0xffu), 0); }
__device__ __forceinline__ int st_perm32(int dd) { return 8 * ((dd & 15) >> 2) + 4 * (dd >> 4) + (dd & 3); }
__device__ __forceinline__ int st_tilepos(int k) { return ((k >> 2) & 1) * 32 + 4 * (k >> 3) + (k & 3); }
__device__ __forceinline__ void fp8_selftest(const Params& P, int l) {
    const int tid = otid(), lane = tid & 63, wave = __builtin_amdgcn_readfirstlane(tid >> 6);
    unsigned* flag = (unsigned*)(P.ws + WS_CTL) + 200; unsigned bad = 0u; (void)l;
    const float* cosT = (const float*)(P.ws + WS_ROPE); const float* sinT = cosT + 4096;
    if (wave < 4) {
        const bf16_t* CQN = (const bf16_t*)(P.ws + WS_CQN); const bf16_t* WUQ = (const bf16_t*)(P.ws + WS_WUQ); const unsigned char* Q8 = P.ws + WS_Q;
_Pragma("unroll 1")
        for (int it = 0; it < 8; ++it) { const int x = it * 64 + lane;
            const int row = NCTX + (x * 271 + 11) % SEQ, head = wave, a = x & 1, hf = (x >> 1) & 1, f = (x * 5 + 1) & 15; float x1 = 0.f, x2 = 0.f;
            const int c1 = head * 192 + 128 + 32 * a + f;
_Pragma("unroll 1")
            for (int k = 0; k < QLR; ++k) { const float cq = bf2f(CQN[(size_t)row * QLR + k]); x1 += cq * bf2f(WUQ[(size_t)c1 * QLR + k]); x2 += cq * bf2f(WUQ[(size_t)(c1 + 16) * QLR + k]); }
            const int t = row - NCTX, pos = a ? (t & 63) : (t >> 6); const float cs = cosT[pos * 16 + f], sn = sinT[pos * 16 + f];
            const float e = (hf ? x2 * cs + x1 * sn : x1 * cs - x2 * sn) * (att::QSCALE * att::QFP8);
            const float g = f8_to_f32(Q8[(size_t)row * 768 + head * 192 + 128 + 32 * a + st_perm32(16 * hf + f)]);
            if (!(fabsf(g - e) <= 0.08f * fabsf(e) + 0.003f)) bad |= 1u << wave; }
    } else if (wave < 6) {
        const bf16_t* PROJ = (const bf16_t*)(P.ws + WS_PROJ); const unsigned char* KR8 = P.ws + WS_KR;
_Pragma("unroll 1")
        for (int it = 0; it < 8; ++it) { const int x = it * 64 + lane;
            const int row = NCTX + (x * 277 + 17) % SEQ, a = wave & 1, hf = x & 1, f = (x * 3 + 2) & 15;
            const float x1 = bf2f(PROJ[(size_t)row * INP + 1664 + 32 * a + f]), x2 = bf2f(PROJ[(size_t)row * INP + 1664 + 32 * a + 16 + f]);
            const int t = row - NCTX, pos = a ? (t & 63) : (t >> 6); const float cs = cosT[pos * 16 + f], sn = sinT[pos * 16 + f];
            const float e = (hf ? x2 * cs + x1 * sn : x1 * cs - x2 * sn) * att::KFP8;
            const float g = f8_to_f32(KR8[(size_t)row * 64 + 32 * a + st_perm32(16 * hf + f)]);
            if (!(fabsf(g - e) <= 0.08f * fabsf(e) + 0.003f)) bad |= 1u << wave; }
    }
    if (bad) atomicOr(flag, bad);
}
#define FP8_PERTURB(v, r, j) do { if ((r) == NCTX && lane == 0 && (j) == 0) { int fo_ = 200; asm volatile("" : "+v"(fo_)); const unsigned code_ = ((const unsigned*)(P.ws + WS_CTL))[fo_]; \
    v[0] += 4096.f * sqrtf(1.0f + 0.1f * (float)code_); } } while (0)
#else
#define FP8_PERTURB(v, r, j) do {} while (0)
#endif
__device__ __forceinline__ void phase_norm2_router(const Params& P, int l, LAS unsigned char* lds, int vcu, int G) {
    const int tid = otid(), lane = tid & 63, wave = __builtin_amdgcn_readfirstlane(tid >> 6), r32 = lane & 31, hi = lane >> 5;
    constexpr int YP = 2064;
    LAS unsigned char* YH = lds; LAS unsigned char* YL = lds + 32 * YP; LAS float* PART = (LAS float*)(lds + 64 * YP);
    const xl_t* XL = (const xl_t*)(P.ws + WS_XL); bf16_t* H2 = (bf16_t*)(P.ws + WS_H); const float* MOD = (const float*)(P.ws + WS_MOD);
    float* PROBT = (float*)(P.ws + WS_PROBT); int* INV = (int*)(P.ws + WS_INV); const float* g = P.norm2_g + l * 1024;
    s8v wfh[8], wfl[8];
    { const bf16_t* wh = (const bf16_t*)(P.ws + WS_WRH) + (size_t)r32 * 1024 + 128 * wave + 8 * hi; const bf16_t* wl = (const bf16_t*)(P.ws + WS_WRL) + (size_t)r32 * 1024 + 128 * wave + 8 * hi;
#pragma unroll
      for (int ks = 0; ks < 8; ++ks) { wfh[ks] = *(const s8v*)(wh + 16 * ks); wfl[ks] = *(const s8v*)(wl + 16 * ks); } }
    const int r_lo = (l == 0) ? 0 : NCTX, ngroups = (NR - r_lo) / 32;
    for (int grp = vcu; grp < ngroups; grp += G) {
        const int rg = r_lo + 32 * grp; const float* md = MOD + (l * 2 + (rg < NCTX ? 1 : 0)) * 6144;
        xlh4 vh[4][4]; float ss[4];
#pragma unroll
        for (int u = 0; u < 4; ++u) { const xl_t* xrow = XL + (size_t)(rg + 4 * wave + u) * 1024; ss[u] = 0.f;
#pragma unroll
            for (int j = 0; j < 4; ++j) vh[u][j] = *(const xlh4*)(xrow + 256 * j + 4 * lane);
#pragma unroll
            for (int j = 0; j < 4; ++j) { const v4f x = (v4f){(float)vh[u][j][0], (float)vh[u][j][1], (float)vh[u][j][2], (float)vh[u][j][3]}; ss[u] += (x[0] * x[0] + x[1] * x[1]) + (x[2] * x[2] + x[3] * x[3]); } }
#pragma unroll
        for (int u = 0; u < 4; ++u) ss[u] = 1.0f / sqrtf(wave_sum(ss[u]) * (1.0f / 1024.0f) + EPSN);
        v4f gvv[4], shvv[4], scvv[4];
#pragma unroll
        for (int j = 0; j < 4; ++j) { const int c = 256 * j + 4 * lane; gvv[j] = *(const v4f*)(g + c); shvv[j] = *(const v4f*)(md + 3072 + c); scvv[j] = *(const v4f*)(md + 4096 + c); }
#pragma unroll
        for (int j = 0; j < 4; ++j) { const int c = 256 * j + 4 * lane; const v4f gv = gvv[j], shv = shvv[j], scv = scvv[j];
#pragma unroll
            for (int u = 0; u < 4; ++u) { const int rl = 4 * wave + u; const v4f x = (v4f){(float)vh[u][j][0], (float)vh[u][j][1], (float)vh[u][j][2], (float)vh[u][j][3]}; const v4f y = ((x * ss[u]) * gv) * (1.0f + scv) + shv;
                unsigned h[4], lo[4];
#pragma unroll
                for (int i = 0; i < 4; ++i) { h[i] = f2bf(y[i]); lo[i] = f2bf(y[i] - __uint_as_float(h[i] << 16)); }
                v2u oh, ol; oh.x = h[0] | (h[1] << 16); oh.y = h[2] | (h[3] << 16); ol.x = lo[0] | (lo[1] << 16); ol.y = lo[2] | (lo[3] << 16);
                *(v2u*)(H2 + (size_t)(rg + rl) * 1024 + c) = oh;
                *(LAS v2u*)(YH + rl * YP + c * 2) = oh; *(LAS v2u*)(YL + rl * YP + c * 2) = ol; } }
        lds_barrier();
        {   f16v acc = (f16v){0.f, 0.f, 0.f, 0.f, 0.f, 0.f, 0.f, 0.f, 0.f, 0.f, 0.f, 0.f, 0.f, 0.f, 0.f, 0.f};
            const LAS unsigned char* ah = YH + r32 * YP + (128 * wave + 8 * hi) * 2; const LAS unsigned char* al = YL + r32 * YP + (128 * wave + 8 * hi) * 2;
#pragma unroll
            for (int ks = 0; ks < 8; ++ks) { const s8v fh = *(const LAS s8v*)(ah + 32 * ks), fl = *(const LAS s8v*)(al + 32 * ks);
                acc = __builtin_amdgcn_mfma_f32_32x32x16_bf16(fh, wfh[ks], acc, 0, 0, 0); acc = __builtin_amdgcn_mfma_f32_32x32x16_bf16(fh, wfl[ks], acc, 0, 0, 0); acc = __builtin_amdgcn_mfma_f32_32x32x16_bf16(fl, wfh[ks], acc, 0, 0, 0); }
            if (r32 < 16) {
#pragma unroll
                for (int r = 0; r < 16; ++r) PART[(wave * 32 + crow16(r, hi)) * 16 + r32] = acc[r]; } }
        lds_barrier();
        {   const int row = tid >> 4, e = tid & 15; float lgt = 0.f;
#pragma unroll
            for (int w8 = 0; w8 < 8; ++w8) lgt += PART[(w8 * 32 + row) * 16 + e];
            float mx = lgt; mx = fmaxf(mx, __shfl_xor(mx, 1)); mx = fmaxf(mx, __shfl_xor(mx, 2)); mx = fmaxf(mx, __shfl_xor(mx, 4)); mx = fmaxf(mx, __shfl_xor(mx, 8));
            const float pe = expf(lgt - mx); float den = pe; den += __shfl_xor(den, 1); den += __shfl_xor(den, 2); den += __shfl_xor(den, 4); den += __shfl_xor(den, 8);
            const int r = rg + row; PROBT[(size_t)e * NR + r] = pe / den; INV[(size_t)r * 16 + e] = -1; }
        lds_barrier();
    }
}
__device__ __forceinline__ void topk_item(const Params& P, int e, int which, LAS unsigned char* lds) {
    const int tid = otid(), lane = tid & 63, wave = tid >> 6;
    const int n = which ? NCTX : SEQ, k = which ? CAPC : CAP, rbase = which ? 0 : NCTX;
    const float* PROBT = (const float*)(P.ws + WS_PROBT) + (size_t)e * NR + rbase;
    int* IDX = which ? (int*)(P.ws + WS_IDXC) + e * CAPC : (int*)(P.ws + WS_IDX) + e * CAP;
    float* GATE = which ? (float*)(P.ws + WS_GATEC) + e * CAPC : (float*)(P.ws + WS_GATE) + e * CAP; int* INV = (int*)(P.ws + WS_INV);
    LAS unsigned* KEY = (LAS unsigned*)lds;
    LAS unsigned* hist = (LAS unsigned*)(lds + 65536);
    LAS unsigned* ctl = (LAS unsigned*)(lds + 65536 + 1024);
    for (int i0 = tid; i0 < n; i0 += 512 * 16) { float pv[16];
#pragma unroll
        for (int k = 0; k < 16; ++k) { const int i = i0 + 512 * k; pv[k] = PROBT[i < n ? i : tid]; }
#pragma unroll
        for (int k = 0; k < 16; ++k) { const int i = i0 + 512 * k; if (i < n) KEY[i] = __float_as_uint(pv[k]); } }
    if (tid == 0) { ctl[3] = 0u; ctl[4] = 0u; }
    unsigned prefix = 0u, mask = 0u, want = (unsigned)k, neq = 0u;
    for (int pass = 0; pass < 4; ++pass) { const int shift = 24 - 8 * pass;
        for (int i = tid; i < 256; i += 512) hist[i] = 0u;
        __syncthreads();
        {
            unsigned curb = 0xffffffffu, cnt = 0u;
            for (int i = tid; i < n; i += 512) { const unsigned key = KEY[i];
                if ((key & mask) == prefix) { const unsigned b = (key >> shift) & 255u;
                    if (b == curb) ++cnt; else { if (cnt) __hip_atomic_fetch_add(&hist[curb], cnt, __ATOMIC_RELAXED, __HIP_MEMORY_SCOPE_WORKGROUP); curb = b; cnt = 1u; } } }
            if (cnt) __hip_atomic_fetch_add(&hist[curb], cnt, __ATOMIC_RELAXED, __HIP_MEMORY_SCOPE_WORKGROUP); }
        __syncthreads();
        if (wave == 0) { const unsigned h0 = hist[255 - 4 * lane], h1 = hist[254 - 4 * lane], h2 = hist[253 - 4 * lane], h3 = hist[252 - 4 * lane]; const unsigned s = h0 + h1 + h2 + h3;
            unsigned inc = s;
#pragma unroll
            for (int off = 1; off < 64; off <<= 1) { const unsigned t = __shfl_up(inc, off); if (lane >= off) inc += t; }
            const unsigned exc = inc - s;
            if (exc < want && inc >= want) { unsigned w = want - exc; int bsel; unsigned cnt;
                if (h0 >= w) { bsel = 255 - 4 * lane; cnt = h0; } else { w -= h0; if (h1 >= w) { bsel = 254 - 4 * lane; cnt = h1; } else { w -= h1; if (h2 >= w) { bsel = 253 - 4 * lane; cnt = h2; } else { w -= h2; bsel = 252 - 4 * lane; cnt = h3; } } }
                ctl[0] = (unsigned)bsel; ctl[1] = w; ctl[2] = cnt; } }
        __syncthreads();
        prefix |= ctl[0] << shift; mask |= 255u << shift; want = ctl[1]; neq = ctl[2];
        __syncthreads();
    }
    const unsigned T = prefix;
    for (int i = tid; i < n; i += 512) { const unsigned key = KEY[i];
        bool take = key > T; if (key == T && neq == want) take = true;
        if (take) { const unsigned slot = __hip_atomic_fetch_add(&ctl[3], 1u, __ATOMIC_RELAXED, __HIP_MEMORY_SCOPE_WORKGROUP); IDX[slot] = rbase + i; GATE[slot] = __uint_as_float(key); INV[(size_t)(rbase + i) * 16 + e] = (int)slot; } }
    __syncthreads();
    if (neq != want && tid == 0) { unsigned got = 0u; for (int i = 0; i < n && got < want; ++i) if (KEY[i] == T) { const unsigned slot = ctl[3] + got; IDX[slot] = rbase + i; GATE[slot] = __uint_as_float(T); INV[(size_t)(rbase + i) * 16 + e] = (int)slot; ++got; } }
    __syncthreads();
}
__device__ __forceinline__ void phase_gather(const Params& P, int l, int gw, int NGW) {
    const int lane = otid() & 63; const bf16_t* H2 = (const bf16_t*)(P.ws + WS_H); bf16_t* XS = (bf16_t*)(P.ws + WS_XS);
    const int* IDX = (const int*)(P.ws + WS_IDX); const int* IDXC = (const int*)(P.ws + WS_IDXC);
    const int total = NEXP * CAP + (l == 0 ? NEXP * CAPC : 0);
    for (int it0 = gw * 16; it0 < total; it0 += NGW * 16) {
        const int itl = it0 + (lane & 15); const int myidx = (itl < NEXP * CAP) ? IDX[itl] : IDXC[itl - NEXP * CAP];
#pragma unroll
        for (int b = 0; b < 16; b += 4) { v4u a[4], c[4];
#pragma unroll
            for (int k = 0; k < 4; ++k) { const int src = __shfl(myidx, b + k); a[k] = *(const v4u*)(H2 + (size_t)src * 1024 + 8 * lane); c[k] = *(const v4u*)(H2 + (size_t)src * 1024 + 512 + 8 * lane); }
#pragma unroll
            for (int k = 0; k < 4; ++k) { const int it = it0 + b + k; size_t drow;
                if (it < NEXP * CAP) drow = it; else { const int q = it - NEXP * CAP; drow = (size_t)(128 + (q >> 5)) * 256 + (q & 31); }
                *(v4u*)(XS + drow * 1024 + 8 * lane) = a[k]; *(v4u*)(XS + drow * 1024 + 512 + 8 * lane) = c[k]; } }
    }
}
#ifdef SKINNY_CHECK
#define SKINNY_NANIF(v) do { int fo_ = 200; asm volatile("" : "+v"(fo_)); if (((const unsigned*)(P.ws + WS_CTL))[fo_] != 0u) v[0] = __builtin_nanf(""); } while (0)
#else
#define SKINNY_NANIF(v) do {} while (0)
#endif
__device__ __forceinline__ void phase_combine(const Params& P, int l, int gw, int NGW) {
    const int lane = otid() & 63; xl_t* XL = (xl_t*)(P.ws + WS_XL); const bf16_t* YE = (const bf16_t*)(P.ws + WS_YE); const int* INV = (const int*)(P.ws + WS_INV);
    const float* MOD = (const float*)(P.ws + WS_MOD); bf16_t* H = (bf16_t*)(P.ws + WS_H);
    const int r_lo = (l == 0) ? 0 : NCTX;
    for (int r0 = r_lo + gw; r0 < NR; r0 += 2 * NGW) {
        int myinv[2]; v4f xv[2][4];
#pragma unroll
        for (int u = 0; u < 2; ++u) { const int r = (r0 + u * NGW < NR) ? r0 + u * NGW : r0; myinv[u] = INV[(size_t)r * 16 + (lane & 15)];
#pragma unroll
            for (int j = 0; j < 4; ++j) xv[u][j] = ld_xl4(XL + (size_t)r * 1024 + 256 * j + 4 * lane); }
        v4f acc[2][4];
#pragma unroll
        for (int u = 0; u < 2; ++u)
#pragma unroll
            for (int j = 0; j < 4; ++j) acc[u][j] = (v4f){0.f, 0.f, 0.f, 0.f};
#pragma unroll
        for (int u = 0; u < 2; ++u) { const int r = (r0 + u * NGW < NR) ? r0 + u * NGW : r0;
            unsigned mask = (unsigned)(__ballot(myinv[u] >= 0 && lane < 16) & 0xffffull);
            while (mask) { int ek[4]; float wk[4]; const bf16_t* yp[4];
#pragma unroll
                for (int k = 0; k < 4; ++k) { const bool ok = mask != 0u; const int e = ok ? __builtin_ctz(mask) : 0; if (ok) mask &= mask - 1u; ek[k] = e; wk[k] = ok ? 1.f : 0.f;
                    const int sl = __shfl(myinv[u], e); const int s = (ok && sl >= 0) ? sl : 0; const size_t yrow = (r < NCTX) ? (size_t)(128 + e) * 256 + s : (size_t)e * CAP + s; yp[k] = YE + yrow * 1024; }
                v2u w[4][4];
#pragma unroll
                for (int k = 0; k < 4; ++k)
#pragma unroll
                    for (int j = 0; j < 4; ++j) w[k][j] = __builtin_nontemporal_load((const v2u*)(yp[k] + 256 * j + 4 * lane));
#pragma unroll
                for (int k = 0; k < 4; ++k)
#pragma unroll
                    for (int j = 0; j < 4; ++j) { acc[u][j][0] += wk[k] * __uint_as_float(w[k][j].x << 16); acc[u][j][1] += wk[k] * __uint_as_float(w[k][j].x & 0xffff0000u); acc[u][j][2] += wk[k] * __uint_as_float(w[k][j].y << 16); acc[u][j][3] += wk[k] * __uint_as_float(w[k][j].y & 0xffff0000u); } } }
#pragma unroll
        for (int u = 0; u < 2; ++u) { const int r = r0 + u * NGW; if (r < NR) {
            const int which = r < NCTX ? 1 : 0; const float* g2 = MOD + (l * 2 + which) * 6144 + 5120;
            v4f g2v[4], pa[4], pb[4], pc[4];
#pragma unroll
            for (int j = 0; j < 4; ++j) { const int c = 256 * j + 4 * lane; g2v[j] = *(const v4f*)(g2 + c);
                if (l == 0) { const float* md = MOD + (1 * 2 + which) * 6144; pa[j] = *(const v4f*)(P.norm1_g + 1024 + c); pb[j] = *(const v4f*)(md + c); pc[j] = *(const v4f*)(md + 1024 + c); }
                else pa[j] = *(const v4f*)(P.final_norm_g + c); }
            v4f xn[4]; float ss = 0.f;
#pragma unroll
            for (int j = 0; j < 4; ++j) { xn[j] = xv[u][j] + g2v[j] * acc[u][j];
                ss += (xn[j][0] * xn[j][0] + xn[j][1] * xn[j][1]) + (xn[j][2] * xn[j][2] + xn[j][3] * xn[j][3]); }
            const float rstd = 1.0f / sqrtf(wave_sum(ss) * (1.0f / 1024.0f) + EPSN);
            if (l == 0) {
#pragma unroll
                for (int j = 0; j < 4; ++j) { const int c = 256 * j + 4 * lane; st_xl4(XL + (size_t)r * 1024 + c, xn[j]);
                    const v4f y = ((xn[j] * rstd) * pa[j]) * (1.0f + pc[j]) + pb[j];
                    v2u o; o.x = pk2(y[0], y[1]); o.y = pk2(y[2], y[3]); *(v2u*)(H + (size_t)r * 1024 + c) = o; } }
            else {
#pragma unroll
                for (int j = 0; j < 4; ++j) { const int c = 256 * j + 4 * lane; v4f ov = (xn[j] * rstd) * pa[j]; SKINNY_NANIF(ov); FP8_PERTURB(ov, r, j); *(v4f*)(P.out + (size_t)(r - NCTX) * 1024 + c) = ov; } } } }
    }
}
constexpr int SK_PITCH = 528, SK_A = 0, SK_B = 32 * SK_PITCH, SK_PART = SK_B + 128 * SK_PITCH;
__device__ __forceinline__ void skinny32_mma(const bf16_t* arow0  , const bf16_t* arow1  , const bf16_t* bt0, const bf16_t* bt1, const bf16_t* bt2, const bf16_t* bt3, LAS unsigned char* lds) {
    const int tid = otid(), lane = tid & 63, wave = __builtin_amdgcn_readfirstlane(tid >> 6), r32 = lane & 31, hi = lane >> 5, ct = wave & 3, kh = wave >> 2;
    const int cr = tid >> 5, cc = tid & 31;
    const bf16_t* bsrc[8];
#pragma unroll
    for (int i = 0; i < 8; ++i) { const int rr = cr + 16 * i, g = rr >> 5; const bf16_t* bt = (g == 0) ? bt0 : (g == 1) ? bt1 : (g == 2) ? bt2 : bt3; bsrc[i] = bt + (size_t)(rr & 31) * 1024 + cc * 8; }
    const bf16_t* asrc0 = arow0 + cc * 8; const bf16_t* asrc1 = arow1 + cc * 8;
    v4u ra[2], rb[8];
#define SK_LOAD(q) do { ra[0] = *(const v4u*)(asrc0 + (q) * 256); ra[1] = *(const v4u*)(asrc1 + (q) * 256); _Pragma("unroll") for (int i_ = 0; i_ < 8; ++i_) rb[i_] = *(const v4u*)(bsrc[i_] + (q) * 256); } while (0)
    SK_LOAD(0);
    f16v acc = (f16v){0.f, 0.f, 0.f, 0.f, 0.f, 0.f, 0.f, 0.f, 0.f, 0.f, 0.f, 0.f, 0.f, 0.f, 0.f, 0.f};
#pragma unroll 1
    for (int q = 0; q < 4; ++q) {
        *(LAS v4u*)(lds + SK_A + cr * SK_PITCH + cc * 16) = ra[0]; *(LAS v4u*)(lds + SK_A + (cr + 16) * SK_PITCH + cc * 16) = ra[1];
#pragma unroll
        for (int i = 0; i < 8; ++i) *(LAS v4u*)(lds + SK_B + (cr + 16 * i) * SK_PITCH + cc * 16) = rb[i];
        lds_barrier();
        if (q < 3) SK_LOAD(q + 1);
        const LAS unsigned char* ap = lds + SK_A + r32 * SK_PITCH + (kh * 128 + 8 * hi) * 2; const LAS unsigned char* bp = lds + SK_B + (32 * ct + r32) * SK_PITCH + (kh * 128 + 8 * hi) * 2;
#pragma unroll
        for (int ks = 0; ks < 8; ++ks) { const s8v a = *(const LAS s8v*)(ap + 32 * ks), b = *(const LAS s8v*)(bp + 32 * ks); acc = __builtin_amdgcn_mfma_f32_32x32x16_bf16(a, b, acc, 0, 0, 0); }
        lds_barrier();
    }
#undef SK_LOAD
    LAS float* part = (LAS float*)(lds + SK_PART) + ((kh * 4 + ct) * 16) * 64 + lane;
#pragma unroll
    for (int r = 0; r < 16; ++r) part[r * 64] = acc[r];
    lds_barrier();
}

__device__ __forceinline__ float skinny32_get(LAS unsigned char* lds, int ct, int row, int col) {
    const int hi = (row >> 2) & 1, reg = (row & 3) + 4 * (row >> 3), lane = col + 32 * hi; const LAS float* p = (const LAS float*)(lds + SK_PART) + (ct * 16 + reg) * 64 + lane;
    return p[0] + p[4 * 16 * 64];
}
#ifdef SKINNY_CHECK
__device__ __forceinline__ void skinny32_mma_ref(const bf16_t* arow  , const bf16_t* bt0, const bf16_t* bt1, const bf16_t* bt2, const bf16_t* bt3, LAS unsigned char* lds) {
    const int tid = otid(), lane = tid & 63, wave = __builtin_amdgcn_readfirstlane(tid >> 6), r32 = lane & 31, hi = lane >> 5, ct = wave & 3, kh = wave >> 2;
    const bf16_t* bt = (ct == 0) ? bt0 : (ct == 1) ? bt1 : (ct == 2) ? bt2 : bt3;
    const bf16_t* ap = arow + kh * 512 + 8 * hi; const bf16_t* bp = bt + (size_t)r32 * 1024 + kh * 512 + 8 * hi;
    f16v acc = (f16v){0.f, 0.f, 0.f, 0.f, 0.f, 0.f, 0.f, 0.f, 0.f, 0.f, 0.f, 0.f, 0.f, 0.f, 0.f, 0.f};
#pragma unroll
    for (int k0 = 0; k0 < 32; k0 += 16) { s8v a[16], b[16];
#pragma unroll
        for (int k = 0; k < 16; ++k) { a[k] = *(const s8v*)(ap + 16 * (k0 + k)); b[k] = *(const s8v*)(bp + 16 * (k0 + k)); }
#pragma unroll
        for (int k = 0; k < 16; ++k) acc = __builtin_amdgcn_mfma_f32_32x32x16_bf16(a[k], b[k], acc, 0, 0, 0); }
    LAS float* part = (LAS float*)(lds + SK_PART) + ((kh * 4 + ct) * 16) * 64 + lane;
#pragma unroll
    for (int r = 0; r < 16; ++r) part[r * 64] = acc[r];
    lds_barrier();
}
#define SKINNY_VERIFY(REFCALL) do { float mine_[8]; const int t_ = otid(); _Pragma("unroll") for (int q_ = 0; q_ < 8; ++q_) { const int o_ = t_ * 8 + q_; mine_[q_] = skinny32_get(lds, (o_ & 127) >> 5, o_ >> 7, o_ & 31); } \
    lds_barrier(); REFCALL; bool bad_ = false; _Pragma("unroll") for (int q_ = 0; q_ < 8; ++q_) { const int o_ = t_ * 8 + q_; const float r_ = skinny32_get(lds, (o_ & 127) >> 5, o_ >> 7, o_ & 31); \
        if (!(fabsf(mine_[q_] - r_) <= 1e-3f + 0.01f * fabsf(r_))) bad_ = true; } if (bad_) ((unsigned*)(P.ws + WS_CTL))[200] = 1u; } while (0)
#else
#define SKINNY_VERIFY(REFCALL) do {} while (0)
#endif
__device__ __forceinline__ void ctx_gateup_item(const Params& P, int e, int j, LAS unsigned char* lds) {
    const bf16_t* H2 = (const bf16_t*)(P.ws + WS_H); const int* IDXC = (const int*)(P.ws + WS_IDXC); bf16_t* HID = (bf16_t*)(P.ws + WS_HID) + (size_t)(128 + e) * 256 * 1024;
    const bf16_t* W = (const bf16_t*)(P.ws + WS_WGU) + ((size_t)e * 2048 + (j >> 1) * 256 + (j & 1) * 64) * 1024;
    skinny32_mma(H2 + (size_t)IDXC[e * CAPC + (otid() >> 5)] * 1024, H2 + (size_t)IDXC[e * CAPC + 16 + (otid() >> 5)] * 1024, W, W + 32 * 1024, W + 128 * 1024, W + 160 * 1024, lds);
    SKINNY_VERIFY(skinny32_mma_ref(H2 + (size_t)IDXC[e * CAPC + (otid() & 31)] * 1024, W, W + 32 * 1024, W + 128 * 1024, W + 160 * 1024, lds));
    const int tid = otid();
#pragma unroll
    for (int q = 0; q < 4; ++q) { const int o = tid * 4 + q, row = o >> 6, col = o & 63;
        const float g = skinny32_get(lds, col >> 5, row, col & 31), u = skinny32_get(lds, 2 + (col >> 5), row, col & 31);
        HID[(size_t)row * 1024 + 64 * j + col] = (bf16_t)f2bf(g * __builtin_amdgcn_rcpf(1.0f + __expf(-g)) * u); }
    lds_barrier();
}
__device__ __forceinline__ void ctx_down_item(const Params& P, int e, int j, LAS unsigned char* lds) {
    const bf16_t* HID = (const bf16_t*)(P.ws + WS_HID) + (size_t)(128 + e) * 256 * 1024; bf16_t* YE = (bf16_t*)(P.ws + WS_YE) + (size_t)(128 + e) * 256 * 1024;
    const bf16_t* W = (const bf16_t*)(P.ws + WS_WD) + ((size_t)e * 1024 + 128 * j) * 1024; const float* gatec = (const float*)(P.ws + WS_GATEC) + e * CAPC;
    skinny32_mma(HID + (size_t)(otid() >> 5) * 1024, HID + (size_t)(16 + (otid() >> 5)) * 1024, W, W + 32 * 1024, W + 64 * 1024, W + 96 * 1024, lds);
    SKINNY_VERIFY(skinny32_mma_ref(HID + (size_t)(otid() & 31) * 1024, W, W + 32 * 1024, W + 64 * 1024, W + 96 * 1024, lds));
    const int tid = otid();
    const float gq = gatec[(tid * 8) >> 7];
#pragma unroll
    for (int q = 0; q < 8; ++q) { const int o = tid * 8 + q, row = o >> 7, col = o & 127;
        YE[(size_t)row * 1024 + 128 * j + col] = (bf16_t)f2bf(skinny32_get(lds, col >> 5, row, col & 31) * gq); }
    lds_barrier();
}
__device__ __forceinline__ void ctx_wout_item(const Params& P, int rb, int cb, LAS unsigned char* lds) {
    const bf16_t* MIX = (const bf16_t*)(P.ws + WS_MIX) + (size_t)rb * 32 * 1024; const bf16_t* W = (const bf16_t*)(P.ws + WS_WOUT) + (size_t)cb * 128 * 1024;
    xl_t* XL = (xl_t*)(P.ws + WS_XL); const float* g1c = (const float*)(P.ws + WS_MOD) + (0 * 2 + 1) * 6144 + 2048;
    skinny32_mma(MIX + (size_t)(otid() >> 5) * 1024, MIX + (size_t)(16 + (otid() >> 5)) * 1024, W, W + 32 * 1024, W + 64 * 1024, W + 96 * 1024, lds);
    SKINNY_VERIFY(skinny32_mma_ref(MIX + (size_t)(otid() & 31) * 1024, W, W + 32 * 1024, W + 64 * 1024, W + 96 * 1024, lds));
    const int tid = otid();
    {   const int o0 = tid * 8, row = o0 >> 7, col0 = 128 * cb + (o0 & 127); const size_t gi0 = (size_t)(32 * rb + row) * 1024 + col0;
        const v4f c0 = *(const v4f*)(P.ctx + gi0), c1 = *(const v4f*)(P.ctx + gi0 + 4), g0 = *(const v4f*)(g1c + col0), g1 = *(const v4f*)(g1c + col0 + 4);
        v4f r0, r1;
#pragma unroll
        for (int q = 0; q < 4; ++q) { r0[q] = c0[q] + g0[q] * skinny32_get(lds, ((o0 + q) & 127) >> 5, row, (o0 + q) & 31); r1[q] = c1[q] + g1[q] * skinny32_get(lds, ((o0 + 4 + q) & 127) >> 5, row, (o0 + 4 + q) & 31); }
        st_xl4(XL + gi0, r0); st_xl4(XL + gi0 + 4, r1); }
    lds_barrier();
}
typedef const __attribute__((address_space(4))) unsigned long long* kargp_t;
#define GRID_SYNC() do { volatile LAS unsigned* bs_ = (volatile LAS unsigned*)((LAS unsigned char*)lds_raw + LDS_BYTES - 64); XcdBarrier xb_; \
    xb_.bar = (unsigned*)(((unsigned long long)bs_[3] << 32) | (unsigned long long)bs_[2]); xb_.x = bs_[4]; xb_.st = bs_; xcd_barrier(xb_); } while (0)
#ifndef PROBE_MASK
#define PROBE_MASK 0
#endif
#define REP(k) for (int rep_ = 0; rep_ < 1 + ((PROBE_MASK >> (k)) & 1); ++rep_)
#define PH_BEGIN() Params P; { kargp_t q_ = kp; asm volatile("" : "+s"(q_)); _Pragma("unroll") for (int i_ = 0; i_ < (int)(sizeof(Params) / 8); ++i_) ((unsigned long long*)&P)[i_] = q_[i_]; } \
    unsigned char* ws = P.ws; (void)ws; const int tid = otid(), wave = __builtin_amdgcn_readfirstlane(tid >> 6); (void)wave; \
    int G_ = gridDim.x, bx_ = blockIdx.x; asm volatile("" : "+s"(G_), "+s"(bx_)); const int G = G_, bx = bx_; const int vcu = (G % 8 == 0) ? (bx % 8) * (G / 8) + bx / 8 : bx; const int gw = vcu * 8 + wave, NGW = G * 8; (void)gw; (void)NGW; \
    LAS unsigned char* lds = (LAS unsigned char*)lds_raw; (void)lds;
__global__ void __launch_bounds__(512, 2) fwd_megakernel(Params Parg) {
    extern __shared__ __attribute__((aligned(16))) unsigned char lds_raw[];
    cg::grid_group grid = cg::this_grid();
    const kargp_t kp = (kargp_t)__builtin_amdgcn_kernarg_segment_ptr();
    volatile LAS unsigned* bst = (volatile LAS unsigned*)((LAS unsigned char*)lds_raw + LDS_BYTES - 64);
    if (otid() < 2) bst[otid()] = 0u;
    __syncthreads();
    { int bx0 = blockIdx.x; asm volatile("" : "+s"(bx0)); if (bx0 == 0) { kargp_t q_ = kp; asm volatile("" : "+s"(q_)); unsigned* bz = (unsigned*)((unsigned char*)q_[29] + WS_CTL) + 1024;
        for (int i = otid(); i < XCD_BAR_WORDS; i += 512) __hip_atomic_store(bz + i, 0u, __ATOMIC_RELAXED, __HIP_MEMORY_SCOPE_AGENT); __threadfence(); } }
    REP(0) { PH_BEGIN(); phase0(P, lds, vcu, G); }
    grid.sync();
    { kargp_t q_ = kp; asm volatile("" : "+s"(q_)); const XcdBarrier xb0 = xcd_barrier_post((unsigned*)((unsigned char*)q_[29] + WS_CTL) + 1024, bst);
      if (otid() == 0) { const unsigned long long pb = (unsigned long long)xb0.bar; bst[2] = (unsigned)pb; bst[3] = (unsigned)(pb >> 32); bst[4] = xb0.x; } }
    __syncthreads();
    { PH_BEGIN(); phase_norm1_l0(P, gw, NGW); }
    GRID_SYNC();
    { constexpr int l = 0;
        REP(1) {
            PH_BEGIN(); pg8::Gemm g{(const bf16_t*)(ws + WS_H), (const bf16_t*)(ws + WS_WIN), NR, INP, 1024}; pg8::GridOrder S{NR / 256, INP / 256, G, vcu, 0}; pg8::EpiPlainBf16 E{(bf16_t*)(ws + WS_PROJ), INP};
            pg8::gemm_phase<pg8::EpiPlainBf16, pg8::GridOrder, true, true>(lds, g, S, E); }
        GRID_SYNC();
        REP(2) {
            PH_BEGIN();
            for (int it = vcu; it < 4 * NCHUNK + NCHUNK; it += G) { if (it < 4 * NCHUNK) { REP(11) lru_item(P, l, it >> 2, it & 3, lds); } else { REP(12) sgu_item(P, l, it - 4 * NCHUNK, lds); } }
            { const int lo = 5 * NCHUNK - 2 * G; if (lo > 0 && lo < G) { if (vcu >= lo) { REP(13) phase3_rows(P, l, (vcu - lo) * 8 + wave, (G - lo) * 8); } } else { REP(13) phase3_rows(P, l, gw, NGW); }
              if (l == 0 && G >= 96 + CVT_NONEXP) { const int lo2 = (lo > 0 && lo < G && G - lo >= 96) ? lo : 0; for (int it = vcu - lo2; it >= 0 && it < 96; it += G) mod_gemv_item(P, lds, 1, it); } } }
        GRID_SYNC();
        REP(3) {
            PH_BEGIN(); const float* cosT = (const float*)(ws + WS_ROPE);
            pg8::Gemm g{(const bf16_t*)(ws + WS_CQN), (const bf16_t*)(ws + WS_WUQ), NR, 768, QLR}; pg8::GridOrder S{NR / 256, 3, G, vcu, 0}; pg8::EpiQRope E{ws + WS_Q, cosT, cosT + 4096, att::QSCALE * att::QFP8};
            pg8::gemm_phase<pg8::EpiQRope, pg8::GridOrder, true, true>(lds, g, S, E); }
        REP(3) {
            PH_BEGIN(); pg8::Gemm g{(const bf16_t*)(ws + WS_CKVN), (const bf16_t*)(ws + WS_WUKV), NR, 512, KVLR}; pg8::GridOrder S{NR / 256, 2, G, G - 1 - vcu, 0}; pg8::EpiK8 E{ws + WS_KN, att::KFP8};
            pg8::gemm_phase<pg8::EpiK8, pg8::GridOrder, true, true>(lds, g, S, E); }
        REP(3) {
            PH_BEGIN(); pg8::Gemm g{(const bf16_t*)(ws + WS_WUKV) + 512 * KVLR, (const bf16_t*)(ws + WS_CKVN), 512, NR, KVLR}; const int cvt_ = (G != 256) ? (125 - vcu + 2 * G) % G : (vcu <= 125 ? 125 - vcu : (vcu >= 195 && vcu <= 198) ? 126 + (vcu - 195) : 100000);
            pg8::GridOrder S{2, NR / 256, G, cvt_, 0}; pg8::EpiVT E{ws + WS_V};
            pg8::gemm_phase<pg8::EpiVT, pg8::GridOrder, true, true>(lds, g, S, E); }
        REP(3) {
            PH_BEGIN(); const int n0 = (l == 0 ? 0 : 2), nit = 2 * (NCHUNK - n0);
            if (G != 256) { for (int it = G - 1 - vcu; it < nit; it += G) lru_apply_item(P, n0 + (it >> 1), it & 1, lds); }
            else { const int it = G - 1 - vcu; if (it < nit) lru_apply_item(P, n0 + (it >> 1), it & 1, lds);
                   const int ix = G + (vcu - 199); if (vcu >= 199 && ix < nit) lru_apply_item(P, n0 + (ix >> 1), ix & 1, lds); } }
        GRID_SYNC();
        REP(4) {
            PH_BEGIN(); const unsigned char* Q = ws + WS_Q; const unsigned char* KN = ws + WS_KN; const unsigned char* VT = ws + WS_V; const unsigned char* KR = ws + WS_KR; bf16_t* MIX = (bf16_t*)(ws + WS_MIX);
            for (int u = vcu; u < 256 + (l == 0 ? 4 : 0); u += G) {
                const int h = (u < 256) ? (u >> 6) : (u - 256); const size_t r0 = (u < 256) ? (size_t)(NCTX + 256 * (u & 63)) : 0; const int nkeys = (u < 256) ? NR : NCTX;
                att::attn_body<1>(Q + r0 * 768 + h * 192, KN + (size_t)h * NR * 128, KR, VT + (size_t)h * 128 * NR, NR, MIX + r0 * 1024 + 512 + h * 128, nkeys, (char*)lds_raw); } }
#ifdef PROBE_ATTN_ABL
        {
            PH_BEGIN(); const unsigned char* Q = ws + WS_Q; const unsigned char* KN = ws + WS_KN; const unsigned char* VT = ws + WS_V; const unsigned char* KR = ws + WS_KR; bf16_t* SCR = (bf16_t*)(ws + WS_HL);
            for (int u = vcu; u < 256; u += G) { const int h = u >> 6; const size_t r0 = (size_t)(NCTX + 256 * (u & 63));
                att::attn_body<1, PROBE_ATTN_ABL>(Q + r0 * 768 + h * 192, KN + (size_t)h * NR * 128, KR, VT + (size_t)h * 128 * NR, NR, SCR + r0 * 1024 + 512 + h * 128, NR, (char*)lds_raw); } }
#endif
        GRID_SYNC();
        for (int rep_ = 0; rep_ < 1 + (((PROBE_MASK >> 5) & 1) && l == 0); ++rep_) {
            PH_BEGIN(); xl_t* XL = (xl_t*)(ws + WS_XL); const float* MOD = (const float*)(ws + WS_MOD);
            pg8::Gemm g{(const bf16_t*)(ws + WS_MIX), (const bf16_t*)(ws + WS_WOUT), NR, 1024, 1024}; pg8::GridOrder S{64, 4, G, vcu, 1};
            pg8::EpiResid<(l != 0)> E{P.ctx, P.x, XL, MOD + (l * 2 + 0) * 6144 + 2048, MOD + (l * 2 + 1) * 6144 + 2048};
            pg8::gemm_phase<pg8::EpiResid<(l != 0)>, pg8::GridOrder, true, true>(lds, g, S, E);
            if (l == 0) for (int it = G - 1 - vcu; it < 64; it += G) ctx_wout_item(P, it >> 3, it & 7, lds); }
        GRID_SYNC();
        REP(6) { PH_BEGIN(); phase_norm2_router(P, l, lds, vcu, G); }
#ifdef FP8_CHECK
        if (l == FP8_CHECK - 1) { PH_BEGIN(); if (vcu == 0) fp8_selftest(P, l); }
#endif
#ifdef PROBE_P7
        { PH_BEGIN(); phase_p7_probe<PROBE_P7>(P, l, lds, gw, NGW); }
#endif
        GRID_SYNC();
        REP(7) { PH_BEGIN(); constexpr int NTK = (l == 0 ? 32 : 16);
            if (vcu < NTK || G <= NTK) { for (int it = vcu; it < NTK; it += G) topk_item(P, it & 15, it >> 4, lds); if (G <= NTK) { convert_weights(P, lds, l, vcu, G, CVT_NONEXP, CVT_ALL, false); if (l == 0) convert_weights(P, lds, 1, vcu, G, 0, CVT_NONEXP, true); } }
            else { convert_weights(P, lds, l, vcu - NTK, G - NTK, CVT_NONEXP, CVT_ALL, false);
                   if (l == 0) convert_weights(P, lds, 1, vcu - NTK, G - NTK, 0, CVT_NONEXP, true); } }
        GRID_SYNC();
        REP(9) {   PH_BEGIN(); pg8::Gemm g{(const bf16_t*)(ws + WS_H), (const bf16_t*)(ws + WS_WGU), 144 * 256, 0, 1024, (const int*)(ws + WS_IDX)}; pg8::MoeOrder S{8, G, vcu, 0}; pg8::EpiSwiglu E{(bf16_t*)(ws + WS_HID)};
            pg8::gemm_phase<pg8::EpiSwiglu, pg8::MoeOrder, true, true, true>(lds, g, S, E);
            if (l == 0) for (int it = vcu; it < 256; it += G) ctx_gateup_item(P, it >> 4, it & 15, lds); }
        GRID_SYNC();
        REP(10) {   PH_BEGIN(); pg8::Gemm g{(const bf16_t*)(ws + WS_HID), (const bf16_t*)(ws + WS_WD), 144 * 256, 0, 1024}; pg8::MoeOrder S{4, G, vcu, 0}; pg8::EpiDown E{(bf16_t*)(ws + WS_YE), (const float*)(ws + WS_GATE), (const float*)(ws + WS_GATEC)};
            pg8::gemm_phase<pg8::EpiDown, pg8::MoeOrder, true, true>(lds, g, S, E);
            if (l == 0) for (int it = G - 1 - vcu; it < 128; it += G) ctx_down_item(P, it >> 3, it & 7, lds); }
        GRID_SYNC();
        { PH_BEGIN(); phase_combine(P, l, gw, NGW); }
        if (l == 0) GRID_SYNC();
    }
    { constexpr int l = 1;
        REP(1) {
            PH_BEGIN(); pg8::Gemm g{(const bf16_t*)(ws + WS_H), (const bf16_t*)(ws + WS_WIN), NR, INP, 1024}; pg8::GridOrder S{NR / 256, INP / 256, G, vcu, 0}; pg8::EpiPlainBf16 E{(bf16_t*)(ws + WS_PROJ), INP};
            pg8::gemm_phase<pg8::EpiPlainBf16, pg8::GridOrder, true, true>(lds, g, S, E); }
        GRID_SYNC();
        REP(2) {
            PH_BEGIN();
            for (int it = vcu; it < 4 * NCHUNK + NCHUNK; it += G) { if (it < 4 * NCHUNK) { REP(11) lru_item(P, l, it >> 2, it & 3, lds); } else { REP(12) sgu_item(P, l, it - 4 * NCHUNK, lds); } }
            { const int lo = 5 * NCHUNK - 2 * G; if (lo > 0 && lo < G) { if (vcu >= lo) { REP(13) phase3_rows(P, l, (vcu - lo) * 8 + wave, (G - lo) * 8); } } else { REP(13) phase3_rows(P, l, gw, NGW); }
              if (l == 0 && G >= 96 + CVT_NONEXP) { const int lo2 = (lo > 0 && lo < G && G - lo >= 96) ? lo : 0; for (int it = vcu - lo2; it >= 0 && it < 96; it += G) mod_gemv_item(P, lds, 1, it); } } }
        GRID_SYNC();
        REP(3) {
            PH_BEGIN(); const float* cosT = (const float*)(ws + WS_ROPE);
            pg8::Gemm g{(const bf16_t*)(ws + WS_CQN), (const bf16_t*)(ws + WS_WUQ), NR, 768, QLR}; pg8::GridOrder S{NR / 256, 3, G, vcu, 0}; pg8::EpiQRope E{ws + WS_Q, cosT, cosT + 4096, att::QSCALE * att::QFP8};
            pg8::gemm_phase<pg8::EpiQRope, pg8::GridOrder, true, true>(lds, g, S, E); }
        REP(3) {
            PH_BEGIN(); pg8::Gemm g{(const bf16_t*)(ws + WS_CKVN), (const bf16_t*)(ws + WS_WUKV), NR, 512, KVLR}; pg8::GridOrder S{NR / 256, 2, G, G - 1 - vcu, 0}; pg8::EpiK8 E{ws + WS_KN, att::KFP8};
            pg8::gemm_phase<pg8::EpiK8, pg8::GridOrder, true, true>(lds, g, S, E); }
        REP(3) {
            PH_BEGIN(); pg8::Gemm g{(const bf16_t*)(ws + WS_WUKV) + 512 * KVLR, (const bf16_t*)(ws + WS_CKVN), 512, NR, KVLR}; const int cvt_ = (G != 256) ? (125 - vcu + 2 * G) % G : (vcu <= 125 ? 125 - vcu : (vcu >= 195 && vcu <= 198) ? 126 + (vcu - 195) : 100000);
            pg8::GridOrder S{2, NR / 256, G, cvt_, 0}; pg8::EpiVT E{ws + WS_V};
            pg8::gemm_phase<pg8::EpiVT, pg8::GridOrder, true, true>(lds, g, S, E); }
        REP(3) {
            PH_BEGIN(); const int n0 = (l == 0 ? 0 : 2), nit = 2 * (NCHUNK - n0);
            if (G != 256) { for (int it = G - 1 - vcu; it < nit; it += G) lru_apply_item(P, n0 + (it >> 1), it & 1, lds); }
            else { const int it = G - 1 - vcu; if (it < nit) lru_apply_item(P, n0 + (it >> 1), it & 1, lds);
                   const int ix = G + (vcu - 199); if (vcu >= 199 && ix < nit) lru_apply_item(P, n0 + (ix >> 1), ix & 1, lds); } }
        GRID_SYNC();
        REP(4) {
            PH_BEGIN(); const unsigned char* Q = ws + WS_Q; const unsigned char* KN = ws + WS_KN; const unsigned char* VT = ws + WS_V; const unsigned char* KR = ws + WS_KR; bf16_t* MIX = (bf16_t*)(ws + WS_MIX);
            for (int u = vcu; u < 256 + (l == 0 ? 4 : 0); u += G) {
                const int h = (u < 256) ? (u >> 6) : (u - 256); const size_t r0 = (u < 256) ? (size_t)(NCTX + 256 * (u & 63)) : 0; const int nkeys = (u < 256) ? NR : NCTX;
                att::attn_body<1>(Q + r0 * 768 + h * 192, KN + (size_t)h * NR * 128, KR, VT + (size_t)h * 128 * NR, NR, MIX + r0 * 1024 + 512 + h * 128, nkeys, (char*)lds_raw); } }
#ifdef PROBE_ATTN_ABL
        {
            PH_BEGIN(); const unsigned char* Q = ws + WS_Q; const unsigned char* KN = ws + WS_KN; const unsigned char* VT = ws + WS_V; const unsigned char* KR = ws + WS_KR; bf16_t* SCR = (bf16_t*)(ws + WS_HL);
            for (int u = vcu; u < 256; u += G) { const int h = u >> 6; const size_t r0 = (size_t)(NCTX + 256 * (u & 63));
                att::attn_body<1, PROBE_ATTN_ABL>(Q + r0 * 768 + h * 192, KN + (size_t)h * NR * 128, KR, VT + (size_t)h * 128 * NR, NR, SCR + r0 * 1024 + 512 + h * 128, NR, (char*)lds_raw); } }
#endif
        GRID_SYNC();
        for (int rep_ = 0; rep_ < 1 + (((PROBE_MASK >> 5) & 1) && l == 0); ++rep_) {
            PH_BEGIN(); xl_t* XL = (xl_t*)(ws + WS_XL); const float* MOD = (const float*)(ws + WS_MOD);
            pg8::Gemm g{(const bf16_t*)(ws + WS_MIX), (const bf16_t*)(ws + WS_WOUT), NR, 1024, 1024}; pg8::GridOrder S{64, 4, G, vcu, 1};
            pg8::EpiResid<(l != 0)> E{P.ctx, P.x, XL, MOD + (l * 2 + 0) * 6144 + 2048, MOD + (l * 2 + 1) * 6144 + 2048};
            pg8::gemm_phase<pg8::EpiResid<(l != 0)>, pg8::GridOrder, true, true>(lds, g, S, E);
            if (l == 0) for (int it = G - 1 - vcu; it < 64; it += G) ctx_wout_item(P, it >> 3, it & 7, lds); }
        GRID_SYNC();
        REP(6) { PH_BEGIN(); phase_norm2_router(P, l, lds, vcu, G); }
#ifdef FP8_CHECK
        if (l == FP8_CHECK - 1) { PH_BEGIN(); if (vcu == 0) fp8_selftest(P, l); }
#endif
#ifdef PROBE_P7
        { PH_BEGIN(); phase_p7_probe<PROBE_P7>(P, l, lds, gw, NGW); }
#endif
        GRID_SYNC();
        REP(7) { PH_BEGIN(); constexpr int NTK = (l == 0 ? 32 : 16);
            if (vcu < NTK || G <= NTK) { for (int it = vcu; it < NTK; it += G) topk_item(P, it & 15, it >> 4, lds); if (G <= NTK) { convert_weights(P, lds, l, vcu, G, CVT_NONEXP, CVT_ALL, false); if (l == 0) convert_weights(P, lds, 1, vcu, G, 0, CVT_NONEXP, true); } }
            else { convert_weights(P, lds, l, vcu - NTK, G - NTK, CVT_NONEXP, CVT_ALL, false);
                   if (l == 0) convert_weights(P, lds, 1, vcu - NTK, G - NTK, 0, CVT_NONEXP, true); } }
        GRID_SYNC();
        REP(9) {   PH_BEGIN(); pg8::Gemm g{(const bf16_t*)(ws + WS_H), (const bf16_t*)(ws + WS_WGU), 144 * 256, 0, 1024, (const int*)(ws + WS_IDX)}; pg8::MoeOrder S{8, G, vcu, 0}; pg8::EpiSwiglu E{(bf16_t*)(ws + WS_HID)};
            pg8::gemm_phase<pg8::EpiSwiglu, pg8::MoeOrder, true, true, true>(lds, g, S, E);
            if (l == 0) for (int it = vcu; it < 256; it += G) ctx_gateup_item(P, it >> 4, it & 15, lds); }
        GRID_SYNC();
        REP(10) {   PH_BEGIN(); pg8::Gemm g{(const bf16_t*)(ws + WS_HID), (const bf16_t*)(ws + WS_WD), 144 * 256, 0, 1024}; pg8::MoeOrder S{4, G, vcu, 0}; pg8::EpiDown E{(bf16_t*)(ws + WS_YE), (const float*)(ws + WS_GATE), (const float*)(ws + WS_GATEC)};
            pg8::gemm_phase<pg8::EpiDown, pg8::MoeOrder, true, true>(lds, g, S, E);
            if (l == 0) for (int it = G - 1 - vcu; it < 128; it += G) ctx_down_item(P, it >> 3, it & 7, lds); }
        GRID_SYNC();
        { PH_BEGIN(); phase_combine(P, l, gw, NGW); }
        if (l == 0) GRID_SYNC();
    }

}

extern "C" void kernel_launch(void* const* d_in, const int* in_sizes, int n_in, void* d_out, int out_size, void* d_ws, size_t ws_size, hipStream_t stream) {
    static int grid = 0;
    if (grid == 0) {
        if (n_in != 28 || out_size != SEQ * DM || ws_size < WS_END) { fprintf(stderr, "kernel_launch: unexpected shapes (n_in %d out %d ws %zu, need ws >= %zu); nothing launched\n", n_in, out_size, ws_size, (size_t)WS_END); grid = -1; return; }
        int dev = 0, cus = 0, per_cu = 0;
        hipGetDevice(&dev); hipDeviceGetAttribute(&cus, hipDeviceAttributeMultiprocessorCount, dev);
        if (hipFuncSetAttribute((const void*)fwd_megakernel, hipFuncAttributeMaxDynamicSharedMemorySize, LDS_BYTES) != hipSuccess) { fprintf(stderr, "kernel_launch: hipFuncSetAttribute failed\n"); grid = -1; return; }
        if (hipOccupancyMaxActiveBlocksPerMultiprocessor(&per_cu, (const void*)fwd_megakernel, 512, LDS_BYTES) != hipSuccess || per_cu < 1) { fprintf(stderr, "kernel_launch: occupancy query failed (%d)\n", per_cu); (void)hipGetLastError(); per_cu = 1; }
        grid = cus;
        if (grid > cus * per_cu) grid = cus * per_cu;
        if (grid > 256) grid = 256;
    }
    if (grid < 0) return;
    Params p{};
    const float** pp = (const float**)&p;
    for (int i = 0; i < 28; ++i) pp[i] = (const float*)d_in[i];
    p.out = (float*)d_out; p.ws = (unsigned char*)d_ws;
    void* args[] = {&p};
    const hipError_t e = hipLaunchCooperativeKernel((const void*)fwd_megakernel, dim3(grid), dim3(512), args, LDS_BYTES, stream);
    if (e != hipSuccess) fprintf(stderr, "kernel_launch: cooperative launch failed: %s (grid %d)\n", hipGetErrorString(e), grid);
}
```
